# Optimizing an MI355X kernel written in HIP

```python
import jax, jax.numpy as jnp
from jax import lax
import numpy as np

D_MODEL = 1024
BATCH = 2
SEQ = 16384
DEPTH = 1

MIX_WIDTH = D_MODEL
GLA_HEADS = 4
GLA_DV = (MIX_WIDTH // 2) // GLA_HEADS
GLA_DK = GLA_DV // 2
GLA_GATE_RANK = 16
GLA_GATE_NORM = 16.0
GLA_CHUNK = 16
RET_HEADS = 4
RET_DK = (MIX_WIDTH // 2) // RET_HEADS
RET_DV = RET_DK
RET_CHUNK = 128
ROPE_BASE = 10000.0
N_EXPERTS = 32
TOP_K = 4
D_EXPERT = D_MODEL
SWIGLU_LIMIT = 7.0
SWIGLU_ALPHA = 1.702
EPS = 1e-6

GLA_QK = GLA_HEADS * GLA_DK
GLA_VW = GLA_HEADS * GLA_DV
RET_QK = RET_HEADS * RET_DK
RET_VW = RET_HEADS * RET_DV
MIX_IN = 2 * GLA_QK + 2 * GLA_VW + GLA_GATE_RANK + 2 * RET_QK + 2 * RET_VW

kernel_name = 'hymba_gla_retnet_moe_adaln'


def rmsnorm(x, w):
    xf = x.astype(jnp.float32)
    y = xf * lax.rsqrt(jnp.mean(xf * xf, axis=-1, keepdims=True) + EPS)
    return (y * w.astype(jnp.float32)).astype(x.dtype)


def layernorm_nobias(x, w):
    xf = x.astype(jnp.float32)
    mu = jnp.mean(xf, axis=-1, keepdims=True)
    var = jnp.mean(jnp.square(xf - mu), axis=-1, keepdims=True)
    return ((xf - mu) * lax.rsqrt(var + EPS) * w.astype(jnp.float32))


def rotary(x, positions):
    half = x.shape[-1] // 2
    inv = ROPE_BASE ** (-jnp.arange(half, dtype=jnp.float32) / half)
    ang = positions.astype(jnp.float32)[..., None] * inv
    cos = jnp.cos(ang)[:, :, None, :]
    sin = jnp.sin(ang)[:, :, None, :]
    x1, x2 = x[..., :half].astype(jnp.float32), x[..., half:].astype(jnp.float32)
    return jnp.concatenate([x1 * cos - x2 * sin, x1 * sin + x2 * cos], axis=-1).astype(x.dtype)


def chunk_state_scan(decay, U):
    def step(S, inp):
        d, u = inp
        return d * S + u, S
    _, prev = lax.scan(step, jnp.zeros_like(U[0]), (decay, U))
    return prev


def gla_chunked(q, k, v, log_a):
    B, S, H, dk = q.shape
    dv = v.shape[-1]
    C = GLA_CHUNK
    N = S // C
    q = q.reshape(B, N, C, H, dk)
    k = k.reshape(B, N, C, H, dk)
    v = v.reshape(B, N, C, H, dv)
    b = jnp.cumsum(log_a.astype(jnp.float32).reshape(B, N, C, H, dk), axis=2)
    causal = jnp.tril(jnp.ones((C, C), dtype=bool))[:, :, None, None]
    diff = b[:, :, :, None] - b[:, :, None, :]
    decay = jnp.exp(jnp.where(causal, diff, -jnp.inf))
    A = jnp.einsum('bntshd,bnshd->bnhts', decay * q[:, :, :, None], k)
    o_intra = jnp.einsum('bnhts,bnshv->bnthv', A, v)
    b_last = b[:, :, -1]
    k_up = k * jnp.exp(b_last[:, :, None] - b)
    U = jnp.einsum('bnshd,bnshv->nbhdv', k_up, v).astype(jnp.float32)
    chunk_decay = jnp.exp(b_last).transpose(1, 0, 2, 3)[..., None]
    S_prev = chunk_state_scan(chunk_decay, U)
    o_inter = jnp.einsum('bnthd,nbhdv->bnthv', q * jnp.exp(b), S_prev)
    return (o_intra + o_inter).reshape(B, S, H, dv)


def retention_chunked(q, k, v, log_gamma):
    B, S, H, dk = q.shape
    dv = v.shape[-1]
    C = RET_CHUNK
    N = S // C
    q = q.reshape(B, N, C, H, dk)
    k = k.reshape(B, N, C, H, dk)
    v = v.reshape(B, N, C, H, dv)
    idx = jnp.arange(C, dtype=jnp.float32)
    rel = idx[:, None] - idx[None, :]
    Dmask = jnp.where((rel >= 0)[None], jnp.exp(rel[None] * log_gamma[:, None, None]), 0.0)
    scores = jnp.einsum('bnthd,bnshd->bnhts', q, k) * Dmask
    o_intra = jnp.einsum('bnhts,bnshv->bnthv', scores, v)
    xi = jnp.exp((idx + 1.0)[:, None] * log_gamma[None, :])
    zeta = jnp.exp((C - 1.0 - idx)[:, None] * log_gamma[None, :])
    U = jnp.einsum('bnshd,bnshv->nbhdv', k * zeta[None, None, :, :, None], v).astype(jnp.float32)
    chunk_decay = jnp.broadcast_to(jnp.exp(C * log_gamma)[None, None, :, None, None], (N, 1, H, 1, 1))
    R_prev = chunk_state_scan(chunk_decay, U)
    o_inter = jnp.einsum('bnthd,nbhdv->bnthv', q * xi[None, None, :, :, None], R_prev)
    return (o_intra + o_inter).reshape(B, S, H, dv)


def hybrid_mixer(h, positions, w_in, w_gk2, b_gk, gla_onorm, ret_onorm, w_out):
    B, S, _ = h.shape
    sizes = [GLA_QK, GLA_QK, GLA_VW, GLA_VW, GLA_GATE_RANK, RET_QK, RET_QK, RET_VW, RET_VW]
    cuts = np.cumsum(sizes)[:-1].tolist()
    proj = h @ w_in
    gq, gk, gv, gg, glr, rq, rk, rv, rg = jnp.split(proj, cuts, axis=-1)
    gq = gq.reshape(B, S, GLA_HEADS, GLA_DK) * (GLA_DK ** -0.5)
    gk = gk.reshape(B, S, GLA_HEADS, GLA_DK)
    gv = gv.reshape(B, S, GLA_HEADS, GLA_DV)
    log_a = jax.nn.log_sigmoid((glr @ w_gk2 + b_gk).astype(jnp.float32)) / GLA_GATE_NORM
    log_a = log_a.reshape(B, S, GLA_HEADS, GLA_DK)
    o_gla = gla_chunked(gq, gk, gv, log_a)
    o_gla = rmsnorm(o_gla.astype(jnp.float32), gla_onorm) * jax.nn.silu(gg.reshape(B, S, GLA_HEADS, GLA_DV).astype(jnp.float32))
    log_gamma = jnp.log(1.0 - jnp.exp2(-5.0 - jnp.arange(RET_HEADS, dtype=jnp.float32)))
    rq = rotary(rq.reshape(B, S, RET_HEADS, RET_DK), positions)
    rk = rotary(rk.reshape(B, S, RET_HEADS, RET_DK), positions) * (RET_DK ** -0.5)
    rv = rv.reshape(B, S, RET_HEADS, RET_DV)
    o_ret = retention_chunked(rq, rk, rv, log_gamma)
    o_ret = layernorm_nobias(o_ret, ret_onorm) * jax.nn.silu(rg.reshape(B, S, RET_HEADS, RET_DV).astype(jnp.float32))
    o = jnp.concatenate([o_gla.reshape(B, S, GLA_VW), o_ret.reshape(B, S, RET_VW)], axis=-1).astype(h.dtype)
    return o @ w_out


def moe_ffn(h, w_router, b_router, w_gu, b_gu, w_down, b_down):
    B, S, D = h.shape
    T = B * S
    hf = h.reshape(T, D)
    logits = (hf @ w_router + b_router).astype(jnp.float32)
    top_val, top_idx = lax.top_k(logits, TOP_K)
    weights = jax.nn.softmax(top_val, axis=-1).astype(h.dtype)
    flat_e = top_idx.reshape(-1)
    order = jnp.argsort(flat_e)
    sorted_e = flat_e[order]
    tok = order // TOP_K
    group_sizes = jnp.bincount(flat_e, length=N_EXPERTS).astype(jnp.int32)
    xs = hf[tok]
    gu = lax.ragged_dot(xs, w_gu, group_sizes) + b_gu[sorted_e]
    gate, up = jnp.split(gu, 2, axis=-1)
    gate = jnp.minimum(gate, SWIGLU_LIMIT)
    up = jnp.clip(up, -SWIGLU_LIMIT, SWIGLU_LIMIT)
    act = (up + 1.0) * (gate * jax.nn.sigmoid(SWIGLU_ALPHA * gate))
    out = lax.ragged_dot(act.astype(h.dtype), w_down, group_sizes) + b_down[sorted_e]
    out = out * weights.reshape(-1)[order][:, None]
    y = jnp.zeros((T, D), dtype=out.dtype).at[tok].add(out)
    return y.reshape(B, S, D).astype(h.dtype)


def setup_inputs(seed: int = 0) -> dict:
    key = jax.random.key(seed)
    ks = jax.random.split(key, 24)
    f32 = jnp.float32
    L, D, E, F = DEPTH, D_MODEL, N_EXPERTS, D_EXPERT
    nrm = lambda k, shape, fan: jax.random.normal(k, shape, f32) * (fan ** -0.5)
    x = jax.random.normal(ks[0], (BATCH, SEQ, D), f32)
    c = jax.random.normal(ks[1], (BATCH, D), f32)
    positions = (jnp.arange(SEQ, dtype=jnp.int32)[None, :]
                 + jax.random.randint(ks[2], (BATCH, 1), 0, 1024, dtype=jnp.int32))
    return {
        'x': x,
        'c': c,
        'positions': positions,
        'w_ada': nrm(ks[3], (L, D, 6 * D), D),
        'b_ada': 0.02 * jax.random.normal(ks[4], (L, 6 * D), f32),
        'norm1': 1.0 + 0.05 * jax.random.normal(ks[5], (L, D), f32),
        'w_in': nrm(ks[6], (L, D, MIX_IN), D),
        'w_gk2': nrm(ks[7], (L, GLA_GATE_RANK, GLA_QK), GLA_GATE_RANK),
        'b_gk': 0.1 * jax.random.normal(ks[8], (L, GLA_QK), f32),
        'gla_onorm': 1.0 + 0.05 * jax.random.normal(ks[9], (L, GLA_DV), f32),
        'ret_onorm': 1.0 + 0.05 * jax.random.normal(ks[10], (L, RET_DV), f32),
        'w_out': nrm(ks[11], (L, MIX_WIDTH, D), MIX_WIDTH),
        'norm2': 1.0 + 0.05 * jax.random.normal(ks[12], (L, D), f32),
        'w_router': nrm(ks[13], (L, D, E), D),
        'b_router': 0.01 * jax.random.normal(ks[14], (L, E), f32),
        'w_gu': nrm(ks[15], (L, E, D, 2 * F), D),
        'b_gu': 0.02 * jax.random.normal(ks[16], (L, E, 2 * F), f32),
        'w_down': nrm(ks[17], (L, E, F, D), F),
        'b_down': 0.02 * jax.random.normal(ks[18], (L, E, D), f32),
        'norm_f': 1.0 + 0.05 * jax.random.normal(ks[19], (D,), f32),
    }


def reference(x, c, positions, w_ada, b_ada, norm1, w_in, w_gk2, b_gk, gla_onorm, ret_onorm,
              w_out, norm2, w_router, b_router, w_gu, b_gu, w_down, b_down, norm_f):
    for l in range(DEPTH):
        mod = jax.nn.silu(c) @ w_ada[l] + b_ada[l]
        sh1, sc1, g1, sh2, sc2, g2 = jnp.split(mod[:, None, :], 6, axis=-1)
        h = rmsnorm(x, norm1[l]) * (1.0 + sc1) + sh1
        x = x + g1 * hybrid_mixer(h, positions, w_in[l], w_gk2[l], b_gk[l],
                                  gla_onorm[l], ret_onorm[l], w_out[l])
        h = rmsnorm(x, norm2[l]) * (1.0 + sc2) + sh2
        x = x + g2 * moe_ffn(h, w_router[l], b_router[l], w_gu[l], b_gu[l], w_down[l], b_down[l])
    return rmsnorm(x, norm_f)
```

```cpp
#include <hip/hip_runtime.h>
#include <hip/hip_cooperative_groups.h>
#include <cstdio>
#include <cstdint>
namespace cg = cooperative_groups;

#ifndef ONE_LAUNCH
#define ONE_LAUNCH 1
#endif
#ifndef USE_CG_SYNC
#define USE_CG_SYNC 0
#endif
#ifndef PROBE_DUP
#define PROBE_DUP -1
#endif
#define DUP(k) (PROBE_DUP == (k))
#ifndef MOE_FP8
#define MOE_FP8 1
#endif
#ifndef Y_FP8
#define Y_FP8 1
#endif
#ifndef X1_BF16
#define X1_BF16 1
#endif
#ifndef NAIVE_LA
#define NAIVE_LA 0
#endif

#define LAS __attribute__((address_space(3)))
#define DI __device__ __forceinline__
typedef unsigned short bf16_t;
typedef short bf16x8 __attribute__((ext_vector_type(8)));
typedef float f32x4 __attribute__((ext_vector_type(4)));
typedef float f32x2 __attribute__((ext_vector_type(2)));
typedef unsigned u32x4 __attribute__((ext_vector_type(4)));
typedef unsigned u32x2 __attribute__((ext_vector_type(2)));
typedef int i32x4 __attribute__((ext_vector_type(4)));
typedef int i32x8 __attribute__((ext_vector_type(8)));

constexpr int D = 1024, BATCH = 2, SEQ = 16384, M = BATCH * SEQ;
constexpr int NPROJ = 3584;
constexpr int NIN_T = 3840;
constexpr int MIX_IN = 3600;
constexpr int NE = 32, TOPK = 4, NPAIR = M * TOPK;
constexpr int ECAP = 32768;
constexpr float EPS = 1e-6f;
constexpr int NWAVES = 8, NTHREADS = 512;

constexpr size_t MiB = 1u << 20;
constexpr size_t WS_CTL = 0, CTL_ZERO_BYTES = 65536;
constexpr size_t WS_MOD = 1 * MiB;
constexpr size_t WS_DEC = 1 * MiB + 65536;
constexpr size_t WS_WIN = 2 * MiB;
constexpr size_t WS_WOUT = 10 * MiB;
constexpr size_t WS_WGU = 12 * MiB;
constexpr size_t WS_WD = 140 * MiB;
constexpr size_t WS_H = 204 * MiB;
constexpr size_t WS_O = 268 * MiB;
constexpr size_t WS_X1 = 332 * MiB;
constexpr size_t WS_PROJ = 460 * MiB;
constexpr size_t WS_BCUM = 684 * MiB;
constexpr size_t WS_U = 716 * MiB;
constexpr size_t WS_SP = 812 * MiB;
constexpr size_t WS_ACT = 460 * MiB;
constexpr size_t WS_Y = 717 * MiB;
constexpr size_t WS_PERM = 973 * MiB;
constexpr size_t WS_PW = 981 * MiB;
constexpr size_t WS_END = 982 * MiB;
constexpr int CW_CNT = 1024;
constexpr int CW_BAR = 8192;

constexpr int RING_BYTES = 131072;
constexpr int TBL_OFF = RING_BYTES, TBL_UNITS = 22, UD_OFF = TBL_OFF + TBL_UNITS * 1024, TBL_BYTES = 24 * 1024;
constexpr int MISC_OFF = TBL_OFF + TBL_BYTES;
constexpr int EPI_OFF = MISC_OFF + 1024;
constexpr int LDS_BYTES = EPI_OFF + 4096;

DI unsigned f2bf(float f) { unsigned u = __builtin_bit_cast(unsigned, f); return (u + 0x7fffu + ((u >> 16) & 1u)) >> 16; }
DI unsigned pk2(float lo, float hi) { return f2bf(lo) | (f2bf(hi) << 16); }
DI float bf2f(unsigned h) { return __builtin_bit_cast(float, h << 16); }
DI float bflo(unsigned w) { return __builtin_bit_cast(float, w << 16); }
DI float bfhi(unsigned w) { return __builtin_bit_cast(float, w & 0xffff0000u); }
DI f32x4 bf4_to_f32(u32x2 w) { return (f32x4){bflo(w.x), bfhi(w.x), bflo(w.y), bfhi(w.y)}; }
DI unsigned cvt_pk_bf16(float lo, float hi) { unsigned r; asm volatile("v_cvt_pk_bf16_f32 %0, %1, %2" : "=v"(r) : "v"(lo), "v"(hi)); return r; }
#define DPPF_(v, ctrl) __builtin_bit_cast(float, __builtin_amdgcn_update_dpp(__builtin_bit_cast(int, v), __builtin_bit_cast(int, v), ctrl, 0xf, 0xf, false))
DI float row16_sum(float v) {
    v += DPPF_(v, 0xB1); v += DPPF_(v, 0x4E); v += DPPF_(v, 0x141); v += DPPF_(v, 0x140); return v;
}
DI float wave_sum(float v) {
    v = row16_sum(v);
    const int iv = __builtin_bit_cast(int, v);
    const float a = __builtin_bit_cast(float, __builtin_amdgcn_readlane(iv, 0)), b = __builtin_bit_cast(float, __builtin_amdgcn_readlane(iv, 16));
    const float c = __builtin_bit_cast(float, __builtin_amdgcn_readlane(iv, 32)), d = __builtin_bit_cast(float, __builtin_amdgcn_readlane(iv, 48));
    return (a + b) + (c + d);
}
DI float wave_max(float v) {
#pragma unroll
    for (int o = 1; o < 64; o <<= 1) v = fmaxf(v, __shfl_xor(v, o));
    return v;
}
DI float sigmoidf_(float x) { return __builtin_amdgcn_rcpf(1.0f + __builtin_amdgcn_exp2f(-1.4426950408889634f * x)); }
DI float logsigmoidf_(float x) { return fminf(x, 0.f) - 0.6931471805599453f * __builtin_amdgcn_logf(1.0f + __builtin_amdgcn_exp2f(-1.4426950408889634f * fabsf(x))); }
#define LDS_WAIT() asm volatile("s_waitcnt lgkmcnt(0)" ::: "memory")
DI unsigned pk4_fp8(float a, float b, float c, float d) {
    a = __builtin_amdgcn_fmed3f(a, -448.f, 448.f); b = __builtin_amdgcn_fmed3f(b, -448.f, 448.f); c = __builtin_amdgcn_fmed3f(c, -448.f, 448.f); d = __builtin_amdgcn_fmed3f(d, -448.f, 448.f);
    int p = __builtin_amdgcn_cvt_pk_fp8_f32(a, b, 0, false); p = __builtin_amdgcn_cvt_pk_fp8_f32(c, d, p, true); return (unsigned)p;
}
DI unsigned pk4_fp8_nc(float a, float b, float c, float d) { int p = __builtin_amdgcn_cvt_pk_fp8_f32(a, b, 0, false); p = __builtin_amdgcn_cvt_pk_fp8_f32(c, d, p, true); return (unsigned)p; }
constexpr float Y8_SCALE = 32.f, Y8_INV = 1.0f / 32.f;
constexpr float W8_SCALE = 512.f, H8_SCALE = 16.f, A8_SCALE = 4.f;
constexpr int W8_E8M0 = 0x76767676, H8_E8M0 = 0x7B7B7B7B, A8_E8M0 = 0x7D7D7D7D;

typedef int i32x4_ __attribute__((ext_vector_type(4)));
namespace pg8 {
constexpr int BM = 256, BK = 64, HALF = 128, HTB = HALF * BK * 2, STAGE_BYTES = 8 * HTB, NXCD = 8, WGM = 8, K = 1024;
__host__ __device__ __forceinline__ int lds_byte(int r, int c) { const int st = (r >> 4) * 2 + (c >> 5), rr = r & 15, cc = c & 31, ob = rr * 64 + cc * 2; return st * 1024 + (ob ^ (((ob >> 9) & 1) << 5)); }
__host__ __device__ __forceinline__ void stage_rc(int b, int& R, int& C) { const int st = b / 1024, sb = b % 1024, swz = sb ^ (((sb >> 9) & 1) << 5); R = (st >> 1) * 16 + swz / 64; C = (st & 1) * 32 + (swz % 64) / 2; }
__host__ __device__ __forceinline__ int perm32(int rho) { const int n = rho >> 4, i = rho & 15; return 8 * (i >> 2) + 4 * n + (i & 3); }

struct Unit { int arow0, pn, e, rows, prow0, rot; };

struct DenseOrder {
    int nM, nN, nwg, G, c;
    const bf16_t* Bt;
    DI void init(int M_, int N_, int G_, int c_, const bf16_t* Bt_) { nM = M_ / BM; nN = N_ / BM; nwg = nM * nN; G = G_; c = c_; Bt = Bt_; }
    DI bool next(int i, Unit& u) const {
        const long L = (long)i * G + c; if (L >= nwg) return false;
        int wgid = (int)L; { const int q = nwg / NXCD, r = nwg % NXCD, xcd = wgid % NXCD, off = wgid / NXCD; wgid = (xcd < r ? xcd * (q + 1) : r * (q + 1) + (xcd - r) * q) + off; }
        const int nig = WGM * nN, gid = wgid / nig, fm = gid * WGM, gsz = (nM - fm) < WGM ? (nM - fm) : WGM;
        const int pm = fm + ((wgid % nig) % gsz); u.pn = (wgid % nig) / gsz; u.arow0 = pm * BM; u.e = 0; u.rows = BM; u.prow0 = 0; u.rot = (pm + 3 * u.pn) & 15; return true;
    }
    DI const char* bptr(const Unit& u) const { return (const char*)Bt + (size_t)u.pn * BM * K * 2; }
    DI int scale_a() const { return 0x7f7f7f7f; }
    DI int scale_b() const { return 0x7f7f7f7f; }
};

struct MoeOrder {
    int n;
    const LAS int* ud;
    const void* Bt; size_t bstride;
    int ebytes, sa, sb;
    DI bool next(int i, Unit& u) const {
        if (i >= n) return false;
        const i32x4_ r = *(const LAS i32x4_*)(ud + 4 * i);
        const int r0 = __builtin_amdgcn_readfirstlane(r.x);
        u.e = r0 & 255; u.pn = (r0 >> 8) & 255; u.rot = r0 >> 16;
        u.rows = __builtin_amdgcn_readfirstlane(r.y); u.arow0 = __builtin_amdgcn_readfirstlane(r.z); u.prow0 = __builtin_amdgcn_readfirstlane(r.w); return true;
    }
    DI bool next_lane(int i, Unit& u) const {
        if (i >= n) return false;
        const i32x4_ r = *(const LAS i32x4_*)(ud + 4 * i);
        u.e = r.x & 255; u.pn = (r.x >> 8) & 255; u.rot = r.x >> 16; u.rows = r.y; u.arow0 = r.z; u.prow0 = r.w; return true;
    }
    DI const char* bptr(const Unit& u) const { return (const char*)Bt + ((size_t)u.e * bstride + (size_t)u.pn * BM * K) * ebytes; }
    DI int scale_a() const { return sa; }
    DI int scale_b() const { return sb; }
};

DI const char* uniform_ptr(const char* p) {
    const unsigned long long v = (unsigned long long)p;
    const unsigned lo = __builtin_amdgcn_readfirstlane((unsigned)v), hi = __builtin_amdgcn_readfirstlane((unsigned)(v >> 32));
    return (const char*)(((unsigned long long)hi << 32) | lo);
}
template <class Epi, class Sched, bool GATHER, bool FP8 = false, bool BMAP16 = false, bool HALFSKIP = false>
DI void gemm_phase(LAS unsigned char* lds, const bf16_t* Abase, const Sched& S, const Epi& E, const LAS unsigned* tbl) {
    int tid = threadIdx.x; asm volatile("" : "+v"(tid));
    const int wid = __builtin_amdgcn_readfirstlane(tid >> 6), lane = tid & 63, wr = wid >> 2, wc = wid & 3, fr = lane & 15, fq = lane >> 4;
    constexpr int KB = FP8 ? K : 2 * K;
    constexpr int nt = KB / 128;
    unsigned voffB[2]; int Rr[2], Cc[2];
#pragma unroll
    for (int i = 0; i < 2; ++i) { int R, C; stage_rc(tid * 16 + i * 8192, R, C);
        const int Rb = BMAP16 ? (64 * (R >> 5) + 16 * ((R & 15) >> 2) + 4 * ((R >> 4) & 1) + (R & 3)) : ((R & ~31) + perm32(R & 31));
        voffB[i] = (unsigned)(Rb * KB + C * 2); Rr[i] = R; Cc[i] = C; }
    const size_t kstep = (size_t)(BK * 2);
    const size_t hstep = BMAP16 ? (size_t)8 * KB : (size_t)HALF * KB;
    const unsigned ldsw = (unsigned)wid * 1024u;
    const int aoff = lds_byte(wr * 64 + fr, fq * 8), boff = lds_byte(wc * 32 + fr, fq * 8);
#define PG8_SA(b, h) (((b) * 2 + (h)) * HTB)
#define PG8_SB(b, h) ((4 + (b) * 2 + (h)) * HTB)
#define PG8_STAGE2(bufoff, gbase, v0, v1) do { \
        __builtin_amdgcn_global_load_lds((const unsigned*)((const char*)(gbase) + (v0)), (LAS unsigned*)(lds + (bufoff) + ldsw), 16, 0, 0); \
        __builtin_amdgcn_global_load_lds((const unsigned*)((const char*)(gbase) + (v1)), (LAS unsigned*)(lds + (bufoff) + ldsw + 8192), 16, 0, 0); } while (0)
#define PG8_STAGEB(bufoff, gbase) PG8_STAGE2(bufoff, gbase, voffB[0], voffB[1])
#define PG8_RD16(off) (*(const LAS i32x4*)(lds + (off)))
#define PG8_LDA(dst, b, h) do { if constexpr (FP8) { _Pragma("unroll") for (int m = 0; m < 4; ++m) dst##8[m] = __builtin_shufflevector(PG8_RD16(PG8_SA(b, h) + aop + m * 2048), PG8_RD16(PG8_SA(b, h) + aop + m * 2048 + 1024), 0, 1, 2, 3, 4, 5, 6, 7); } \
        else { _Pragma("unroll") for (int m = 0; m < 4; ++m) _Pragma("unroll") for (int k = 0; k < 2; ++k) dst[m][k] = *(const LAS bf16x8*)(lds + PG8_SA(b, h) + aoff + m * 2048 + k * 1024); } } while (0)
#define PG8_LDB(dst, b, h) do { if constexpr (FP8) { _Pragma("unroll") for (int n = 0; n < 2; ++n) dst##8[n] = __builtin_shufflevector(PG8_RD16(PG8_SB(b, h) + bop + n * 2048), PG8_RD16(PG8_SB(b, h) + bop + n * 2048 + 1024), 0, 1, 2, 3, 4, 5, 6, 7); } \
        else { _Pragma("unroll") for (int n = 0; n < 2; ++n) _Pragma("unroll") for (int k = 0; k < 2; ++k) dst[n][k] = *(const LAS bf16x8*)(lds + PG8_SB(b, h) + boff + n * 2048 + k * 1024); } } while (0)
#define PG8_MMA(ai, bj, At, Bt) do { __builtin_amdgcn_s_setprio(1); \
        if constexpr (FP8) { _Pragma("unroll") for (int m = 0; m < 4; ++m) _Pragma("unroll") for (int n = 0; n < 2; ++n) \
            acc[ai][bj][m][n] = __builtin_amdgcn_mfma_scale_f32_16x16x128_f8f6f4(Bt##8[n], At##8[m], acc[ai][bj][m][n], 0, 0, 0, sclB, 0, sclA); } \
        else { _Pragma("unroll") for (int m = 0; m < 4; ++m) _Pragma("unroll") for (int n = 0; n < 2; ++n) _Pragma("unroll") for (int k = 0; k < 2; ++k) \
            acc[ai][bj][m][n] = __builtin_amdgcn_mfma_f32_16x16x32_bf16(Bt[n][k], At[m][k], acc[ai][bj][m][n], 0, 0, 0); } \
        __builtin_amdgcn_s_setprio(0); } while (0)
#define PG8_WAIT_V(n) asm volatile("s_waitcnt vmcnt(" #n ")" ::: "memory")
#define PG8_WAIT_L(n) asm volatile("s_waitcnt lgkmcnt(" #n ")" ::: "memory")
#define PG8_BAR __builtin_amdgcn_s_barrier()
#define PG8_SCHED __builtin_amdgcn_sched_barrier(0)
#define PG8_LOADVA(dst00, dst01, dst10, dst11, ui_) do { \
        if constexpr (GATHER) { const LAS unsigned* t_ = tbl + (ui_) * 256; \
            dst00 = t_[Rr[0]] + (unsigned)Cc[0] * 2u; dst01 = t_[Rr[1]] + (unsigned)Cc[1] * 2u; dst10 = t_[128 + Rr[0]] + (unsigned)Cc[0] * 2u; dst11 = t_[128 + Rr[1]] + (unsigned)Cc[1] * 2u; } \
        else { dst00 = (unsigned)(Rr[0] * KB + Cc[0] * 2); dst01 = (unsigned)(Rr[1] * KB + Cc[1] * 2); dst10 = (unsigned)((128 + Rr[0]) * KB + Cc[0] * 2); dst11 = (unsigned)((128 + Rr[1]) * KB + Cc[1] * 2); } } while (0)
    Unit cur, nxt; int ui = 0;
    if (!S.next(0, cur)) return;
    f32x4 acc[2][2][4][2];
    f32x4 bia[2][2];
    E.bias(cur, wc, fq, bia);
    u32x2 pre;
    E.pre_load(cur, tid, pre);
    bf16x8 At[4][2], B0[2][2], B1[2][2];
    i32x8 At8[4], B08[2], B18[2];
    const int sclA = S.scale_a(), sclB = S.scale_b();
    unsigned vA00, vA01, vA10, vA11;
    PG8_LOADVA(vA00, vA01, vA10, vA11, 0);
    const char* cA = GATHER ? (const char*)Abase : (const char*)Abase + (size_t)cur.arow0 * KB;
    const char* cB = S.bptr(cur);
#define PG8_KOFF(rot_, i_) ((size_t)(((i_) + (rot_)) & (nt - 1)) * kstep)
    { const size_t k0_ = PG8_KOFF(cur.rot, 0);
    PG8_STAGEB(PG8_SB(0, 0), cB + k0_); PG8_STAGEB(PG8_SB(0, 1), cB + hstep + k0_); PG8_STAGE2(PG8_SA(0, 0), cA + k0_, vA00, vA01); PG8_STAGE2(PG8_SA(0, 1), cA + k0_, vA10, vA11); }
#define PG8_ACC_INIT() do { _Pragma("unroll") for (int a = 0; a < 2; ++a) _Pragma("unroll") for (int b = 0; b < 2; ++b) _Pragma("unroll") for (int m = 0; m < 4; ++m) _Pragma("unroll") for (int n = 0; n < 2; ++n) acc[a][b][m][n] = bia[b][n]; } while (0)
    PG8_ACC_INIT();
    E.pre_store(pre, tid, lds + EPI_OFF);
    if (wr == 1) PG8_BAR;
    PG8_WAIT_V(2); PG8_BAR;
    { const size_t k1_ = PG8_KOFF(cur.rot, 1);
    PG8_STAGEB(PG8_SB(1, 0), cB + k1_); PG8_STAGE2(PG8_SA(1, 0), cA + k1_, vA00, vA01); PG8_STAGEB(PG8_SB(1, 1), cB + hstep + k1_); }
    PG8_WAIT_V(6); PG8_BAR;
    for (;;) {
        const bool has_next = S.next(ui + 1, nxt);
        const char* nA = cA; const char* nB = cB;
        if (has_next) { nB = S.bptr(nxt); if constexpr (!GATHER) nA = (const char*)Abase + (size_t)nxt.arow0 * KB; }
        const int nrot = has_next ? nxt.rot : cur.rot;
        const bool full = !HALFSKIP || cur.rows > 128;
#define PG8_KLOOP(FULL_) _Pragma("unroll 1") \
        for (int t = 0; t < nt; t += 2) { \
            const bool last = (t == nt - 2); \
            int aop = aoff, bop = boff; asm volatile("" : "+v"(aop), "+v"(bop)); \
            const size_t o1 = PG8_KOFF(cur.rot, t + 1), o2 = last ? PG8_KOFF(nrot, 0) : PG8_KOFF(cur.rot, t + 2), o3 = last ? PG8_KOFF(nrot, 1) : PG8_KOFF(cur.rot, t + 3); \
            const char* a1 = cA + o1; const char* b1x = cB + o1; \
            const char* a2 = (last ? nA : cA) + o2; const char* b2 = (last ? nB : cB) + o2; \
            const char* a3 = (last ? nA : cA) + o3; const char* b3 = (last ? nB : cB) + o3; \
            (void)b1x; \
 \
            PG8_LDB(B0, 0, 0); PG8_LDB(B1, 0, 1); PG8_SCHED; PG8_LDA(At, 0, 0); PG8_STAGE2(PG8_SA(1, 1), a1, vA10, vA11); \
            if constexpr (GATHER) { if (last && has_next) PG8_LOADVA(vA00, vA01, vA10, vA11, ui + 1); } \
            PG8_WAIT_V(8); PG8_WAIT_L(0); PG8_BAR; PG8_MMA(0, 0, At, B0); PG8_MMA(0, 1, At, B1); PG8_BAR; PG8_SCHED; \
 \
            if (FULL_) PG8_LDA(At, 0, 1); \
            PG8_STAGEB(PG8_SB(0, 0), b2); PG8_STAGEB(PG8_SB(0, 1), b2 + hstep); PG8_STAGE2(PG8_SA(0, 0), a2, vA00, vA01); \
            PG8_WAIT_V(8); PG8_WAIT_L(0); PG8_BAR; if (FULL_) { PG8_MMA(1, 0, At, B0); PG8_MMA(1, 1, At, B1); } PG8_BAR; PG8_SCHED; \
 \
            PG8_LDB(B0, 1, 0); PG8_LDB(B1, 1, 1); PG8_SCHED; PG8_LDA(At, 1, 0); PG8_STAGE2(PG8_SA(0, 1), a2, vA10, vA11); \
            PG8_WAIT_V(8); PG8_WAIT_L(0); PG8_BAR; PG8_MMA(0, 0, At, B0); PG8_MMA(0, 1, At, B1); PG8_BAR; PG8_SCHED; \
 \
            if (FULL_) PG8_LDA(At, 1, 1); \
            PG8_STAGEB(PG8_SB(1, 0), b3); PG8_STAGEB(PG8_SB(1, 1), b3 + hstep); PG8_STAGE2(PG8_SA(1, 0), a3, vA00, vA01); \
            PG8_WAIT_V(8); PG8_WAIT_L(0); PG8_BAR; if (FULL_) { PG8_MMA(1, 0, At, B0); PG8_MMA(1, 1, At, B1); } PG8_BAR; PG8_SCHED; \
        }
        if (full) { PG8_KLOOP(1) } else { PG8_KLOOP(0) }
#undef PG8_KLOOP
        if (wr == 0) PG8_BAR;
        if (has_next) { E.bias(nxt, wc, fq, bia); E.pre_load(nxt, tid, pre); }
        E(acc, cur, lds + EPI_OFF + (ui & 1) * 2048, wr, wc, fr, fq);
        if (!has_next) break;
        PG8_ACC_INIT();
        E.pre_store(pre, tid, lds + EPI_OFF + ((ui + 1) & 1) * 2048);
        cur = nxt; cA = nA; cB = nB; ++ui;
        if (wr == 1) PG8_BAR;
    }
    PG8_WAIT_V(0);
    PG8_BAR;
#undef PG8_SA
#undef PG8_SB
#undef PG8_STAGE2
#undef PG8_STAGEB
#undef PG8_LDA
#undef PG8_LDB
#undef PG8_MMA
#undef PG8_RD16
#undef PG8_WAIT_V
#undef PG8_WAIT_L
#undef PG8_BAR
#undef PG8_SCHED
#undef PG8_LOADVA
#undef PG8_KOFF
#undef PG8_ACC_INIT
}
}

typedef f32x4 AccT[2][2][4][2];

DI void store8_bf16(bf16_t* p, const float* v) {
    u32x4 w; w.x = cvt_pk_bf16(v[0], v[1]); w.y = cvt_pk_bf16(v[2], v[3]); w.z = cvt_pk_bf16(v[4], v[5]); w.w = cvt_pk_bf16(v[6], v[7]);
    *(u32x4*)p = w;
}
DI float dpp_shr_f(float x, int ctrl_sel);

struct EpiProj {
    bf16_t* proj; float* bcum; const int* pos; const float* bgk;
    DI void bias(const pg8::Unit& u, int wc, int fq, f32x4 (&bia)[2][2]) const {
        bia[0][0] = bia[0][1] = bia[1][0] = bia[1][1] = (f32x4){0.f, 0.f, 0.f, 0.f};
        if (u.pn == 14) { const float* b = bgk + wc * 32 + 8 * fq; bia[0][0] = *(const f32x4*)b; bia[0][1] = *(const f32x4*)(b + 4); bia[1][0] = *(const f32x4*)(b + 128); bia[1][1] = *(const f32x4*)(b + 132); }
    }
    DI void pre_load(const pg8::Unit& u, int tid, u32x2& pre) const { if (u.pn >= 6 && u.pn <= 9 && tid < 256) pre.x = (unsigned)pos[u.arow0 + tid]; }
    DI void pre_store(const u32x2& pre, int tid, LAS unsigned char* buf) const { if (tid < 256) *(LAS unsigned*)(buf + tid * 4) = pre.x; }
    DI void operator()(const AccT& acc, const pg8::Unit& u, const LAS unsigned char* ebuf, int wr, int wc, int fr, int fq) const {
        const int pn = u.pn, cl = wc * 32 + 8 * fq, row0 = u.arow0 + wr * 64 + fr;
        if (pn == 14) {
            const int lane = threadIdx.x & 63;
#pragma unroll
            for (int ai = 0; ai < 2; ++ai)
#pragma unroll
                for (int bj = 0; bj < 2; ++bj) {
                    float v[4][8];
#pragma unroll
                    for (int q = 0; q < 8; ++q) {
                        float carry = 0.f;
#pragma unroll
                        for (int m = 0; m < 4; ++m) {
                            float x = logsigmoidf_(acc[ai][bj][m][q >> 2][q & 3]) * 0.0625f;
                            x += __builtin_bit_cast(float, __builtin_amdgcn_update_dpp(0, __builtin_bit_cast(int, x), 0x111, 0xf, 0xf, true));
                            x += __builtin_bit_cast(float, __builtin_amdgcn_update_dpp(0, __builtin_bit_cast(int, x), 0x112, 0xf, 0xf, true));
                            x += __builtin_bit_cast(float, __builtin_amdgcn_update_dpp(0, __builtin_bit_cast(int, x), 0x114, 0xf, 0xf, true));
                            x += __builtin_bit_cast(float, __builtin_amdgcn_update_dpp(0, __builtin_bit_cast(int, x), 0x118, 0xf, 0xf, true));
                            x += carry;
                            v[m][q] = x;
                            carry = __shfl(x, lane | 15);
                        }
                    }
#pragma unroll
                    for (int m = 0; m < 4; ++m) {
                        const int row = row0 + ai * 128 + m * 16;
                        float* p = bcum + (size_t)row * 256 + bj * 128 + cl;
                        *(f32x4*)p = (f32x4){v[m][0], v[m][1], v[m][2], v[m][3]};
                        *(f32x4*)(p + 4) = (f32x4){v[m][4], v[m][5], v[m][6], v[m][7]};
                    }
                    asm volatile("" ::: "memory");
                }
        } else if (pn >= 6 && pn <= 9) {
            float inv[8];
#pragma unroll
            for (int q = 0; q < 8; ++q) inv[q] = exp2f(-(float)((cl + q) & 63) * 0.20762050593046014f);
            const int hh = cl >> 6;
            const float sc = (pn >= 8) ? 0.08838834764831845f : 1.0f;
            int pv[8];
#pragma unroll
            for (int i = 0; i < 8; ++i) pv[i] = *(const LAS int*)(ebuf + (wr * 64 + fr + (i >> 2) * 128 + (i & 3) * 16) * 4);
#pragma unroll
            for (int ai = 0; ai < 2; ++ai)
#pragma unroll
                for (int m = 0; m < 4; ++m) {
                    const int row = row0 + ai * 128 + m * 16;
                    const float p = (float)pv[ai * 4 + m];
                    float o1[8], o2[8];
#pragma unroll
                    for (int q = 0; q < 8; ++q) {
                        const float ang = p * inv[q];
                        const float t = rintf(ang * 0.15915493667125702f);
                        const float f = fmaf(ang, 0.15915493667125702f, -t) + ang * 6.4206382432985265e-09f;
                        const float sn = __builtin_amdgcn_sinf(f), cs = __builtin_amdgcn_cosf(f);
                        const float x1 = acc[ai][0][m][q >> 2][q & 3], x2 = acc[ai][1][m][q >> 2][q & 3];
                        o1[q] = (x1 * cs - x2 * sn) * sc; o2[q] = (x1 * sn + x2 * cs) * sc;
                    }
                    bf16_t* dst = proj + (size_t)row * NPROJ + pn * 256 + hh * 128 + (cl & 63);
                    store8_bf16(dst, o1); store8_bf16(dst + 64, o2);
                }
        } else {
            const bool silu = (pn == 4 || pn == 5 || pn == 12 || pn == 13);
#pragma unroll
            for (int ai = 0; ai < 2; ++ai)
#pragma unroll
                for (int m = 0; m < 4; ++m) {
                    const int row = row0 + ai * 128 + m * 16;
#pragma unroll
                    for (int bj = 0; bj < 2; ++bj) {
                        f32x4 v0 = acc[ai][bj][m][0], v1 = acc[ai][bj][m][1];
                        if (silu) {
                            const f32x4 t0 = v0 * (-1.4426950408889634f), t1 = v1 * (-1.4426950408889634f);
                            f32x4 d0, d1;
#pragma unroll
                            for (int i = 0; i < 4; ++i) { d0[i] = __builtin_amdgcn_exp2f(t0[i]); d1[i] = __builtin_amdgcn_exp2f(t1[i]); }
                            d0 = d0 + 1.0f; d1 = d1 + 1.0f;
#pragma unroll
                            for (int i = 0; i < 4; ++i) { d0[i] = __builtin_amdgcn_rcpf(d0[i]); d1[i] = __builtin_amdgcn_rcpf(d1[i]); }
                            v0 = v0 * d0; v1 = v1 * d1;
                        } else if (pn == 0) { v0 = v0 * 0.125f; v1 = v1 * 0.125f; }
                        u32x4 w; w.x = cvt_pk_bf16(v0[0], v0[1]); w.y = cvt_pk_bf16(v0[2], v0[3]); w.z = cvt_pk_bf16(v1[0], v1[1]); w.w = cvt_pk_bf16(v1[2], v1[3]);
                        *(u32x4*)(proj + (size_t)row * NPROJ + pn * 256 + bj * 128 + cl) = w;
                    }
                }
        }
    }
};

struct EpiRes1 {
    const float* x; const float* mod; float* x1;
    DI void bias(const pg8::Unit&, int, int, f32x4 (&bia)[2][2]) const { bia[0][0] = bia[0][1] = bia[1][0] = bia[1][1] = (f32x4){0.f, 0.f, 0.f, 0.f}; }
    DI void pre_load(const pg8::Unit&, int, u32x2&) const {}
    DI void pre_store(const u32x2&, int, LAS unsigned char*) const {}
    DI void operator()(const AccT& acc, const pg8::Unit& u, const LAS unsigned char* ebuf, int wr, int wc, int fr, int fq) const {
        const int cl = wc * 64 + 16 * fq, row0 = u.arow0 + wr * 64 + fr;
        const int b = u.arow0 >= SEQ ? 1 : 0;
        const float* g = mod + b * 6144 + 2048 + u.pn * 256 + cl;
        f32x4 gv[2][2];
#pragma unroll
        for (int bj = 0; bj < 2; ++bj) { gv[bj][0] = *(const f32x4*)(g + 8 * bj); gv[bj][1] = *(const f32x4*)(g + 8 * bj + 4); }
        f32x4 xa[4], xb[4];
        const size_t off0 = (size_t)row0 * D + u.pn * 256 + cl;
#define RES_LOAD(X_, i_) do { const size_t o_ = off0 + (size_t)(((i_) >> 2) * 128 + ((i_) & 3) * 16) * D; \
        X_[0] = *(const f32x4*)(x + o_); X_[1] = *(const f32x4*)(x + o_ + 4); X_[2] = *(const f32x4*)(x + o_ + 8); X_[3] = *(const f32x4*)(x + o_ + 12); } while (0)
#if X1_BF16
#define RES_STORE(X_, i_) do { const size_t o_ = off0 + (size_t)(((i_) >> 2) * 128 + ((i_) & 3) * 16) * D; \
        const f32x4 r0_ = X_[0] + gv[0][0] * acc[(i_) >> 2][0][(i_) & 3][0], r1_ = X_[1] + gv[0][1] * acc[(i_) >> 2][0][(i_) & 3][1]; \
        const f32x4 r2_ = X_[2] + gv[1][0] * acc[(i_) >> 2][1][(i_) & 3][0], r3_ = X_[3] + gv[1][1] * acc[(i_) >> 2][1][(i_) & 3][1]; \
        u32x4 w0_, w1_; w0_.x = cvt_pk_bf16(r0_[0], r0_[1]); w0_.y = cvt_pk_bf16(r0_[2], r0_[3]); w0_.z = cvt_pk_bf16(r1_[0], r1_[1]); w0_.w = cvt_pk_bf16(r1_[2], r1_[3]); \
        w1_.x = cvt_pk_bf16(r2_[0], r2_[1]); w1_.y = cvt_pk_bf16(r2_[2], r2_[3]); w1_.z = cvt_pk_bf16(r3_[0], r3_[1]); w1_.w = cvt_pk_bf16(r3_[2], r3_[3]); \
        bf16_t* xp_ = (bf16_t*)x1 + o_; *(u32x4*)xp_ = w0_; *(u32x4*)(xp_ + 8) = w1_; } while (0)
#else
#define RES_STORE(X_, i_) do { const size_t o_ = off0 + (size_t)(((i_) >> 2) * 128 + ((i_) & 3) * 16) * D; \
        *(f32x4*)(x1 + o_) = X_[0] + gv[0][0] * acc[(i_) >> 2][0][(i_) & 3][0]; *(f32x4*)(x1 + o_ + 4) = X_[1] + gv[0][1] * acc[(i_) >> 2][0][(i_) & 3][1]; \
        *(f32x4*)(x1 + o_ + 8) = X_[2] + gv[1][0] * acc[(i_) >> 2][1][(i_) & 3][0]; *(f32x4*)(x1 + o_ + 12) = X_[3] + gv[1][1] * acc[(i_) >> 2][1][(i_) & 3][1]; } while (0)
#endif
        RES_LOAD(xa, 0);
        RES_LOAD(xb, 1); RES_STORE(xa, 0);
        RES_LOAD(xa, 2); RES_STORE(xb, 1);
        RES_LOAD(xb, 3); RES_STORE(xa, 2);
        RES_LOAD(xa, 4); RES_STORE(xb, 3);
        RES_LOAD(xb, 5); RES_STORE(xa, 4);
        RES_LOAD(xa, 6); RES_STORE(xb, 5);
        RES_LOAD(xb, 7); RES_STORE(xa, 6);
        RES_STORE(xb, 7);
#undef RES_LOAD
#undef RES_STORE
    }
};

struct EpiGU {
    const float* bgu; bf16_t* act;
    DI void pre_load(const pg8::Unit&, int, u32x2&) const {}
    DI void pre_store(const u32x2&, int, LAS unsigned char*) const {}
    DI void bias(const pg8::Unit& u, int wc, int fq, f32x4 (&bia)[2][2]) const {
        const float* bg = bgu + (size_t)u.e * 2048 + u.pn * 128 + wc * 32 + 8 * fq;
        bia[0][0] = *(const f32x4*)bg; bia[0][1] = *(const f32x4*)(bg + 4); bia[1][0] = *(const f32x4*)(bg + 1024); bia[1][1] = *(const f32x4*)(bg + 1028);
    }
    DI void operator()(const AccT& acc, const pg8::Unit& u, const LAS unsigned char* ebuf, int wr, int wc, int fr, int fq) const {
        const int cl = wc * 32 + 8 * fq;
        constexpr float OS = MOE_FP8 ? A8_SCALE : 1.0f;
#pragma unroll
        for (int ai = 0; ai < 2; ++ai)
#pragma unroll
            for (int m = 0; m < 4; ++m) {
                const int r = ai * 128 + wr * 64 + m * 16 + fr;
                if (r < u.rows) {
                    f32x2 o[4];
#pragma unroll
                    for (int q = 0; q < 4; ++q) {
                        const f32x4 ag = acc[ai][0][m][q >> 1], au = acc[ai][1][m][q >> 1];
                        f32x2 gt = (q & 1) ? (f32x2){ag[2], ag[3]} : (f32x2){ag[0], ag[1]};
                        f32x2 up = (q & 1) ? (f32x2){au[2], au[3]} : (f32x2){au[0], au[1]};
                        gt.x = fminf(gt.x, 7.0f); gt.y = fminf(gt.y, 7.0f);
                        up.x = __builtin_amdgcn_fmed3f(up.x, -7.0f, 7.0f); up.y = __builtin_amdgcn_fmed3f(up.y, -7.0f, 7.0f);
                        const f32x2 t = gt * (-2.4554669595930157f);
                        f32x2 d; d.x = __builtin_amdgcn_exp2f(t.x); d.y = __builtin_amdgcn_exp2f(t.y);
                        d = d + 1.0f;
                        f32x2 rc; rc.x = __builtin_amdgcn_rcpf(d.x); rc.y = __builtin_amdgcn_rcpf(d.y);
                        o[q] = (up * OS + OS) * (gt * rc);
                    }
#if MOE_FP8
                    u32x2 w8; w8.x = pk4_fp8_nc(o[0].x, o[0].y, o[1].x, o[1].y); w8.y = pk4_fp8_nc(o[2].x, o[2].y, o[3].x, o[3].y);
                    *(u32x2*)((unsigned char*)act + (size_t)(u.arow0 + r) * D + u.pn * 128 + cl) = w8;
#else
                    const float ov[8] = {o[0].x, o[0].y, o[1].x, o[1].y, o[2].x, o[2].y, o[3].x, o[3].y};
                    store8_bf16(act + (size_t)(u.arow0 + r) * D + u.pn * 128 + cl, ov);
#endif
                }
            }
    }
};

struct EpiDown {
    const float* bd; const u32x2* perm; bf16_t* Y;
    DI void pre_load(const pg8::Unit& u, int tid, u32x2& pre) const { if (tid < 256) pre = perm[u.prow0 + (tid < u.rows ? tid : 0)]; }
    DI void pre_store(const u32x2& pre, int tid, LAS unsigned char* buf) const { if (tid < 256) *(LAS u32x2*)(buf + tid * 8) = pre; }
    DI void bias(const pg8::Unit& u, int wc, int fq, f32x4 (&bia)[2][2]) const {
        const float* b = bd + (size_t)u.e * D + u.pn * 256 + wc * 64 + 16 * fq;
        bia[0][0] = *(const f32x4*)b; bia[0][1] = *(const f32x4*)(b + 4); bia[1][0] = *(const f32x4*)(b + 8); bia[1][1] = *(const f32x4*)(b + 12);
    }
    DI void operator()(const AccT& acc, const pg8::Unit& u, const LAS unsigned char* ebuf, int wr, int wc, int fr, int fq) const {
        asm volatile("" : "+v"(fr), "+v"(fq));
        const int cl = wc * 64 + 16 * fq;
#pragma unroll
        for (int ai = 0; ai < 2; ++ai) {
            u32x2 rec[4];
#pragma unroll
            for (int m = 0; m < 4; ++m) { const int r = ai * 128 + wr * 64 + m * 16 + fr; rec[m] = *(const LAS u32x2*)(ebuf + r * 8); }
#pragma unroll
            for (int m = 0; m < 4; ++m) {
                const int r = ai * 128 + wr * 64 + m * 16 + fr;
                if (r < u.rows) {
                    const unsigned wbits = rec[m].y; const float wgt = __uint_as_float(wbits);
#if Y_FP8
                    const float wg8 = wgt * Y8_SCALE;
                    const f32x4 v00 = acc[ai][0][m][0] * wg8, v01 = acc[ai][0][m][1] * wg8, v10 = acc[ai][1][m][0] * wg8, v11 = acc[ai][1][m][1] * wg8;
                    u32x4 w; w.x = pk4_fp8(v00[0], v00[1], v00[2], v00[3]); w.y = pk4_fp8(v01[0], v01[1], v01[2], v01[3]); w.z = pk4_fp8(v10[0], v10[1], v10[2], v10[3]); w.w = pk4_fp8(v11[0], v11[1], v11[2], v11[3]);
                    *(u32x4*)((unsigned char*)Y + (size_t)rec[m].x * D + u.pn * 256 + cl) = w;
#else
                    const f32x4 v00 = acc[ai][0][m][0] * wgt, v01 = acc[ai][0][m][1] * wgt, v10 = acc[ai][1][m][0] * wgt, v11 = acc[ai][1][m][1] * wgt;
                    u32x4 w0, w1; w0.x = cvt_pk_bf16(v00[0], v00[1]); w0.y = cvt_pk_bf16(v00[2], v00[3]); w0.z = cvt_pk_bf16(v01[0], v01[1]); w0.w = cvt_pk_bf16(v01[2], v01[3]);
                    w1.x = cvt_pk_bf16(v10[0], v10[1]); w1.y = cvt_pk_bf16(v10[2], v10[3]); w1.z = cvt_pk_bf16(v11[0], v11[1]); w1.w = cvt_pk_bf16(v11[2], v11[3]);
                    bf16_t* yp = Y + (size_t)rec[m].x * D + u.pn * 256 + cl; *(u32x4*)yp = w0; *(u32x4*)(yp + 8) = w1;
#endif
                }
            }
            asm volatile("" ::: "memory");
        }
    }
};

#define XB_TMO      128
#define XB_XCNT(j)  (256  + 64 * (j))
#define XB_XSUB(j)  (1280 + 64 * (j))
#define XB_XGEN(j)  (2304 + 64 * (j))
#define XB_TOP      3328
#define XB_TOPGEN   3392
#define XCD_BAR_WORDS 3456
#define XB_SPIN_CAP (1u << 22)
DI unsigned xb_ld(unsigned* p)              { return __hip_atomic_load(p, __ATOMIC_RELAXED, __HIP_MEMORY_SCOPE_AGENT); }
DI unsigned xb_add(unsigned* p, unsigned v) { return __hip_atomic_fetch_add(p, v, __ATOMIC_RELAXED, __HIP_MEMORY_SCOPE_AGENT); }
DI unsigned xb_xcc_id() { return (unsigned)__builtin_amdgcn_s_getreg((3 << 11) | 20) & 0xFu; }
#define XB_SPIN(cond, bar) do { unsigned _sp = 0; while (cond) { __builtin_amdgcn_s_sleep(1); \
    if ((++_sp & 255u) == 0u) { if (xb_ld(&(bar)[XB_TMO])) break; if (_sp > XB_SPIN_CAP) { atomicAdd(&(bar)[XB_TMO], 1u); break; } } } } while (0)
struct XcdBarrier { unsigned* bar; unsigned x; volatile LAS unsigned* st; };
DI XcdBarrier xcd_barrier_post(unsigned* bar, volatile LAS unsigned* st) {
    XcdBarrier b; b.bar = bar; b.x = xb_xcc_id(); b.st = st;
    if (threadIdx.x == 0) (void)xb_add(&bar[XB_XCNT(b.x)], 1u);
    return b;
}
DI void xcd_barrier_complete(unsigned* bar, unsigned x, unsigned& nloc, unsigned& nx) {
    const unsigned G = gridDim.x * gridDim.y * gridDim.z;
    unsigned sum, cnt, mine, sp = 0u;
    for (;;) {
        sum = 0u; cnt = 0u; mine = 0u;
#pragma unroll
        for (unsigned j = 0; j < 16; ++j) { const unsigned c = xb_ld(&bar[XB_XCNT(j)]); sum += c; cnt += (c > 0u) ? 1u : 0u; mine = (j == x) ? c : mine; }
        if (sum == G) break;
        __builtin_amdgcn_s_sleep(1);
        if ((++sp & 255u) == 0u) { if (xb_ld(&bar[XB_TMO])) break; if (sp > XB_SPIN_CAP) { atomicAdd(&bar[XB_TMO], 1u); break; } }
    }
    nloc = mine > 0u ? mine : 1u; nx = cnt > 0u ? cnt : 1u;
}
DI void xcd_barrier(const XcdBarrier& b) {
    asm volatile("s_waitcnt vmcnt(0)" ::: "memory");
    __syncthreads();
    if (threadIdx.x == 0) {
        unsigned* bar = b.bar;
        __builtin_amdgcn_s_waitcnt(0);
        unsigned nloc = b.st[0], nx = b.st[1];
        if (nloc == 0u) { xcd_barrier_complete(bar, b.x, nloc, nx); b.st[0] = nloc; b.st[1] = nx; }
        const unsigned old = xb_add(&bar[XB_XSUB(b.x)], 1u);
        const unsigned gen = old / nloc;
        if (old + 1u == (gen + 1u) * nloc) {
            __builtin_amdgcn_fence(__ATOMIC_RELEASE, "agent");
            asm volatile("s_waitcnt vmcnt(0)" ::: "memory");
            const unsigned og = xb_add(&bar[XB_TOP], 1u);
            const unsigned tg = og / nx;
            if (og + 1u == (tg + 1u) * nx) xb_add(&bar[XB_TOPGEN], 1u);
            else XB_SPIN(xb_ld(&bar[XB_TOPGEN]) == tg, bar);
            __builtin_amdgcn_fence(__ATOMIC_ACQUIRE, "agent");
            xb_add(&bar[XB_XGEN(b.x)], 1u);
            asm volatile("s_waitcnt vmcnt(0)" ::: "memory");
        } else {
            XB_SPIN(xb_ld(&bar[XB_XGEN(b.x)]) == gen, bar);
            __builtin_amdgcn_fence(__ATOMIC_ACQUIRE, "agent");
            asm volatile("s_waitcnt vmcnt(0)" ::: "memory");
        }
    }
    __syncthreads();
}

struct Args { const void* in[20]; float* out; unsigned char* ws; int ph_lo, ph_hi; };

struct Frame {
    LAS unsigned char* lds;
    int tid, lane, wave, G, bid;
    const float *x, *c, *w_ada, *b_ada, *norm1, *w_in, *w_gk2, *b_gk, *gla_onorm, *ret_onorm, *w_out, *norm2, *w_router, *b_router, *w_gu, *b_gu, *w_down, *b_down, *norm_f;
    const int* positions;
    float* out; unsigned char* ws;
    unsigned* ctl; float* mod; bf16_t *win_t, *wout_t, *wgu_t, *wd_t, *hbuf, *obuf, *proj, *act, *Y; float *x1, *bcum, *pw; u32x2* perm;
};

DI void tr_item(const float* W, int ldw, int k0, int src_c0, bf16_t* dst, LAS float* scr, int lane) {
    { float t[32]; const float* wp = W + (size_t)(k0 + (lane >> 5)) * ldw + src_c0 + (lane & 31);
#pragma unroll
      for (int i = 0; i < 32; ++i) t[i] = wp[(size_t)(2 * i) * ldw];
#pragma unroll
      for (int i = 0; i < 32; ++i) scr[(2 * i + (lane >> 5)) * 33 + (lane & 31)] = t[i]; }
    LDS_WAIT(); asm volatile("" ::: "memory");
    const int c = lane & 7;
#pragma unroll
    for (int j = 0; j < 4; ++j) { const int n = (lane >> 3) + 8 * j; const LAS float* s = scr + (8 * c) * 33 + n;
        u32x4 o; o.x = pk2(s[0 * 33], s[1 * 33]); o.y = pk2(s[2 * 33], s[3 * 33]); o.z = pk2(s[4 * 33], s[5 * 33]); o.w = pk2(s[6 * 33], s[7 * 33]);
        *(u32x4*)(dst + (size_t)n * D + k0 + 8 * c) = o; }
    LDS_WAIT(); asm volatile("" ::: "memory");
}

DI void tr_item8(const float* W, int ldw, int k0, int src_c0, unsigned char* dst, LAS float* scr, int lane) {
    { float t[32]; const float* wp = W + (size_t)(k0 + (lane >> 5)) * ldw + src_c0 + (lane & 31);
#pragma unroll
      for (int i = 0; i < 32; ++i) t[i] = wp[(size_t)(2 * i) * ldw];
#pragma unroll
      for (int i = 0; i < 32; ++i) scr[(2 * i + (lane >> 5)) * 33 + (lane & 31)] = t[i]; }
    LDS_WAIT(); asm volatile("" ::: "memory");
    const int c = lane & 3;
#pragma unroll
    for (int j = 0; j < 2; ++j) { const int n = (lane >> 2) + 16 * j; const LAS float* s = scr + (16 * c) * 33 + n;
        u32x4 o;
        o.x = pk4_fp8(s[0 * 33] * W8_SCALE, s[1 * 33] * W8_SCALE, s[2 * 33] * W8_SCALE, s[3 * 33] * W8_SCALE);
        o.y = pk4_fp8(s[4 * 33] * W8_SCALE, s[5 * 33] * W8_SCALE, s[6 * 33] * W8_SCALE, s[7 * 33] * W8_SCALE);
        o.z = pk4_fp8(s[8 * 33] * W8_SCALE, s[9 * 33] * W8_SCALE, s[10 * 33] * W8_SCALE, s[11 * 33] * W8_SCALE);
        o.w = pk4_fp8(s[12 * 33] * W8_SCALE, s[13 * 33] * W8_SCALE, s[14 * 33] * W8_SCALE, s[15 * 33] * W8_SCALE);
        *(u32x4*)(dst + (size_t)n * D + k0 + 16 * c) = o; }
    LDS_WAIT(); asm volatile("" ::: "memory");
}

struct TrDesc { const float* W; int ldw, k0, src; unsigned char* dst; int fp8; };
constexpr int TR_I_IN = 112 * 16, TR_I_OUT = 32 * 16, TR_I_GU = 64 * 16, TR_I_D = 32 * 16, TR_NITEMS = TR_I_IN + TR_I_OUT + NE * TR_I_GU + NE * TR_I_D;
DI bool tr_decode(Frame& F, int it, TrDesc& d) {
    if (it >= TR_NITEMS) return false;
    int r = it;
    if (r < TR_I_IN) {
        const int kb = r / 112, nb = r % 112, n0 = nb * 32, pn = n0 >> 8, cl0 = n0 & 255;
        int src;
        if (pn < 6) src = n0;
        else if (pn <= 9) { const int bj = cl0 >> 7, o0 = cl0 & 127; src = pn * 256 + 16 + 128 * (o0 >> 6) + 64 * bj + (o0 & 63); }
        else src = n0 + 16;
        d.W = F.w_in; d.ldw = MIX_IN; d.k0 = kb * 64; d.src = src; d.dst = (unsigned char*)(F.win_t + (size_t)n0 * D); d.fp8 = 0; return true;
    }
    r -= TR_I_IN;
    if (r < TR_I_OUT) { const int kb = r / 32, nb = r % 32; d.W = F.w_out; d.ldw = D; d.k0 = kb * 64; d.src = nb * 32; d.dst = (unsigned char*)(F.wout_t + (size_t)nb * 32 * D); d.fp8 = 0; return true; }
    r -= TR_I_OUT;
    if (r < NE * TR_I_GU) {
        const int e = r / TR_I_GU, rr = r % TR_I_GU, kb = rr / 64, nb = rr % 64, n0 = nb * 32, pn = n0 >> 8, cl0 = n0 & 255, bj = cl0 >> 7, o0 = cl0 & 127;
        d.W = F.w_gu + (size_t)e * D * 2048; d.ldw = 2048; d.k0 = kb * 64; d.src = 1024 * bj + 128 * pn + o0; d.fp8 = MOE_FP8;
        d.dst = (unsigned char*)F.wgu_t + ((size_t)e * 2048 + n0) * D * (MOE_FP8 ? 1 : 2); return true;
    }
    r -= NE * TR_I_GU;
    { const int e = r / TR_I_D, rr = r % TR_I_D, kb = rr / 32, nb = rr % 32;
      d.W = F.w_down + (size_t)e * D * D; d.ldw = D; d.k0 = kb * 64; d.src = nb * 32; d.fp8 = MOE_FP8;
      d.dst = (unsigned char*)F.wd_t + ((size_t)e * D + nb * 32) * D * (MOE_FP8 ? 1 : 2); return true; }
}
DI void tr_load(float (&t)[32], const TrDesc& d, int lane) {
    const float* wp = d.W + (size_t)(d.k0 + (lane >> 5)) * d.ldw + d.src + (lane & 31);
#pragma unroll
    for (int i = 0; i < 32; ++i) t[i] = __builtin_nontemporal_load(wp + (size_t)(2 * i) * d.ldw);
}
DI void tr_finish(const float (&t)[32], const TrDesc& d, LAS float* scr, int lane) {
#pragma unroll
    for (int i = 0; i < 32; ++i) scr[(2 * i + (lane >> 5)) * 33 + (lane & 31)] = t[i];
    LDS_WAIT(); asm volatile("" ::: "memory");
    if (d.fp8) {
        const int c = lane & 3;
#pragma unroll
        for (int j = 0; j < 2; ++j) { const int n = (lane >> 2) + 16 * j; const LAS float* s = scr + (16 * c) * 33 + n;
            u32x4 o;
            o.x = pk4_fp8(s[0 * 33] * W8_SCALE, s[1 * 33] * W8_SCALE, s[2 * 33] * W8_SCALE, s[3 * 33] * W8_SCALE);
            o.y = pk4_fp8(s[4 * 33] * W8_SCALE, s[5 * 33] * W8_SCALE, s[6 * 33] * W8_SCALE, s[7 * 33] * W8_SCALE);
            o.z = pk4_fp8(s[8 * 33] * W8_SCALE, s[9 * 33] * W8_SCALE, s[10 * 33] * W8_SCALE, s[11 * 33] * W8_SCALE);
            o.w = pk4_fp8(s[12 * 33] * W8_SCALE, s[13 * 33] * W8_SCALE, s[14 * 33] * W8_SCALE, s[15 * 33] * W8_SCALE);
            *(u32x4*)(d.dst + (size_t)n * D + d.k0 + 16 * c) = o; }
    } else {
        const int c = lane & 7;
#pragma unroll
        for (int j = 0; j < 4; ++j) { const int n = (lane >> 3) + 8 * j; const LAS float* s = scr + (8 * c) * 33 + n;
            u32x4 o; o.x = pk2(s[0 * 33], s[1 * 33]); o.y = pk2(s[2 * 33], s[3 * 33]); o.z = pk2(s[4 * 33], s[5 * 33]); o.w = pk2(s[6 * 33], s[7 * 33]);
            *(u32x4*)((bf16_t*)d.dst + (size_t)n * D + d.k0 + 8 * c) = o; }
    }
    LDS_WAIT(); asm volatile("" ::: "memory");
}

constexpr int TR_SPLIT1 = TR_NITEMS - 9216 - 7168, TR_SPLIT2 = TR_NITEMS - 7168;
DI void tr_range(Frame& F, LAS float* scr, int first, int last, int widx, int nw) {
    int it = first + widx; TrDesc d0, d1; float t0[32], t1[32];
    bool v0 = it < last && tr_decode(F, it, d0);
    if (v0) tr_load(t0, d0, F.lane);
    while (v0) {
        const bool v1 = (it + nw) < last && tr_decode(F, it + nw, d1);
        if (v1) tr_load(t1, d1, F.lane);
        tr_finish(t0, d0, scr, F.lane);
        if (!v1) break;
        it += 2 * nw; v0 = it < last && tr_decode(F, it, d0);
        if (v0) tr_load(t0, d0, F.lane);
        tr_finish(t1, d1, scr, F.lane);
    }
}

DI void p0_prep(Frame& F) {
    { int t_ = threadIdx.x; asm volatile("" : "+v"(t_)); F.tid = t_; F.lane = t_ & 63; }
    LAS float* red = (LAS float*)F.lds;
    LAS float* sc_ = (LAS float*)(F.lds + 4096);
    for (int i = F.tid; i < 2 * D; i += NTHREADS) { const float cv = F.c[i]; sc_[i] = cv * sigmoidf_(cv); }
    __syncthreads();
    for (int cb = F.bid; cb < 256; cb += F.G) {
        if (F.tid < 504) {
            const int col = F.tid % 24, ks = F.tid / 24; float a0 = 0.f, a1 = 0.f;
            const float* wp = F.w_ada + (size_t)ks * 6144 + cb * 24 + col;
#pragma unroll 1
            for (int k0 = 0; k0 < 49; k0 += 7) {
                float w[7];
#pragma unroll
                for (int j = 0; j < 7; ++j) { const int k = ks + 21 * (k0 + j); w[j] = k < D ? wp[(size_t)(21 * (k0 + j)) * 6144] : 0.f; }
#pragma unroll
                for (int j = 0; j < 7; ++j) { const int k = ks + 21 * (k0 + j); if (k < D) { a0 += sc_[k] * w[j]; a1 += sc_[D + k] * w[j]; } }
            }
            red[ks * 24 + col] = a0; red[(21 + ks) * 24 + col] = a1;
        }
        __syncthreads();
        if (F.tid < 48) {
            const int b = F.tid / 24, col = F.tid % 24; float s = F.b_ada[cb * 24 + col];
            for (int ks = 0; ks < 21; ++ks) s += red[(b * 21 + ks) * 24 + col];
            F.mod[b * 6144 + cb * 24 + col] = s;
        }
        __syncthreads();
    }
    for (int it = F.bid * NTHREADS + F.tid; it < 256 * 128; it += F.G * NTHREADS) {
        const int c = it & 255, k8 = it >> 8;
        float w2[16];
#pragma unroll
        for (int j = 0; j < 16; ++j) w2[j] = F.w_gk2[j * 256 + c];
        float o[8];
#pragma unroll
        for (int kk = 0; kk < 8; ++kk) {
            const float* wi = F.w_in + (size_t)(k8 * 8 + kk) * MIX_IN + 1536; float s = 0.f;
#pragma unroll
            for (int j = 0; j < 16; ++j) s += wi[j] * w2[j];
            o[kk] = s;
        }
        u32x4 w; w.x = pk2(o[0], o[1]); w.y = pk2(o[2], o[3]); w.z = pk2(o[4], o[5]); w.w = pk2(o[6], o[7]);
        *(u32x4*)(F.win_t + (size_t)(3584 + c) * D + k8 * 8) = w;
    }
    tr_range(F, (LAS float*)(F.lds + 16384 + F.wave * 8704), 0, F.G == 256 ? TR_SPLIT1 : TR_NITEMS, F.bid * NWAVES + F.wave, F.G * NWAVES);
}

DI void p1_h1(Frame& F) {
    { int t_ = threadIdx.x; asm volatile("" : "+v"(t_)); F.tid = t_; F.lane = t_ & 63; }
    const int gw = F.bid * NWAVES + F.wave, NGW = F.G * NWAVES;
    f32x4 v[4], vn[4];
    if (gw < M) { const f32x4* xr = (const f32x4*)(F.x + (size_t)gw * D) + F.lane;
#pragma unroll
        for (int j = 0; j < 4; ++j) v[j] = xr[64 * j]; }
    for (int m = gw; m < M; m += NGW) {
        const int b = m >= SEQ;
        if (m + NGW < M) { const f32x4* xn = (const f32x4*)(F.x + (size_t)(m + NGW) * D) + F.lane;
#pragma unroll
            for (int j = 0; j < 4; ++j) vn[j] = xn[64 * j]; }
        const f32x4* nr = (const f32x4*)F.norm1 + F.lane;
        const f32x4* shr = (const f32x4*)(F.mod + b * 6144) + F.lane;
        const f32x4* scr = (const f32x4*)(F.mod + b * 6144 + 1024) + F.lane;
        float s = 0.f;
#pragma unroll
        for (int j = 0; j < 4; ++j) s += (v[j].x * v[j].x + v[j].y * v[j].y) + (v[j].z * v[j].z + v[j].w * v[j].w);
        const float rstd = __builtin_amdgcn_rsqf(wave_sum(s) * (1.0f / D) + EPS);
        u32x2* o8 = (u32x2*)(F.hbuf + (size_t)m * D) + F.lane;
#pragma unroll
        for (int j = 0; j < 4; ++j) {
            const f32x4 w = nr[64 * j], sc = scr[64 * j], sh = shr[64 * j];
            const f32x4 h = v[j] * rstd * w * (sc + 1.0f) + sh;
            u32x2 p; p.x = pk2(h.x, h.y); p.y = pk2(h.z, h.w); o8[64 * j] = p;
        }
#pragma unroll
        for (int j = 0; j < 4; ++j) v[j] = vn[j];
    }
}

template <int DK, bool GLA>
DI void la_naive_stream(Frame& F, int b, int h) {
    LAS float* qs = (LAS float*)F.lds;
    LAS float* ks = qs + 64 * DK;
    LAS float* as = ks + 64 * DK;
    LAS float* vs = (LAS float*)(F.lds + 3 * 64 * 128 * 4);
    const int qcol = GLA ? h * 64 : 1536 + h * 128, kcol = GLA ? 256 + h * 64 : 2048 + h * 128, vcol = GLA ? 512 + h * 128 : 2560 + h * 128, gcol = GLA ? 1024 + h * 128 : 3072 + h * 128;
    const float gamma = 1.0f - exp2f(-5.0f - (float)h);
    float S[DK];
#pragma unroll
    for (int d = 0; d < DK; ++d) S[d] = 0.f;
    for (int tile = 0; tile < SEQ / 64; ++tile) {
        const int row0 = b * SEQ + tile * 64;
        for (int i = F.tid; i < 64 * DK; i += NTHREADS) {
            const int t = i / DK, d = i % DK; const size_t r = (size_t)(row0 + t);
            qs[i] = bf2f(F.proj[r * NPROJ + qcol + d]); ks[i] = bf2f(F.proj[r * NPROJ + kcol + d]);
            if (GLA) { const float bc = F.bcum[r * 256 + h * 64 + d]; const float bp = t > 0 ? F.bcum[(r - 1) * 256 + h * 64 + d] : 0.f; as[i] = expf(bc - bp); }
        }
        for (int i = F.tid; i < 64 * 128; i += NTHREADS) { const int t = i >> 7, e = i & 127; vs[i] = bf2f(F.proj[(size_t)(row0 + t) * NPROJ + vcol + e]); }
        __syncthreads();
        if (F.tid < 128) {
            const int e = F.tid;
            for (int t = 0; t < 64; ++t) {
                const float v = vs[t * 128 + e]; float o = 0.f;
#pragma unroll
                for (int d = 0; d < DK; ++d) {
                    const float a = GLA ? as[t * DK + d] : gamma;
                    S[d] = a * S[d] + ks[t * DK + d] * v; o += qs[t * DK + d] * S[d];
                }
                vs[t * 128 + e] = o;
            }
        }
        __syncthreads();
        for (int tt = 0; tt < 8; ++tt) {
            const int t = F.wave * 8 + tt; const size_t r = (size_t)(row0 + t);
            const float o0 = vs[t * 128 + F.lane], o1 = vs[t * 128 + 64 + F.lane];
            float y0, y1;
            if (GLA) {
                const float rstd = 1.0f / sqrtf(wave_sum(o0 * o0 + o1 * o1) * (1.0f / 128.f) + EPS);
                y0 = o0 * rstd * F.gla_onorm[F.lane]; y1 = o1 * rstd * F.gla_onorm[64 + F.lane];
            } else {
                const float mu = wave_sum(o0 + o1) * (1.0f / 128.f); const float d0 = o0 - mu, d1 = o1 - mu;
                const float rstd = 1.0f / sqrtf(wave_sum(d0 * d0 + d1 * d1) * (1.0f / 128.f) + EPS);
                y0 = d0 * rstd * F.ret_onorm[F.lane]; y1 = d1 * rstd * F.ret_onorm[64 + F.lane];
            }
            y0 *= bf2f(F.proj[r * NPROJ + gcol + F.lane]); y1 *= bf2f(F.proj[r * NPROJ + gcol + 64 + F.lane]);
            const int oc = (GLA ? 0 : 512) + h * 128;
            F.obuf[r * D + oc + F.lane] = (bf16_t)f2bf(y0); F.obuf[r * D + oc + 64 + F.lane] = (bf16_t)f2bf(y1);
        }
        __syncthreads();
    }
}
DI void p3_la_naive(Frame& F) {
    { int t_ = threadIdx.x; asm volatile("" : "+v"(t_)); F.tid = t_; F.lane = t_ & 63; }
    for (int s = F.bid; s < 16; s += F.G) {
        const int type = s >> 3, b = (s >> 2) & 1, h = s & 3;
        if (type == 0) la_naive_stream<64, true>(F, b, h); else la_naive_stream<128, false>(F, b, h);
    }
}


typedef short s16x4 __attribute__((ext_vector_type(4)));
constexpr int LA_C = 128, LA_NC = SEQ / LA_C;
constexpr size_t U_RET_OFF = (size_t)8 * LA_NC * 128 * 64;
DI bf16x8 tr_pair(const LAS unsigned char* p0, const LAS unsigned char* p1) {
    const s16x4 lo = __builtin_amdgcn_ds_read_tr16_b64_v4i16((LAS s16x4*)p0);
    const s16x4 hi = __builtin_amdgcn_ds_read_tr16_b64_v4i16((LAS s16x4*)p1);
    return __builtin_shufflevector(lo, hi, 0, 1, 2, 3, 4, 5, 6, 7);
}
DI int slot_swap23(int t) { return (t & ~12) | ((t >> 1) & 4) | ((t << 1) & 8); }
DI float lg2_gamma(int h) { return log2f(1.0f - exp2f(-5.0f - (float)h)); }
DI bf16x8 scale8(u32x4 w, const float* f) {
    u32x4 o;
    o.x = cvt_pk_bf16(bflo(w.x) * f[0], bfhi(w.x) * f[1]); o.y = cvt_pk_bf16(bflo(w.y) * f[2], bfhi(w.y) * f[3]);
    o.z = cvt_pk_bf16(bflo(w.z) * f[4], bfhi(w.z) * f[5]); o.w = cvt_pk_bf16(bflo(w.w) * f[6], bfhi(w.w) * f[7]);
    return __builtin_bit_cast(bf16x8, o);
}
DI bf16x8 scale1(u32x4 w, float f) {
    u32x4 o;
    o.x = cvt_pk_bf16(bflo(w.x) * f, bfhi(w.x) * f); o.y = cvt_pk_bf16(bflo(w.y) * f, bfhi(w.y) * f);
    o.z = cvt_pk_bf16(bflo(w.z) * f, bfhi(w.z) * f); o.w = cvt_pk_bf16(bflo(w.w) * f, bfhi(w.w) * f);
    return __builtin_bit_cast(bf16x8, o);
}

template <int DK, int EB, bool GLA>
DI void la_pass1_unit(Frame& F, LAS unsigned char* wl, int b, int h, int n, int eh, bf16_t* Ubase) {
    int lane = F.lane; asm volatile("" : "+v"(lane), "+s"(n));
    const int g = lane >> 4, i16 = lane & 15, q = i16 >> 2, p = i16 & 3;
    constexpr int NDB = DK / 16, VCOLS = 16 * EB, VC = VCOLS / 8, KC = DK / 8, VI = 32 * VC / 64, KI = 32 * KC / 64;
    LAS unsigned char* vt = wl; LAS unsigned char* kt = wl + EB * 1024;
    const int r0 = b * SEQ + n * LA_C;
    const int kcol = GLA ? 256 + h * 64 : 2048 + h * 128, vcol = (GLA ? 512 : 2560) + h * 128 + eh * VCOLS, hd = h * 64;
    f32x4 acc[EB][NDB];
#pragma unroll
    for (int e = 0; e < EB; ++e)
#pragma unroll
        for (int d = 0; d < NDB; ++d) acc[e][d] = (f32x4){0.f, 0.f, 0.f, 0.f};
    const int kc = lane % KC, ktok = lane / KC, vch = lane % VC, vtok = lane / VC;
    float bl[8], b63[8]; const float lg2 = lg2_gamma(h);
    if (GLA) {
        const f32x4 a0 = *(const f32x4*)(F.bcum + (size_t)(r0 + 127) * 256 + hd + 8 * kc), a1 = *(const f32x4*)(F.bcum + (size_t)(r0 + 127) * 256 + hd + 8 * kc + 4);
        const f32x4 c0 = *(const f32x4*)(F.bcum + (size_t)(r0 + 63) * 256 + hd + 8 * kc), c1 = *(const f32x4*)(F.bcum + (size_t)(r0 + 63) * 256 + hd + 8 * kc + 4);
#pragma unroll
        for (int j = 0; j < 4; ++j) { bl[j] = a0[j]; bl[4 + j] = a1[j]; b63[j] = c0[j]; b63[4 + j] = c1[j]; }
    }
    if (GLA && eh == 0 && lane < KC) {
        float* dp = (float*)(F.ws + WS_DEC) + ((size_t)((b * 4 + h) * LA_NC + n) * 64) + 8 * kc;
        *(f32x4*)dp = (f32x4){__expf(bl[0] + b63[0]), __expf(bl[1] + b63[1]), __expf(bl[2] + b63[2]), __expf(bl[3] + b63[3])};
        *(f32x4*)(dp + 4) = (f32x4){__expf(bl[4] + b63[4]), __expf(bl[5] + b63[5]), __expf(bl[6] + b63[6]), __expf(bl[7] + b63[7])};
    }
    const int rbase = (((g >> 1) * 16 + (g & 1) * 4 + q) * 32) + 8 * p;
    u32x4 vr[VI], kr[KI]; f32x4 kbv[KI][2];
#define LA1_LOAD(step_) do { const int rs_ = r0 + 32 * (step_); \
        _Pragma("unroll") for (int i = 0; i < VI; ++i) vr[i] = *(const u32x4*)(F.proj + (size_t)(rs_ + vtok + i * (64 / VC)) * NPROJ + vcol + 8 * vch); \
        _Pragma("unroll") for (int i = 0; i < KI; ++i) { const size_t row = (size_t)(rs_ + ktok + i * (64 / KC)); kr[i] = *(const u32x4*)(F.proj + row * NPROJ + kcol + 8 * kc); \
            if (GLA) { kbv[i][0] = *(const f32x4*)(F.bcum + row * 256 + hd + 8 * kc); kbv[i][1] = *(const f32x4*)(F.bcum + row * 256 + hd + 8 * kc + 4); } } } while (0)
    LA1_LOAD(0);
#pragma unroll 1
    for (int step = 0; step < 4; ++step) {
#pragma unroll
        for (int i = 0; i < VI; ++i) { const int tau = vtok + i * (64 / VC); *(LAS u32x4*)(vt + (vch >> 1) * 1024 + slot_swap23(tau) * 32 + (vch & 1) * 16) = vr[i]; }
#pragma unroll
        for (int i = 0; i < KI; ++i) {
            const int tau = ktok + i * (64 / KC), t = 32 * step + tau;
            bf16x8 o;
            if (GLA) {
                float f[8];
#pragma unroll
                for (int j = 0; j < 8; ++j) f[j] = __expf(bl[j] - kbv[i][j >> 2][j & 3] + (t < 64 ? b63[j] : 0.f));
                o = scale8(kr[i], f);
            } else {
                o = scale1(kr[i], exp2f((float)(127 - t) * lg2));
            }
            *(LAS bf16x8*)(kt + (kc >> 1) * 1024 + slot_swap23(tau) * 32 + (kc & 1) * 16) = o;
        }
        if (step < 3) LA1_LOAD(step + 1);
        bf16x8 af[EB], bfr[NDB];
#pragma unroll
        for (int e = 0; e < EB; ++e) af[e] = tr_pair(vt + e * 1024 + rbase, vt + e * 1024 + rbase + 256);
#pragma unroll
        for (int d = 0; d < NDB; ++d) bfr[d] = tr_pair(kt + d * 1024 + rbase, kt + d * 1024 + rbase + 256);
#pragma unroll
        for (int e = 0; e < EB; ++e)
#pragma unroll
            for (int d = 0; d < NDB; ++d) acc[e][d] = __builtin_amdgcn_mfma_f32_16x16x32_bf16(bfr[d], af[e], acc[e][d], 0, 0, 0);
    }
#undef LA1_LOAD
    bf16_t* U = Ubase + (size_t)n * 128 * DK;
#pragma unroll
    for (int e = 0; e < EB; ++e)
#pragma unroll
        for (int d = 0; d < NDB; ++d)
            { u32x2 w; w.x = cvt_pk_bf16(acc[e][d][0], acc[e][d][1]); w.y = cvt_pk_bf16(acc[e][d][2], acc[e][d][3]);
              *(u32x2*)(U + (size_t)(eh * VCOLS + 16 * e + i16) * DK + 16 * d + 4 * g) = w; }
}

DI void p3_la_pass1(Frame& F) {
    { int t_ = threadIdx.x; asm volatile("" : "+v"(t_)); F.tid = t_; F.lane = t_ & 63; }
    LAS unsigned char* wl = F.lds + F.wave * 16384;
    const int gw = F.bid * NWAVES + F.wave, NGW = F.G * NWAVES;
    bf16_t* Ug = (bf16_t*)(F.ws + WS_U); bf16_t* Ur = Ug + U_RET_OFF;
    for (int u = gw; u < 2048 + 4096; u += NGW) {
        if (u < 2048) { const int eh = u & 1, n = (u >> 1) & 127, st = u >> 8; la_pass1_unit<64, 4, true>(F, wl, st >> 2, st & 3, n, eh, Ug + (size_t)st * LA_NC * 128 * 64); }
        else { const int v = u - 2048, eh = v & 3, n = (v >> 2) & 127, st = v >> 9; la_pass1_unit<128, 2, false>(F, wl, st >> 2, st & 3, n, eh, Ur + (size_t)st * LA_NC * 128 * 128); }
    }
}

DI void p4_la_scan(Frame& F) {
    { int t_ = threadIdx.x; asm volatile("" : "+v"(t_)); F.tid = t_; F.lane = t_ & 63; }
    const bf16_t* Ug = (const bf16_t*)(F.ws + WS_U); bf16_t* Sg = (bf16_t*)(F.ws + WS_SP);
    if (F.tid >= 384) { if (F.G == 256) tr_range(F, (LAS float*)(F.lds + 16384 + F.wave * 8704), TR_SPLIT2, TR_NITEMS, F.bid * 2 + (F.wave - 6), F.G * 2); return; }
    for (int it = F.bid * 384 + F.tid; it < 32768 + 65536; it += F.G * 384) {
        const bool gla = it < 32768;
        int st, e, d2, DK; size_t base;
        if (gla) { st = it >> 12; const int idx = it & 4095; e = idx >> 5; d2 = idx & 31; DK = 64; base = (size_t)st * LA_NC * 128 * 64; }
        else { const int v = it - 32768; st = v >> 13; const int idx = v & 8191; e = idx >> 6; d2 = idx & 63; DK = 128; base = U_RET_OFF + (size_t)st * LA_NC * 128 * 128; }
        const int b = st >> 2, h = st & 3;
        const size_t cstride = (size_t)128 * DK;
        const bf16_t* up = Ug + base + (size_t)e * DK + 2 * d2;
        bf16_t* sp = Sg + base + (size_t)e * DK + 2 * d2;
        const float* bc = (const float*)(F.ws + WS_DEC) + (size_t)(st & 7) * LA_NC * 64 + 2 * d2;
        const float dr = exp2f(128.0f * lg2_gamma(h));
        float s0 = 0.f, s1 = 0.f;
        unsigned uv[16], un[16]; f32x2 dv[16], dn[16];
#define LA4_LOAD(U_, D_, n0_) do { _Pragma("unroll") for (int j = 0; j < 16; ++j) { \
            U_[j] = *(const unsigned*)(up + (size_t)((n0_) + j) * cstride); \
            if (gla) D_[j] = *(const f32x2*)(bc + (size_t)((n0_) + j) * 64); } } while (0)
#define LA4_STEP(U_, D_, n0_) do { _Pragma("unroll") for (int j = 0; j < 16; ++j) { \
            *(unsigned*)(sp + (size_t)((n0_) + j) * cstride) = pk2(s0, s1); \
            const float d0 = gla ? D_[j].x : dr, d1 = gla ? D_[j].y : dr; \
            s0 = d0 * s0 + bflo(U_[j]); s1 = d1 * s1 + bfhi(U_[j]); } } while (0)
        LA4_LOAD(uv, dv, 0);
#pragma unroll 1
        for (int n0 = 0; n0 < LA_NC; n0 += 32) {
            LA4_LOAD(un, dn, n0 + 16);
            LA4_STEP(uv, dv, n0);
            if (n0 + 32 < LA_NC) LA4_LOAD(uv, dv, n0 + 32);
            LA4_STEP(un, dn, n0 + 16);
        }
#undef LA4_LOAD
#undef LA4_STEP
    }
}

template <int DK, bool GLA>
DI void la_pass3_unit(Frame& F, LAS unsigned char* wl, int b, int h, int n, int tq, const bf16_t* SpBase) {
    int lane = F.lane; asm volatile("" : "+v"(lane), "+s"(n), "+s"(tq));
    const int g = lane >> 4, i16 = lane & 15, q = i16 >> 2, p = i16 & 3;
    constexpr int NKS = DK / 32;
    const int r0 = b * SEQ + n * LA_C, t0 = 32 * tq, hd = h * 64;
    const int qcol = GLA ? h * 64 : 1536 + h * 128, kcol = GLA ? 256 + h * 64 : 2048 + h * 128, vcol = (GLA ? 512 : 2560) + h * 128, gcol = (GLA ? 1024 : 3072) + h * 128, ocol = (GLA ? 0 : 512) + h * 128;
    const float lg2 = lg2_gamma(h);
    u32x4 qraw[2][NKS]; f32x4 qb[2][NKS][2]; f32x4 c63[NKS][2];
    u32x4 kraw[2][NKS]; f32x4 kb[2][NKS][2]; u32x4 vraw[8];
#pragma unroll
    for (int tb = 0; tb < 2; ++tb)
#pragma unroll
        for (int ks = 0; ks < NKS; ++ks) {
            const size_t row = (size_t)(r0 + t0 + 16 * tb + i16);
            qraw[tb][ks] = *(const u32x4*)(F.proj + row * NPROJ + qcol + 32 * ks + 8 * g);
            if (GLA) { const float* bp = F.bcum + row * 256 + hd + 32 * ks + 8 * g; qb[tb][ks][0] = *(const f32x4*)bp; qb[tb][ks][1] = *(const f32x4*)(bp + 4); }
        }
    if (GLA) {
#pragma unroll
        for (int ks = 0; ks < NKS; ++ks) { const float* cp = F.bcum + (size_t)(r0 + 63) * 256 + hd + 32 * ks + 8 * g; c63[ks][0] = *(const f32x4*)cp; c63[ks][1] = *(const f32x4*)(cp + 4); }
    }
#define LA3_LOAD_KV(sp_) do { const int rs_ = r0 + 32 * (sp_); \
        _Pragma("unroll") for (int sb = 0; sb < 2; ++sb) _Pragma("unroll") for (int ks = 0; ks < NKS; ++ks) { const size_t row = (size_t)(rs_ + 16 * sb + i16); \
            kraw[sb][ks] = *(const u32x4*)(F.proj + row * NPROJ + kcol + 32 * ks + 8 * g); \
            if (GLA) { const float* bp = F.bcum + row * 256 + hd + 32 * ks + 8 * g; kb[sb][ks][0] = *(const f32x4*)bp; kb[sb][ks][1] = *(const f32x4*)(bp + 4); } } \
        _Pragma("unroll") for (int i = 0; i < 8; ++i) vraw[i] = *(const u32x4*)(F.proj + (size_t)(rs_ + (lane >> 4) + 4 * i) * NPROJ + vcol + 8 * (lane & 15)); } while (0)
    LA3_LOAD_KV(0);
    bf16x8 qf[2][NKS];
#pragma unroll
    for (int tb = 0; tb < 2; ++tb)
#pragma unroll
        for (int ks = 0; ks < NKS; ++ks) {
            if (GLA) {
                float f[8];
#pragma unroll
                for (int j = 0; j < 8; ++j) f[j] = __expf(qb[tb][ks][j >> 2][j & 3] + (t0 >= 64 ? c63[ks][j >> 2][j & 3] : 0.f));
                qf[tb][ks] = scale8(qraw[tb][ks], f);
            } else qf[tb][ks] = scale1(qraw[tb][ks], exp2f((float)(t0 + 16 * tb + i16 + 1) * lg2));
        }
    f32x4 o[2][8];
#pragma unroll
    for (int tb = 0; tb < 2; ++tb)
#pragma unroll
        for (int eb = 0; eb < 8; ++eb) o[tb][eb] = (f32x4){0.f, 0.f, 0.f, 0.f};
    const int vbase = (4 * g + q) * 32 + 8 * p;
#pragma unroll 1
    for (int sp = 0; sp <= tq; ++sp) {
#pragma unroll
        for (int i = 0; i < 8; ++i) { const int tau = (lane >> 4) + 4 * i, ch = lane & 15; *(LAS u32x4*)(wl + (ch >> 1) * 1024 + tau * 32 + (ch & 1) * 16) = vraw[i]; }
        bf16x8 kf[2][NKS];
#pragma unroll
        for (int sb = 0; sb < 2; ++sb)
#pragma unroll
            for (int ks = 0; ks < NKS; ++ks) {
                if (GLA) {
                    float f[8];
#pragma unroll
                    for (int j = 0; j < 8; ++j) f[j] = __expf(-(kb[sb][ks][j >> 2][j & 3] + (sp >= 2 ? c63[ks][j >> 2][j & 3] : 0.f)));
                    kf[sb][ks] = scale8(kraw[sb][ks], f);
                } else kf[sb][ks] = scale1(kraw[sb][ks], exp2f(-(float)(32 * sp + 16 * sb + i16 + 1) * lg2));
            }
        if (sp < tq) LA3_LOAD_KV(sp + 1);
        bf16x8 pf[2];
#pragma unroll
        for (int tb = 0; tb < 2; ++tb) {
            const int T = 2 * tq + tb;
            f32x4 s0 = (f32x4){0.f, 0.f, 0.f, 0.f}, s1 = s0;
#pragma unroll
            for (int ks = 0; ks < NKS; ++ks) {
                s0 = __builtin_amdgcn_mfma_f32_16x16x32_bf16(kf[0][ks], qf[tb][ks], s0, 0, 0, 0);
                s1 = __builtin_amdgcn_mfma_f32_16x16x32_bf16(kf[1][ks], qf[tb][ks], s1, 0, 0, 0);
            }
            const int S0 = 2 * sp, S1 = 2 * sp + 1;
#pragma unroll
            for (int r = 0; r < 4; ++r) {
                const bool keep = (4 * g + r) <= i16;
                if (S0 == T && !keep) s0[r] = 0.f;
                if (S1 > T || (S1 == T && !keep)) s1[r] = 0.f;
            }
            u32x4 pw_; pw_.x = cvt_pk_bf16(s0[0], s0[1]); pw_.y = cvt_pk_bf16(s0[2], s0[3]); pw_.z = cvt_pk_bf16(s1[0], s1[1]); pw_.w = cvt_pk_bf16(s1[2], s1[3]);
            pf[tb] = __builtin_bit_cast(bf16x8, pw_);
        }
#pragma unroll
        for (int eb = 0; eb < 8; ++eb) {
            const bf16x8 vf = tr_pair(wl + eb * 1024 + vbase, wl + eb * 1024 + vbase + 512);
            o[0][eb] = __builtin_amdgcn_mfma_f32_16x16x32_bf16(pf[0], vf, o[0][eb], 0, 0, 0);
            o[1][eb] = __builtin_amdgcn_mfma_f32_16x16x32_bf16(pf[1], vf, o[1][eb], 0, 0, 0);
        }
    }
#undef LA3_LOAD_KV
    u32x4 gt[8];
#pragma unroll
    for (int i = 0; i < 8; ++i) gt[i] = *(const u32x4*)(F.proj + (size_t)(r0 + t0 + 4 * i + (lane >> 4)) * NPROJ + gcol + 8 * (lane & 15));
    const bf16_t* Sp = SpBase + (size_t)n * 128 * DK;
#pragma unroll
    for (int eb = 0; eb < 8; ++eb)
#pragma unroll
        for (int ks = 0; ks < NKS; ++ks) {
            const bf16x8 sf = *(const bf16x8*)(Sp + (size_t)(16 * eb + i16) * DK + 32 * ks + 8 * g);
            o[0][eb] = __builtin_amdgcn_mfma_f32_16x16x32_bf16(qf[0][ks], sf, o[0][eb], 0, 0, 0);
            o[1][eb] = __builtin_amdgcn_mfma_f32_16x16x32_bf16(qf[1][ks], sf, o[1][eb], 0, 0, 0);
        }
#pragma unroll
    for (int tb = 0; tb < 2; ++tb)
#pragma unroll
        for (int r = 0; r < 4; ++r) {
            float mu = 0.f;
            if (!GLA) {
                float s = 0.f;
#pragma unroll
                for (int eb = 0; eb < 8; ++eb) s += o[tb][eb][r];
                s = row16_sum(s);
                mu = s * (1.0f / 128.f);
            }
            float ss = 0.f;
#pragma unroll
            for (int eb = 0; eb < 8; ++eb) { const float dlt = o[tb][eb][r] - mu; o[tb][eb][r] = dlt; ss += dlt * dlt; }
            ss = row16_sum(ss);
            const float rstd = __builtin_amdgcn_rsqf(ss * (1.0f / 128.f) + EPS);
#pragma unroll
            for (int eb = 0; eb < 8; ++eb) *(LAS float*)(wl + ((16 * tb + 4 * g + r) * 128 + 16 * eb + i16) * 4) = o[tb][eb][r] * rstd;
        }
    {
        const int ch = lane & 15; const float* onw = (GLA ? F.gla_onorm : F.ret_onorm) + 8 * ch;
        const f32x4 w0 = *(const f32x4*)onw, w1 = *(const f32x4*)(onw + 4);
#pragma unroll
        for (int i = 0; i < 8; ++i) {
            const int t = 4 * i + (lane >> 4); const size_t row = (size_t)(r0 + t0 + t);
            const f32x4 y0 = *(const LAS f32x4*)(wl + (t * 128 + 8 * ch) * 4), y1 = *(const LAS f32x4*)(wl + (t * 128 + 8 * ch + 4) * 4);
            const u32x4 gg = gt[i];
            float ov[8];
            ov[0] = y0[0] * w0[0] * bflo(gg.x); ov[1] = y0[1] * w0[1] * bfhi(gg.x); ov[2] = y0[2] * w0[2] * bflo(gg.y); ov[3] = y0[3] * w0[3] * bfhi(gg.y);
            ov[4] = y1[0] * w1[0] * bflo(gg.z); ov[5] = y1[1] * w1[1] * bfhi(gg.z); ov[6] = y1[2] * w1[2] * bflo(gg.w); ov[7] = y1[3] * w1[3] * bfhi(gg.w);
            store8_bf16(F.obuf + row * D + ocol + 8 * ch, ov);
        }
    }
}

DI void p5_la_pass3(Frame& F) {
    { int t_ = threadIdx.x; asm volatile("" : "+v"(t_)); F.tid = t_; F.lane = t_ & 63; }
    LAS unsigned char* wl = F.lds + F.wave * 16384;
    const int gw = F.bid * NWAVES + F.wave, NGW = F.G * NWAVES;
    const bf16_t* Sg = (const bf16_t*)(F.ws + WS_SP); const bf16_t* Sr = Sg + U_RET_OFF;
    const int ntask_round = NGW >> 2;
#pragma unroll 1
    for (int i = 0; i * ntask_round < 2048; ++i) {
        const int task = i * ntask_round + (gw >> 2); if (task >= 2048) break;
        const int tq = (gw + i) & 3, type = task & 1, idx = task >> 1, st = idx >> 7, n = idx & 127;
        if (type == 0) la_pass3_unit<64, true>(F, wl, st >> 2, st & 3, n, tq, Sg + (size_t)st * LA_NC * 128 * 64);
        else la_pass3_unit<128, false>(F, wl, st >> 2, st & 3, n, tq, Sr + (size_t)st * LA_NC * 128 * 128);
    }
}

#define DPPF(v, ctrl) __builtin_bit_cast(float, __builtin_amdgcn_update_dpp(__builtin_bit_cast(int, v), __builtin_bit_cast(int, v), ctrl, 0xf, 0xf, false))
DI float row16_max(float v) {
    v = fmaxf(v, DPPF(v, 0xB1)); v = fmaxf(v, DPPF(v, 0x4E)); v = fmaxf(v, DPPF(v, 0x141)); v = fmaxf(v, DPPF(v, 0x140)); return v;
}
DI void p7_router(Frame& F) {
    { int t_ = threadIdx.x; asm volatile("" : "+v"(t_)); F.tid = t_; F.lane = t_ & 63; }
    constexpr int RS = 2064;
    LAS unsigned char* hh = F.lds;
    LAS unsigned char* hlo = F.lds + 16 * RS;
    LAS float* part = (LAS float*)(F.lds + 69632);
    LAS int* hist = (LAS int*)(F.lds + 98304);
    LAS int* basearr = hist + 32;
    LAS int* pinfo = hist + 64;
    LAS float* pwl = (LAS float*)(pinfo + 512);
    const int e = F.lane & 31, g = F.lane >> 4, i16 = F.lane & 15;
    for (int rb = F.bid; rb < M / 128; rb += F.G) {
        const int row0 = rb * 128, b = row0 >= SEQ;
        bf16x8 wh[4][2], wl[4][2];
#pragma unroll
        for (int ks = 0; ks < 4; ++ks)
#pragma unroll
            for (int eb = 0; eb < 2; ++eb) {
                const float* wp = F.w_router + (size_t)(128 * F.wave + 32 * ks + 8 * g) * NE + 16 * eb + i16;
                float w[8];
#pragma unroll
                for (int j = 0; j < 8; ++j) w[j] = wp[j * NE];
                u32x4 hi, lo;
                hi.x = pk2(w[0], w[1]); hi.y = pk2(w[2], w[3]); hi.z = pk2(w[4], w[5]); hi.w = pk2(w[6], w[7]);
                lo.x = pk2(w[0] - bflo(hi.x), w[1] - bfhi(hi.x)); lo.y = pk2(w[2] - bflo(hi.y), w[3] - bfhi(hi.y));
                lo.z = pk2(w[4] - bflo(hi.z), w[5] - bfhi(hi.z)); lo.w = pk2(w[6] - bflo(hi.w), w[7] - bfhi(hi.w));
                wh[ks][eb] = __builtin_bit_cast(bf16x8, hi); wl[ks][eb] = __builtin_bit_cast(bf16x8, lo);
            }
        f32x4 cs[4], sh[4];
#pragma unroll
        for (int j = 0; j < 4; ++j) {
            const f32x4 w = ((const f32x4*)F.norm2)[F.lane + 64 * j], sc = ((const f32x4*)(F.mod + b * 6144 + 4096))[F.lane + 64 * j];
            cs[j] = w * (sc + 1.0f); sh[j] = ((const f32x4*)(F.mod + b * 6144 + 3072))[F.lane + 64 * j];
        }
        const float brt = F.b_router[e];
        if (F.tid < 32) hist[F.tid] = 0;
        f32x4 va[4], vb[4];
#if X1_BF16
        { const u32x2* xa = (const u32x2*)((const bf16_t*)F.x1 + (size_t)(row0 + 2 * F.wave) * D) + F.lane;
#pragma unroll
          for (int j = 0; j < 4; ++j) { va[j] = bf4_to_f32(xa[64 * j]); vb[j] = bf4_to_f32(xa[256 + 64 * j]); } }
#else
        { const f32x4* xa = (const f32x4*)(F.x1 + (size_t)(row0 + 2 * F.wave) * D) + F.lane;
#pragma unroll
          for (int j = 0; j < 4; ++j) { va[j] = xa[64 * j]; vb[j] = xa[256 + 64 * j]; } }
#endif
        __syncthreads();
#pragma unroll 1
        for (int batch = 0; batch < 8; ++batch) {
            {
                const int rl0 = 2 * F.wave, rowa = row0 + batch * 16 + rl0;
                float sa = 0.f, sb = 0.f;
#pragma unroll
                for (int j = 0; j < 4; ++j) { sa += (va[j].x * va[j].x + va[j].y * va[j].y) + (va[j].z * va[j].z + va[j].w * va[j].w); sb += (vb[j].x * vb[j].x + vb[j].y * vb[j].y) + (vb[j].z * vb[j].z + vb[j].w * vb[j].w); }
                const float ra = __builtin_amdgcn_rsqf(wave_sum(sa) * (1.0f / D) + EPS), rbb = __builtin_amdgcn_rsqf(wave_sum(sb) * (1.0f / D) + EPS);
#if MOE_FP8
                unsigned* oa = (unsigned*)((unsigned char*)F.hbuf + (size_t)rowa * D) + F.lane;
#else
                u32x2* oa = (u32x2*)(F.hbuf + (size_t)rowa * D) + F.lane;
#endif
#pragma unroll
                for (int j = 0; j < 4; ++j) {
                    const f32x4 ha = va[j] * ra * cs[j] + sh[j], hb = vb[j] * rbb * cs[j] + sh[j];
#if MOE_FP8
                    oa[64 * j] = pk4_fp8(ha.x * H8_SCALE, ha.y * H8_SCALE, ha.z * H8_SCALE, ha.w * H8_SCALE);
                    oa[256 + 64 * j] = pk4_fp8(hb.x * H8_SCALE, hb.y * H8_SCALE, hb.z * H8_SCALE, hb.w * H8_SCALE);
#else
                    u32x2 p; p.x = pk2(ha.x, ha.y); p.y = pk2(ha.z, ha.w); oa[64 * j] = p;
                    p.x = pk2(hb.x, hb.y); p.y = pk2(hb.z, hb.w); oa[256 + 64 * j] = p;
#endif
                    u32x2 h1, l1, h2_, l2_;
                    h1.x = pk2(ha.x, ha.y); h1.y = pk2(ha.z, ha.w); l1.x = pk2(ha.x - bflo(h1.x), ha.y - bfhi(h1.x)); l1.y = pk2(ha.z - bflo(h1.y), ha.w - bfhi(h1.y));
                    h2_.x = pk2(hb.x, hb.y); h2_.y = pk2(hb.z, hb.w); l2_.x = pk2(hb.x - bflo(h2_.x), hb.y - bfhi(h2_.x)); l2_.y = pk2(hb.z - bflo(h2_.y), hb.w - bfhi(h2_.y));
                    const int co = (4 * F.lane + 256 * j) * 2;
                    *(LAS u32x2*)(hh + rl0 * RS + co) = h1; *(LAS u32x2*)(hlo + rl0 * RS + co) = l1;
                    *(LAS u32x2*)(hh + (rl0 + 1) * RS + co) = h2_; *(LAS u32x2*)(hlo + (rl0 + 1) * RS + co) = l2_;
                }
                if (batch < 7) {
#if X1_BF16
                    const u32x2* xn = (const u32x2*)((const bf16_t*)F.x1 + (size_t)(rowa + 16) * D) + F.lane;
#pragma unroll
                    for (int j = 0; j < 4; ++j) { va[j] = bf4_to_f32(xn[64 * j]); vb[j] = bf4_to_f32(xn[256 + 64 * j]); }
#else
                    const f32x4* xn = (const f32x4*)(F.x1 + (size_t)(rowa + 16) * D) + F.lane;
#pragma unroll
                    for (int j = 0; j < 4; ++j) { va[j] = xn[64 * j]; vb[j] = xn[256 + 64 * j]; }
#endif
                }
            }
            __syncthreads();
            {
                f32x4 acc0 = (f32x4){0.f, 0.f, 0.f, 0.f}, acc1 = acc0;
#pragma unroll
                for (int ks = 0; ks < 4; ++ks) {
                    const int off = i16 * RS + (128 * F.wave + 32 * ks + 8 * g) * 2;
                    const bf16x8 ah = *(const LAS bf16x8*)(hh + off), al = *(const LAS bf16x8*)(hlo + off);
                    acc0 = __builtin_amdgcn_mfma_f32_16x16x32_bf16(ah, wh[ks][0], acc0, 0, 0, 0);
                    acc0 = __builtin_amdgcn_mfma_f32_16x16x32_bf16(ah, wl[ks][0], acc0, 0, 0, 0);
                    acc0 = __builtin_amdgcn_mfma_f32_16x16x32_bf16(al, wh[ks][0], acc0, 0, 0, 0);
                    acc1 = __builtin_amdgcn_mfma_f32_16x16x32_bf16(ah, wh[ks][1], acc1, 0, 0, 0);
                    acc1 = __builtin_amdgcn_mfma_f32_16x16x32_bf16(ah, wl[ks][1], acc1, 0, 0, 0);
                    acc1 = __builtin_amdgcn_mfma_f32_16x16x32_bf16(al, wh[ks][1], acc1, 0, 0, 0);
                }
#pragma unroll
                for (int r = 0; r < 4; ++r) { part[((4 * g + r) * 8 + F.wave) * 32 + i16] = acc0[r]; part[((4 * g + r) * 8 + F.wave) * 32 + 16 + i16] = acc1[r]; }
            }
            __syncthreads();
#pragma unroll
            for (int rr = 0; rr < 2; ++rr) {
                const int rl = 2 * F.wave + rr, rloc = batch * 16 + rl;
                float val = brt;
#pragma unroll
                for (int p = 0; p < 8; ++p) val += part[(rl * 8 + p) * 32 + e];
                if (F.lane >= 32) val = -INFINITY;
                int sel[4]; float sv[4];
#pragma unroll
                for (int k = 0; k < 4; ++k) {
                    const float rm = row16_max(val);
                    const float mx = fmaxf(__builtin_bit_cast(float, __builtin_amdgcn_readlane(__builtin_bit_cast(int, rm), 0)), __builtin_bit_cast(float, __builtin_amdgcn_readlane(__builtin_bit_cast(int, rm), 16)));
                    const unsigned long long bal = __ballot(val == mx && F.lane < 32);
                    const int idx = bal ? (int)__builtin_ctzll(bal) : 0;
                    sel[k] = idx; sv[k] = mx;
                    if (F.lane == idx) val = -INFINITY;
                }
                const float e1 = __expf(sv[1] - sv[0]), e2 = __expf(sv[2] - sv[0]), e3 = __expf(sv[3] - sv[0]);
                const float inv = 1.0f / (1.0f + e1 + e2 + e3);
                if (F.lane < 4) {
                    const int k = F.lane;
                    const int se = k == 0 ? sel[0] : k == 1 ? sel[1] : k == 2 ? sel[2] : sel[3];
                    const float wv = (k == 0 ? 1.0f : k == 1 ? e1 : k == 2 ? e2 : e3) * inv;
                    const int lr = __hip_atomic_fetch_add(hist + se, 1, __ATOMIC_RELAXED, __HIP_MEMORY_SCOPE_WORKGROUP);
                    pinfo[rloc * 4 + k] = se | (lr << 8);
                    pwl[rloc * 4 + k] = wv;
                }
            }
            __syncthreads();
        }
        if (F.tid < 32) basearr[F.tid] = (int)atomicAdd(F.ctl + CW_CNT + 64 * F.tid, (unsigned)hist[F.tid]);
        __syncthreads();
        { const int info = pinfo[F.tid], ee = info & 255, lr = info >> 8; u32x2 rec; rec.x = (unsigned)(row0 * 4 + F.tid); rec.y = __builtin_bit_cast(unsigned, pwl[F.tid]); F.perm[(size_t)ee * ECAP + basearr[ee] + lr] = rec; }
        __syncthreads();
    }
}

DI void moe_order(Frame& F, pg8::MoeOrder& S, int NT, const void* Bt, size_t bstride, int ebytes, int sa, int sb) {
    LAS int* mi = (LAS int*)(F.lds + MISC_OFF);
    LAS int* ud = (LAS int*)(F.lds + UD_OFF);
    if (F.tid < 32) mi[F.tid] = (int)F.ctl[CW_CNT + 64 * F.tid];
    __syncthreads();
    if (F.tid == 0) { int o = 0, tp = 0; for (int i = 0; i < NE; ++i) { mi[32 + i] = o; mi[64 + i] = tp; o += mi[i]; tp += (mi[i] + 255) >> 8; } mi[96] = tp; }
    __syncthreads();
    const int x = F.bid & 7, JB = F.G >> 3, j = F.bid >> 3;
    const int ptot = mi[96], lo = ptot * x / 8, hi = ptot * (x + 1) / 8, U = (hi - lo) * NT;
    const int R = U / JB, tail = U - R * JB, split = (tail > 0 && 2 * tail <= JB) ? 1 : 0;
    int nu = R;
    if (split) { if (j < 2 * tail) nu = R + 1; } else if (j < tail) nu = R + 1;
    if (F.tid < 64 && F.tid < nu) {
        const int i = F.tid, half = (split && i == R) ? (j & 1) : 0;
        const int q = (split && i == R) ? R * JB + (j >> 1) : j + i * JB;
        const int pl = q / NT, pn = q % NT, g = lo + pl;
        int e = 0;
        for (int k = 1; k < NE; ++k) e += (mi[64 + k] <= g) ? 1 : 0;
        const int p = g - mi[64 + e], left = mi[e] - p * 256;
        int rows = left < 256 ? left : 256, r0 = 0;
        if (split && i == R) { r0 = 128 * half; rows = half ? rows - 128 : (rows < 128 ? rows : 128); if (rows < 0) rows = 0; }
        i32x4_ r; r.x = e | (pn << 8) | (((pn + 2 * pl) & 7) << 16); r.y = rows; r.z = mi[32 + e] + p * 256 + r0; r.w = e * ECAP + p * 256 + r0;
        *(LAS i32x4_*)(ud + 4 * i) = r;
    }
    __syncthreads();
    S.n = __builtin_amdgcn_readfirstlane(nu < 64 ? nu : 64); S.ud = ud; S.Bt = Bt; S.bstride = bstride; S.ebytes = ebytes; S.sa = sa; S.sb = sb;
}
struct MoeBatch {
    pg8::MoeOrder S; int i0, n;
    DI bool next(int i, pg8::Unit& u) const { if (i >= n) return false; return S.next(i0 + i, u); }
    DI const char* bptr(const pg8::Unit& u) const { return S.bptr(u); }
    DI int scale_a() const { return S.sa; }
    DI int scale_b() const { return S.sb; }
};

DI void p8_gu(Frame& F) {
    { int t_ = threadIdx.x; asm volatile("" : "+v"(t_)); F.tid = t_; F.lane = t_ & 63; }
    pg8::MoeOrder S; moe_order(F, S, 8, F.wgu_t, (size_t)2048 * D, MOE_FP8 ? 1 : 2, H8_E8M0, W8_E8M0);
    LAS unsigned* tbl = (LAS unsigned*)(F.lds + TBL_OFF);
    EpiGU E{F.b_gu, F.act};
    for (int i0 = 0;; i0 += TBL_UNITS) {
        pg8::Unit u; if (!S.next(i0, u)) break;
        int n;
        {
            int t_ = threadIdx.x; asm volatile("" : "+v"(t_));
            const int ln = t_ & 63, half = __builtin_amdgcn_readfirstlane(t_ >> 8), idx = t_ & 255;
            pg8::Unit uk; uk.prow0 = 0; uk.rows = 0;
            const bool ok = ln < TBL_UNITS && S.next_lane(i0 + ln, uk);
            n = __builtin_popcountll(__ballot(ok));
            const int pv = ok ? uk.prow0 : 0, rv = ok ? uk.rows : 0;
            unsigned pr[TBL_UNITS / 2];
#pragma unroll
            for (int it = 0; it < TBL_UNITS / 2; ++it) {
                const int k = 2 * it + half; pr[it] = 0u;
                if (k < n) { const int p0 = __builtin_amdgcn_readlane(pv, k), rw = __builtin_amdgcn_readlane(rv, k); if (rw > 0) pr[it] = F.perm[p0 + (idx < rw ? idx : 0)].x; }
            }
#pragma unroll
            for (int it = 0; it < TBL_UNITS / 2; ++it) { const int k = 2 * it + half; if (k < n) tbl[k * 256 + idx] = (pr[it] >> 2) * (unsigned)(D * (MOE_FP8 ? 1 : 2)); }
        }
        __syncthreads();
        MoeBatch Bt{S, i0, n};
        pg8::gemm_phase<EpiGU, MoeBatch, true, (MOE_FP8 != 0), false, true>(F.lds, F.hbuf, Bt, E, tbl);
        __syncthreads();
    }
}
DI void p9_down(Frame& F) {
    { int t_ = threadIdx.x; asm volatile("" : "+v"(t_)); F.tid = t_; F.lane = t_ & 63; }
    pg8::MoeOrder S; moe_order(F, S, 4, F.wd_t, (size_t)D * D, MOE_FP8 ? 1 : 2, A8_E8M0, W8_E8M0);
    LAS unsigned* tbl = (LAS unsigned*)(F.lds + TBL_OFF);
    EpiDown E{F.b_down, F.perm, F.Y};
    for (int i0 = 0;; i0 += TBL_UNITS) {
        pg8::Unit u; if (!S.next(i0, u)) break;
        int n = 0;
        for (; n < TBL_UNITS; ++n) {
            if (!S.next(i0 + n, u)) break;
            int t_ = threadIdx.x; asm volatile("" : "+v"(t_));
            if (t_ < 256) tbl[n * 256 + t_] = (unsigned)(u.arow0 + t_) * (unsigned)(D * (MOE_FP8 ? 1 : 2));
        }
        __syncthreads();
        MoeBatch Bt{S, i0, n};
        pg8::gemm_phase<EpiDown, MoeBatch, true, (MOE_FP8 != 0), true, true>(F.lds, F.act, Bt, E, tbl);
        __syncthreads();
    }
}

DI void p10_final(Frame& F) {
    { int t_ = threadIdx.x; asm volatile("" : "+v"(t_)); F.tid = t_; F.lane = t_ & 63; }
    const int gw = F.bid * NWAVES + F.wave, NGW = F.G * NWAVES;
    f32x4 xv[4], xn[4]; int yv[4][4], yn[4][4];
#if X1_BF16
#define P10_XLOAD(xr_, j_) bf4_to_f32(__builtin_nontemporal_load((const u32x2*)((const bf16_t*)(xr_)) + F.lane + 64 * (j_)))
#else
#define P10_XLOAD(xr_, j_) __builtin_nontemporal_load((const f32x4*)(xr_) + F.lane + 64 * (j_))
#endif
#define P10_LOAD(X_, Y_, m_) do { const void* xr_ = X1_BF16 ? (const void*)((const bf16_t*)F.x1 + (size_t)(m_) * D) : (const void*)(F.x1 + (size_t)(m_) * D); \
        _Pragma("unroll") for (int j = 0; j < 4; ++j) { X_[j] = P10_XLOAD(xr_, j); \
            _Pragma("unroll") for (int k = 0; k < 4; ++k) Y_[j][k] = __builtin_nontemporal_load((const int*)((const unsigned char*)F.Y + ((size_t)(m_) * 4 + k) * D * (Y_FP8 ? 1 : 2)) + F.lane + 64 * j); } } while (0)
    static_assert(Y_FP8, "p10_final reads fp8 rows");
    if (gw < M) P10_LOAD(xv, yv, gw);
    for (int m = gw; m < M; m += NGW) {
        const int b = m >= SEQ;
        if (m + NGW < M) P10_LOAD(xn, yn, m + NGW);
        const f32x4* gr = (const f32x4*)(F.mod + b * 6144 + 5120) + F.lane;
        f32x4 v[4]; float s = 0.f;
#pragma unroll
        for (int j = 0; j < 4; ++j) {
            f32x4 y = (f32x4){0.f, 0.f, 0.f, 0.f};
#pragma unroll
            for (int k = 0; k < 4; ++k) {
                const f32x2 lo = __builtin_amdgcn_cvt_pk_f32_fp8(yv[j][k], false), hi = __builtin_amdgcn_cvt_pk_f32_fp8(yv[j][k], true);
                y += (f32x4){lo.x, lo.y, hi.x, hi.y};
            }
            v[j] = xv[j] + gr[64 * j] * (y * Y8_INV);
            s += (v[j].x * v[j].x + v[j].y * v[j].y) + (v[j].z * v[j].z + v[j].w * v[j].w);
        }
        const float rstd = __builtin_amdgcn_rsqf(wave_sum(s) * (1.0f / D) + EPS);
        f32x4* o = (f32x4*)(F.out + (size_t)m * D) + F.lane;
#pragma unroll
        for (int j = 0; j < 4; ++j) __builtin_nontemporal_store(v[j] * rstd * ((const f32x4*)F.norm_f)[F.lane + 64 * j], o + 64 * j);
#pragma unroll
        for (int j = 0; j < 4; ++j) { xv[j] = xn[j];
#pragma unroll
            for (int k = 0; k < 4; ++k) yv[j][k] = yn[j][k]; }
    }
#undef P10_LOAD
}

constexpr int NPH = 11;
template <int LO, int HI>
__global__ void __launch_bounds__(NTHREADS, 2) fwd_kernel(Args args) {
    extern __shared__ __attribute__((aligned(16))) unsigned char lds[];
    Frame F;
    F.lds = (LAS unsigned char*)lds;
    F.tid = threadIdx.x; F.lane = F.tid & 63; F.wave = __builtin_amdgcn_readfirstlane(F.tid >> 6);
    F.G = gridDim.x; F.bid = blockIdx.x;
    F.x = (const float*)args.in[0]; F.c = (const float*)args.in[1]; F.positions = (const int*)args.in[2]; F.w_ada = (const float*)args.in[3]; F.b_ada = (const float*)args.in[4];
    F.norm1 = (const float*)args.in[5]; F.w_in = (const float*)args.in[6]; F.w_gk2 = (const float*)args.in[7]; F.b_gk = (const float*)args.in[8]; F.gla_onorm = (const float*)args.in[9];
    F.ret_onorm = (const float*)args.in[10]; F.w_out = (const float*)args.in[11]; F.norm2 = (const float*)args.in[12]; F.w_router = (const float*)args.in[13]; F.b_router = (const float*)args.in[14];
    F.w_gu = (const float*)args.in[15]; F.b_gu = (const float*)args.in[16]; F.w_down = (const float*)args.in[17]; F.b_down = (const float*)args.in[18]; F.norm_f = (const float*)args.in[19];
    F.out = args.out; F.ws = args.ws;
    unsigned char* ws = args.ws;
    F.ctl = (unsigned*)(ws + WS_CTL); F.mod = (float*)(ws + WS_MOD); F.win_t = (bf16_t*)(ws + WS_WIN); F.wout_t = (bf16_t*)(ws + WS_WOUT); F.wgu_t = (bf16_t*)(ws + WS_WGU); F.wd_t = (bf16_t*)(ws + WS_WD);
    F.hbuf = (bf16_t*)(ws + WS_H); F.obuf = (bf16_t*)(ws + WS_O); F.proj = (bf16_t*)(ws + WS_PROJ); F.act = (bf16_t*)(ws + WS_ACT); F.Y = (bf16_t*)(ws + WS_Y);
    F.x1 = (float*)(ws + WS_X1); F.bcum = (float*)(ws + WS_BCUM); F.pw = (float*)(ws + WS_PW); F.perm = (u32x2*)(ws + WS_PERM);

#define IN(k) (LO <= (k) && (k) < HI)
#if ONE_LAUNCH && USE_CG_SYNC
#define GSYNC(k) do { if (IN(k) && IN((k) + 1)) { cg::this_grid().sync(); } } while (0)
#elif ONE_LAUNCH
    { volatile LAS unsigned* st = (volatile LAS unsigned*)(F.lds + MISC_OFF + 512); if (F.tid < 2) st[F.tid] = 0u; }
    __syncthreads();
    const XcdBarrier bar = xcd_barrier_post(F.ctl + CW_BAR, (volatile LAS unsigned*)(F.lds + MISC_OFF + 512));
#define GSYNC(k) do { if (IN(k) && IN((k) + 1)) { xcd_barrier(bar); } } while (0)
#else
#define GSYNC(k) do { } while (0)
#endif
    if (IN(0)) { p0_prep(F); if (DUP(0)) p0_prep(F); } GSYNC(0);
    if (IN(1)) { p1_h1(F); if (DUP(1)) p1_h1(F); } GSYNC(1);
    if (IN(2)) {
        pg8::DenseOrder S; S.init(M, NIN_T, F.G, F.bid, F.win_t);
        EpiProj E{F.proj, F.bcum, F.positions, F.b_gk};
        pg8::gemm_phase<EpiProj, pg8::DenseOrder, false>(F.lds, F.hbuf, S, E, nullptr);
        if (DUP(2)) pg8::gemm_phase<EpiProj, pg8::DenseOrder, false>(F.lds, F.hbuf, S, E, nullptr);
        { pg8::Unit u8; if (F.G == 256 && !S.next(7, u8)) {
            { int t_ = threadIdx.x; asm volatile("" : "+v"(t_)); F.tid = t_; F.lane = t_ & 63; }
            const int nidle = F.G - (1920 - 7 * F.G), widx = (F.bid - (1920 - 7 * F.G)) * NWAVES + F.wave;
            if (nidle > 0 && widx >= 0) tr_range(F, (LAS float*)(F.lds + 16384 + F.wave * 8704), TR_SPLIT1, TR_SPLIT2, widx, nidle * NWAVES); } }
    } GSYNC(2);
#if NAIVE_LA
    if (IN(3)) { p3_la_naive(F); } GSYNC(3);
    GSYNC(4);
    GSYNC(5);
#else
    if (IN(3)) { p3_la_pass1(F); if (DUP(3)) p3_la_pass1(F); } GSYNC(3);
    if (IN(4)) { p4_la_scan(F); if (DUP(4)) p4_la_scan(F); } GSYNC(4);
    if (IN(5)) { p5_la_pass3(F); if (DUP(5)) p5_la_pass3(F); } GSYNC(5);
#endif
    if (IN(6)) {
        pg8::DenseOrder S; S.init(M, D, F.G, F.bid, F.wout_t);
        EpiRes1 E{F.x, F.mod, F.x1};
        pg8::gemm_phase<EpiRes1, pg8::DenseOrder, false, false, true>(F.lds, F.obuf, S, E, nullptr);
        if (DUP(6)) pg8::gemm_phase<EpiRes1, pg8::DenseOrder, false, false, true>(F.lds, F.obuf, S, E, nullptr);
    } GSYNC(6);
    if (IN(7)) { p7_router(F); } GSYNC(7);
    if (IN(8)) { p8_gu(F); if (DUP(8)) p8_gu(F); } GSYNC(8);
    if (IN(9)) { p9_down(F); if (DUP(9)) p9_down(F); } GSYNC(9);
    if (IN(10)) { p10_final(F); if (DUP(10)) p10_final(F); }
}

extern "C" void kernel_launch(void* const* d_in, const int* in_sizes, int n_in, void* d_out, int out_size, void* d_ws, size_t ws_size, hipStream_t stream) {
    static int grid = 0;
    if (grid == 0) {
        if (n_in != 20 || out_size != M * D || ws_size < WS_END) { fprintf(stderr, "kernel_launch: unexpected shapes (n_in %d out %d ws %zu)\n", n_in, out_size, ws_size); grid = -1; return; }
        int dev = 0, cus = 0, per_cu = 0;
        hipGetDevice(&dev); hipDeviceGetAttribute(&cus, hipDeviceAttributeMultiprocessorCount, dev);
#if ONE_LAUNCH
        hipFuncSetAttribute((const void*)fwd_kernel<0, NPH>, hipFuncAttributeMaxDynamicSharedMemorySize, LDS_BYTES);
        hipOccupancyMaxActiveBlocksPerMultiprocessor(&per_cu, (const void*)fwd_kernel<0, NPH>, NTHREADS, LDS_BYTES);
#else
        per_cu = 1;
#define SETATTR(k) hipFuncSetAttribute((const void*)fwd_kernel<k, k + 1>, hipFuncAttributeMaxDynamicSharedMemorySize, LDS_BYTES)
        SETATTR(0); SETATTR(1); SETATTR(2); SETATTR(3); SETATTR(4); SETATTR(5); SETATTR(6); SETATTR(7); SETATTR(8); SETATTR(9); SETATTR(10);
#endif
        (void)hipGetLastError();
        if (per_cu < 1) { fprintf(stderr, "kernel_launch: occupancy query says %d blocks/CU\n", per_cu); per_cu = 1; }
        grid = cus;
        if (grid != 256) fprintf(stderr, "kernel_launch: %d CUs (expected 256)\n", grid);
    }
    if (grid < 0) return;
    hipMemsetAsync((char*)d_ws + WS_CTL, 0, CTL_ZERO_BYTES, stream);
    Args a{};
    for (int i = 0; i < 20; ++i) a.in[i] = d_in[i];
    a.out = (float*)d_out; a.ws = (unsigned char*)d_ws;
#if ONE_LAUNCH
    a.ph_lo = 0; a.ph_hi = NPH;
#if USE_CG_SYNC
    void* params[] = {&a};
    hipError_t e = hipLaunchCooperativeKernel((const void*)fwd_kernel<0, NPH>, dim3(grid), dim3(NTHREADS), params, LDS_BYTES, stream);
    if (e != hipSuccess) fprintf(stderr, "cooperative launch failed: %s (grid %d)\n", hipGetErrorString(e), grid);
#else
    hipLaunchKernelGGL((fwd_kernel<0, NPH>), dim3(grid), dim3(NTHREADS), LDS_BYTES, stream, a);
#endif
#else
#define LAUNCH(k) hipLaunchKernelGGL((fwd_kernel<k, k + 1>), dim3(grid), dim3(NTHREADS), LDS_BYTES, stream, a)
    LAUNCH(0); LAUNCH(1); LAUNCH(2); LAUNCH(3); LAUNCH(4); LAUNCH(5); LAUNCH(6); LAUNCH(7); LAUNCH(8); LAUNCH(9); LAUNCH(10);
#endif
}
```

```cpp
#include <hip/hip_runtime.h>
#include <hip/hip_cooperative_groups.h>
#include <cstdio>
#include <cstdint>
namespace cg = cooperative_groups;

#ifndef ONE_LAUNCH
#define ONE_LAUNCH 1
#endif
#ifndef USE_CG_SYNC
#define USE_CG_SYNC 0
#endif
#ifndef PROBE_DUP
#define PROBE_DUP -1
#endif
#define DUP(k) (PROBE_DUP == (k))
#ifndef MOE_FP8
#define MOE_FP8 1
#endif
#ifndef Y_FP8
#define Y_FP8 1
#endif
#ifndef X1_BF16
#define X1_BF16 1
#endif
#ifndef NAIVE_LA
#define NAIVE_LA 0
#endif

#define LAS __attribute__((address_space(3)))
#define DI __device__ __forceinline__
typedef unsigned short bf16_t;
typedef short bf16x8 __attribute__((ext_vector_type(8)));
typedef float f32x4 __attribute__((ext_vector_type(4)));
typedef float f32x2 __attribute__((ext_vector_type(2)));
typedef unsigned u32x4 __attribute__((ext_vector_type(4)));
typedef unsigned u32x2 __attribute__((ext_vector_type(2)));
typedef int i32x4 __attribute__((ext_vector_type(4)));
typedef int i32x8 __attribute__((ext_vector_type(8)));

constexpr int D = 1024, BATCH = 2, SEQ = 16384, M = BATCH * SEQ;
constexpr int NPROJ = 3584;
constexpr int NIN_T = 3840;
constexpr int MIX_IN = 3600;
constexpr int NE = 32, TOPK = 4, NPAIR = M * TOPK;
constexpr int ECAP = 32768;
constexpr float EPS = 1e-6f;
constexpr int NWAVES = 8, NTHREADS = 512;

constexpr size_t MiB = 1u << 20;
constexpr size_t WS_CTL = 0, CTL_ZERO_BYTES = 65536;
constexpr size_t WS_MOD = 1 * MiB;
constexpr size_t WS_DEC = 1 * MiB + 65536;
constexpr size_t WS_WIN = 2 * MiB;
constexpr size_t WS_WOUT = 10 * MiB;
constexpr size_t WS_WGU = 12 * MiB;
constexpr size_t WS_WD = 140 * MiB;
constexpr size_t WS_H = 204 * MiB;
constexpr size_t WS_O = 268 * MiB;
constexpr size_t WS_X1 = 332 * MiB;
constexpr size_t WS_PROJ = 460 * MiB;
constexpr size_t WS_BCUM = 684 * MiB;
constexpr size_t WS_U = 716 * MiB;
constexpr size_t WS_SP = 812 * MiB;
constexpr size_t WS_ACT = 460 * MiB;
constexpr size_t WS_Y = 717 * MiB;
constexpr size_t WS_PERM = 973 * MiB;
constexpr size_t WS_PW = 981 * MiB;
constexpr size_t WS_END = 982 * MiB;
constexpr int CW_CNT = 1024;
constexpr int CW_BAR = 8192;

constexpr int RING_BYTES = 131072;
constexpr int TBL_OFF = RING_BYTES, TBL_UNITS = 22, UD_OFF = TBL_OFF + TBL_UNITS * 1024, TBL_BYTES = 24 * 1024;
constexpr int MISC_OFF = TBL_OFF + TBL_BYTES;
constexpr int EPI_OFF = MISC_OFF + 1024;
constexpr int LDS_BYTES = EPI_OFF + 4096;

DI unsigned f2bf(float f) { unsigned u = __builtin_bit_cast(unsigned, f); return (u + 0x7fffu + ((u >> 16) & 1u)) >> 16; }
DI unsigned pk2(float lo, float hi) { return f2bf(lo) | (f2bf(hi) << 16); }
DI float bf2f(unsigned h) { return __builtin_bit_cast(float, h << 16); }
DI float bflo(unsigned w) { return __builtin_bit_cast(float, w << 16); }
DI float bfhi(unsigned w) { return __builtin_bit_cast(float, w & 0xffff0000u); }
DI f32x4 bf4_to_f32(u32x2 w) { return (f32x4){bflo(w.x), bfhi(w.x), bflo(w.y), bfhi(w.y)}; }
DI unsigned cvt_pk_bf16(float lo, float hi) { unsigned r; asm volatile("v_cvt_pk_bf16_f32 %0, %1, %2" : "=v"(r) : "v"(lo), "v"(hi)); return r; }
#define DPPF_(v, ctrl) __builtin_bit_cast(float, __builtin_amdgcn_update_dpp(__builtin_bit_cast(int, v), __builtin_bit_cast(int, v), ctrl, 0xf, 0xf, false))
DI float row16_sum(float v) {
    v += DPPF_(v, 0xB1); v += DPPF_(v, 0x4E); v += DPPF_(v, 0x141); v += DPPF_(v, 0x140); return v;
}
DI float wave_sum(float v) {
    v = row16_sum(v);
    const int iv = __builtin_bit_cast(int, v);
    const float a = __builtin_bit_cast(float, __builtin_amdgcn_readlane(iv, 0)), b = __builtin_bit_cast(float, __builtin_amdgcn_readlane(iv, 16));
    const float c = __builtin_bit_cast(float, __builtin_amdgcn_readlane(iv, 32)), d = __builtin_bit_cast(float, __builtin_amdgcn_readlane(iv, 48));
    return (a + b) + (c + d);
}
DI float wave_max(float v) {
#pragma unroll
    for (int o = 1; o < 64; o <<= 1) v = fmaxf(v, __shfl_xor(v, o));
    return v;
}
DI float sigmoidf_(float x) { return __builtin_amdgcn_rcpf(1.0f + __builtin_amdgcn_exp2f(-1.4426950408889634f * x)); }
DI float logsigmoidf_(float x) { return fminf(x, 0.f) - 0.6931471805599453f * __builtin_amdgcn_logf(1.0f + __builtin_amdgcn_exp2f(-1.4426950408889634f * fabsf(x))); }
#define LDS_WAIT() asm volatile("s_waitcnt lgkmcnt(0)" ::: "memory")
DI unsigned pk4_fp8(float a, float b, float c, float d) {
    a = __builtin_amdgcn_fmed3f(a, -448.f, 448.f); b = __builtin_amdgcn_fmed3f(b, -448.f, 448.f); c = __builtin_amdgcn_fmed3f(c, -448.f, 448.f); d = __builtin_amdgcn_fmed3f(d, -448.f, 448.f);
    int p = __builtin_amdgcn_cvt_pk_fp8_f32(a, b, 0, false); p = __builtin_amdgcn_cvt_pk_fp8_f32(c, d, p, true); return (unsigned)p;
}
DI unsigned pk4_fp8_nc(float a, float b, float c, float d) { int p = __builtin_amdgcn_cvt_pk_fp8_f32(a, b, 0, false); p = __builtin_amdgcn_cvt_pk_fp8_f32(c, d, p, true); return (unsigned)p; }
constexpr float Y8_SCALE = 32.f, Y8_INV = 1.0f / 32.f;
constexpr float W8_SCALE = 512.f, H8_SCALE = 16.f, A8_SCALE = 4.f;
constexpr int W8_E8M0 = 0x76767676, H8_E8M0 = 0x7B7B7B7B, A8_E8M0 = 0x7D7D7D7D;

typedef int i32x4_ __attribute__((ext_vector_type(4)));
namespace pg8 {
constexpr int BM = 256, BK = 64, HALF = 128, HTB = HALF * BK * 2, STAGE_BYTES = 8 * HTB, NXCD = 8, WGM = 8, K = 1024;
__host__ __device__ __forceinline__ int lds_byte(int r, int c) { const int st = (r >> 4) * 2 + (c >> 5), rr = r & 15, cc = c & 31, ob = rr * 64 + cc * 2; return st * 1024 + (ob ^ (((ob >> 9) & 1) << 5)); }
__host__ __device__ __forceinline__ void stage_rc(int b, int& R, int& C) { const int st = b / 1024, sb = b % 1024, swz = sb ^ (((sb >> 9) & 1) << 5); R = (st >> 1) * 16 + swz / 64; C = (st & 1) * 32 + (swz % 64) / 2; }
__host__ __device__ __forceinline__ int perm32(int rho) { const int n = rho >> 4, i = rho & 15; return 8 * (i >> 2) + 4 * n + (i & 3); }

struct Unit { int arow0, pn, e, rows, prow0, rot; };

struct DenseOrder {
    int nM, nN, nwg, G, c;
    const bf16_t* Bt;
    DI void init(int M_, int N_, int G_, int c_, const bf16_t* Bt_) { nM = M_ / BM; nN = N_ / BM; nwg = nM * nN; G = G_; c = c_; Bt = Bt_; }
    DI bool next(int i, Unit& u) const {
        const long L = (long)i * G + c; if (L >= nwg) return false;
        int wgid = (int)L; { const int q = nwg / NXCD, r = nwg % NXCD, xcd = wgid % NXCD, off = wgid / NXCD; wgid = (xcd < r ? xcd * (q + 1) : r * (q + 1) + (xcd - r) * q) + off; }
        const int nig = WGM * nN, gid = wgid / nig, fm = gid * WGM, gsz = (nM - fm) < WGM ? (nM - fm) : WGM;
        const int pm = fm + ((wgid % nig) % gsz); u.pn = (wgid % nig) / gsz; u.arow0 = pm * BM; u.e = 0; u.rows = BM; u.prow0 = 0; u.rot = (pm + 3 * u.pn) & 15; return true;
    }
    DI const char* bptr(const Unit& u) const { return (const char*)Bt + (size_t)u.pn * BM * K * 2; }
    DI int scale_a() const { return 0x7f7f7f7f; }
    DI int scale_b() const { return 0x7f7f7f7f; }
};

struct MoeOrder {
    int n;
    const LAS int* ud;
    const void* Bt; size_t bstride;
    int ebytes, sa, sb;
    DI bool next(int i, Unit& u) const {
        if (i >= n) return false;
        const i32x4_ r = *(const LAS i32x4_*)(ud + 4 * i);
        const int r0 = __builtin_amdgcn_readfirstlane(r.x);
        u.e = r0 & 255; u.pn = (r0 >> 8) & 255; u.rot = r0 >> 16;
        u.rows = __builtin_amdgcn_readfirstlane(r.y); u.arow0 = __builtin_amdgcn_readfirstlane(r.z); u.prow0 = __builtin_amdgcn_readfirstlane(r.w); return true;
    }
    DI bool next_lane(int i, Unit& u) const {
        if (i >= n) return false;
        const i32x4_ r = *(const LAS i32x4_*)(ud + 4 * i);
        u.e = r.x & 255; u.pn = (r.x >> 8) & 255; u.rot = r.x >> 16; u.rows = r.y; u.arow0 = r.z; u.prow0 = r.w; return true;
    }
    DI const char* bptr(const Unit& u) const { return (const char*)Bt + ((size_t)u.e * bstride + (size_t)u.pn * BM * K) * ebytes; }
    DI int scale_a() const { return sa; }
    DI int scale_b() const { return sb; }
};

DI const char* uniform_ptr(const char* p) {
    const unsigned long long v = (unsigned long long)p;
    const unsigned lo = __builtin_amdgcn_readfirstlane((unsigned)v), hi = __builtin_amdgcn_readfirstlane((unsigned)(v >> 32));
    return (const char*)(((unsigned long long)hi << 32) | lo);
}
template <class Epi, class Sched, bool GATHER, bool FP8 = false, bool BMAP16 = false>
DI void gemm_phase(LAS unsigned char* lds, const bf16_t* Abase, const Sched& S, const Epi& E, const LAS unsigned* tbl) {
    int tid = threadIdx.x; asm volatile("" : "+v"(tid));
    const int wid = __builtin_amdgcn_readfirstlane(tid >> 6), lane = tid & 63, wr = wid >> 2, wc = wid & 3, fr = lane & 15, fq = lane >> 4;
    constexpr int KB = FP8 ? K : 2 * K;
    constexpr int nt = KB / 128;
    unsigned voffB[2]; int Rr[2], Cc[2];
#pragma unroll
    for (int i = 0; i < 2; ++i) { int R, C; stage_rc(tid * 16 + i * 8192, R, C);
        const int Rb = BMAP16 ? (64 * (R >> 5) + 16 * ((R & 15) >> 2) + 4 * ((R >> 4) & 1) + (R & 3)) : ((R & ~31) + perm32(R & 31));
        voffB[i] = (unsigned)(Rb * KB + C * 2); Rr[i] = R; Cc[i] = C; }
    const size_t kstep = (size_t)(BK * 2);
    const size_t hstep = BMAP16 ? (size_t)8 * KB : (size_t)HALF * KB;
    const unsigned ldsw = (unsigned)wid * 1024u;
    const int aoff = lds_byte(wr * 64 + fr, fq * 8), boff = lds_byte(wc * 32 + fr, fq * 8);
#define PG8_SA(b, h) (((b) * 2 + (h)) * HTB)
#define PG8_SB(b, h) ((4 + (b) * 2 + (h)) * HTB)
#define PG8_STAGE2(bufoff, gbase, v0, v1) do { \
        __builtin_amdgcn_global_load_lds((const unsigned*)((const char*)(gbase) + (v0)), (LAS unsigned*)(lds + (bufoff) + ldsw), 16, 0, 0); \
        __builtin_amdgcn_global_load_lds((const unsigned*)((const char*)(gbase) + (v1)), (LAS unsigned*)(lds + (bufoff) + ldsw + 8192), 16, 0, 0); } while (0)
#define PG8_STAGEB(bufoff, gbase) PG8_STAGE2(bufoff, gbase, voffB[0], voffB[1])
#define PG8_RD16(off) (*(const LAS i32x4*)(lds + (off)))
#define PG8_LDA(dst, b, h) do { if constexpr (FP8) { _Pragma("unroll") for (int m = 0; m < 4; ++m) dst##8[m] = __builtin_shufflevector(PG8_RD16(PG8_SA(b, h) + aop + m * 2048), PG8_RD16(PG8_SA(b, h) + aop + m * 2048 + 1024), 0, 1, 2, 3, 4, 5, 6, 7); } \
        else { _Pragma("unroll") for (int m = 0; m < 4; ++m) _Pragma("unroll") for (int k = 0; k < 2; ++k) dst[m][k] = *(const LAS bf16x8*)(lds + PG8_SA(b, h) + aoff + m * 2048 + k * 1024); } } while (0)
#define PG8_LDB(dst, b, h) do { if constexpr (FP8) { _Pragma("unroll") for (int n = 0; n < 2; ++n) dst##8[n] = __builtin_shufflevector(PG8_RD16(PG8_SB(b, h) + bop + n * 2048), PG8_RD16(PG8_SB(b, h) + bop + n * 2048 + 1024), 0, 1, 2, 3, 4, 5, 6, 7); } \
        else { _Pragma("unroll") for (int n = 0; n < 2; ++n) _Pragma("unroll") for (int k = 0; k < 2; ++k) dst[n][k] = *(const LAS bf16x8*)(lds + PG8_SB(b, h) + boff + n * 2048 + k * 1024); } } while (0)
#define PG8_MMA(ai, bj, At, Bt) do { __builtin_amdgcn_s_setprio(1); \
        if constexpr (FP8) { _Pragma("unroll") for (int m = 0; m < 4; ++m) _Pragma("unroll") for (int n = 0; n < 2; ++n) \
            acc[ai][bj][m][n] = __builtin_amdgcn_mfma_scale_f32_16x16x128_f8f6f4(Bt##8[n], At##8[m], acc[ai][bj][m][n], 0, 0, 0, sclB, 0, sclA); } \
        else { _Pragma("unroll") for (int m = 0; m < 4; ++m) _Pragma("unroll") for (int n = 0; n < 2; ++n) _Pragma("unroll") for (int k = 0; k < 2; ++k) \
            acc[ai][bj][m][n] = __builtin_amdgcn_mfma_f32_16x16x32_bf16(Bt[n][k], At[m][k], acc[ai][bj][m][n], 0, 0, 0); } \
        __builtin_amdgcn_s_setprio(0); } while (0)
#define PG8_WAIT_V(n) asm volatile("s_waitcnt vmcnt(" #n ")" ::: "memory")
#define PG8_WAIT_L(n) asm volatile("s_waitcnt lgkmcnt(" #n ")" ::: "memory")
#define PG8_BAR __builtin_amdgcn_s_barrier()
#define PG8_SCHED __builtin_amdgcn_sched_barrier(0)
#define PG8_LOADVA(dst00, dst01, dst10, dst11, ui_) do { \
        if constexpr (GATHER) { const LAS unsigned* t_ = tbl + (ui_) * 256; \
            dst00 = t_[Rr[0]] + (unsigned)Cc[0] * 2u; dst01 = t_[Rr[1]] + (unsigned)Cc[1] * 2u; dst10 = t_[128 + Rr[0]] + (unsigned)Cc[0] * 2u; dst11 = t_[128 + Rr[1]] + (unsigned)Cc[1] * 2u; } \
        else { dst00 = (unsigned)(Rr[0] * KB + Cc[0] * 2); dst01 = (unsigned)(Rr[1] * KB + Cc[1] * 2); dst10 = (unsigned)((128 + Rr[0]) * KB + Cc[0] * 2); dst11 = (unsigned)((128 + Rr[1]) * KB + Cc[1] * 2); } } while (0)
    Unit cur, nxt; int ui = 0;
    if (!S.next(0, cur)) return;
    f32x4 acc[2][2][4][2];
    f32x4 bia[2][2];
    E.bias(cur, wc, fq, bia);
    u32x2 pre;
    E.pre_load(cur, tid, pre);
    bf16x8 At[4][2], B0[2][2], B1[2][2];
    i32x8 At8[4], B08[2], B18[2];
    const int sclA = S.scale_a(), sclB = S.scale_b();
    unsigned vA00, vA01, vA10, vA11;
    PG8_LOADVA(vA00, vA01, vA10, vA11, 0);
    const char* cA = GATHER ? (const char*)Abase : (const char*)Abase + (size_t)cur.arow0 * KB;
    const char* cB = S.bptr(cur);
#define PG8_KOFF(rot_, i_) ((size_t)(((i_) + (rot_)) & (nt - 1)) * kstep)
    { const size_t k0_ = PG8_KOFF(cur.rot, 0);
    PG8_STAGEB(PG8_SB(0, 0), cB + k0_); PG8_STAGEB(PG8_SB(0, 1), cB + hstep + k0_); PG8_STAGE2(PG8_SA(0, 0), cA + k0_, vA00, vA01); PG8_STAGE2(PG8_SA(0, 1), cA + k0_, vA10, vA11); }
#define PG8_ACC_INIT() do { _Pragma("unroll") for (int a = 0; a < 2; ++a) _Pragma("unroll") for (int b = 0; b < 2; ++b) _Pragma("unroll") for (int m = 0; m < 4; ++m) _Pragma("unroll") for (int n = 0; n < 2; ++n) acc[a][b][m][n] = bia[b][n]; } while (0)
    PG8_ACC_INIT();
    E.pre_store(pre, tid, lds + EPI_OFF);
    if (wr == 1) PG8_BAR;
    PG8_WAIT_V(2); PG8_BAR;
    { const size_t k1_ = PG8_KOFF(cur.rot, 1);
    PG8_STAGEB(PG8_SB(1, 0), cB + k1_); PG8_STAGE2(PG8_SA(1, 0), cA + k1_, vA00, vA01); PG8_STAGEB(PG8_SB(1, 1), cB + hstep + k1_); }
    PG8_WAIT_V(6); PG8_BAR;
    for (;;) {
        const bool has_next = S.next(ui + 1, nxt);
        const char* nA = cA; const char* nB = cB;
        if (has_next) { nB = S.bptr(nxt); if constexpr (!GATHER) nA = (const char*)Abase + (size_t)nxt.arow0 * KB; }
        const int nrot = has_next ? nxt.rot : cur.rot;
#pragma unroll 1
        for (int t = 0; t < nt; t += 2) {
            const bool last = (t == nt - 2);
            int aop = aoff, bop = boff; asm volatile("" : "+v"(aop), "+v"(bop));
            const size_t o1 = PG8_KOFF(cur.rot, t + 1), o2 = last ? PG8_KOFF(nrot, 0) : PG8_KOFF(cur.rot, t + 2), o3 = last ? PG8_KOFF(nrot, 1) : PG8_KOFF(cur.rot, t + 3);
            const char* a1 = cA + o1; const char* b1x = cB + o1;
            const char* a2 = (last ? nA : cA) + o2; const char* b2 = (last ? nB : cB) + o2;
            const char* a3 = (last ? nA : cA) + o3; const char* b3 = (last ? nB : cB) + o3;
            (void)b1x;
            PG8_LDB(B0, 0, 0); PG8_LDB(B1, 0, 1); PG8_SCHED; PG8_LDA(At, 0, 0); PG8_STAGE2(PG8_SA(1, 1), a1, vA10, vA11);
            if constexpr (GATHER) { if (last && has_next) PG8_LOADVA(vA00, vA01, vA10, vA11, ui + 1); }
            PG8_WAIT_V(8); PG8_WAIT_L(0); PG8_BAR; PG8_MMA(0, 0, At, B0); PG8_MMA(0, 1, At, B1); PG8_BAR; PG8_SCHED;
            PG8_LDA(At, 0, 1); PG8_STAGEB(PG8_SB(0, 0), b2); PG8_STAGEB(PG8_SB(0, 1), b2 + hstep); PG8_STAGE2(PG8_SA(0, 0), a2, vA00, vA01);
            PG8_WAIT_V(8); PG8_WAIT_L(0); PG8_BAR; PG8_MMA(1, 0, At, B0); PG8_MMA(1, 1, At, B1); PG8_BAR; PG8_SCHED;
            PG8_LDB(B0, 1, 0); PG8_LDB(B1, 1, 1); PG8_SCHED; PG8_LDA(At, 1, 0); PG8_STAGE2(PG8_SA(0, 1), a2, vA10, vA11);
            PG8_WAIT_V(8); PG8_WAIT_L(0); PG8_BAR; PG8_MMA(0, 0, At, B0); PG8_MMA(0, 1, At, B1); PG8_BAR; PG8_SCHED;
            PG8_LDA(At, 1, 1); PG8_STAGEB(PG8_SB(1, 0), b3); PG8_STAGEB(PG8_SB(1, 1), b3 + hstep); PG8_STAGE2(PG8_SA(1, 0), a3, vA00, vA01);
            PG8_WAIT_V(8); PG8_WAIT_L(0); PG8_BAR; PG8_MMA(1, 0, At, B0); PG8_MMA(1, 1, At, B1); PG8_BAR; PG8_SCHED;
        }
        if (wr == 0) PG8_BAR;
        if (has_next) { E.bias(nxt, wc, fq, bia); E.pre_load(nxt, tid, pre); }
        E(acc, cur, lds + EPI_OFF + (ui & 1) * 2048, wr, wc, fr, fq);
        if (!has_next) break;
        PG8_ACC_INIT();
        E.pre_store(pre, tid, lds + EPI_OFF + ((ui + 1) & 1) * 2048);
        cur = nxt; cA = nA; cB = nB; ++ui;
        if (wr == 1) PG8_BAR;
    }
    PG8_WAIT_V(0);
    PG8_BAR;
#undef PG8_SA
#undef PG8_SB
#undef PG8_STAGE2
#undef PG8_STAGEB
#undef PG8_LDA
#undef PG8_LDB
#undef PG8_MMA
#undef PG8_RD16
#undef PG8_WAIT_V
#undef PG8_WAIT_L
#undef PG8_BAR
#undef PG8_SCHED
#undef PG8_LOADVA
#undef PG8_KOFF
#undef PG8_ACC_INIT
}
}

typedef f32x4 AccT[2][2][4][2];

DI void store8_bf16(bf16_t* p, const float* v) {
    u32x4 w; w.x = cvt_pk_bf16(v[0], v[1]); w.y = cvt_pk_bf16(v[2], v[3]); w.z = cvt_pk_bf16(v[4], v[5]); w.w = cvt_pk_bf16(v[6], v[7]);
    *(u32x4*)p = w;
}
DI float dpp_shr_f(float x, int ctrl_sel);

struct EpiProj {
    bf16_t* proj; float* bcum; const int* pos; const float* bgk;
    DI void bias(const pg8::Unit& u, int wc, int fq, f32x4 (&bia)[2][2]) const {
        bia[0][0] = bia[0][1] = bia[1][0] = bia[1][1] = (f32x4){0.f, 0.f, 0.f, 0.f};
        if (u.pn == 14) { const float* b = bgk + wc * 32 + 8 * fq; bia[0][0] = *(const f32x4*)b; bia[0][1] = *(const f32x4*)(b + 4); bia[1][0] = *(const f32x4*)(b + 128); bia[1][1] = *(const f32x4*)(b + 132); }
    }
    DI void pre_load(const pg8::Unit& u, int tid, u32x2& pre) const { if (u.pn >= 6 && u.pn <= 9 && tid < 256) pre.x = (unsigned)pos[u.arow0 + tid]; }
    DI void pre_store(const u32x2& pre, int tid, LAS unsigned char* buf) const { if (tid < 256) *(LAS unsigned*)(buf + tid * 4) = pre.x; }
    DI void operator()(const AccT& acc, const pg8::Unit& u, const LAS unsigned char* ebuf, int wr, int wc, int fr, int fq) const {
        const int pn = u.pn, cl = wc * 32 + 8 * fq, row0 = u.arow0 + wr * 64 + fr;
        if (pn == 14) {
            const int lane = threadIdx.x & 63;
#pragma unroll
            for (int ai = 0; ai < 2; ++ai)
#pragma unroll
                for (int bj = 0; bj < 2; ++bj) {
                    float v[4][8];
#pragma unroll
                    for (int q = 0; q < 8; ++q) {
                        float carry = 0.f;
#pragma unroll
                        for (int m = 0; m < 4; ++m) {
                            float x = logsigmoidf_(acc[ai][bj][m][q >> 2][q & 3]) * 0.0625f;
                            x += __builtin_bit_cast(float, __builtin_amdgcn_update_dpp(0, __builtin_bit_cast(int, x), 0x111, 0xf, 0xf, true));
                            x += __builtin_bit_cast(float, __builtin_amdgcn_update_dpp(0, __builtin_bit_cast(int, x), 0x112, 0xf, 0xf, true));
                            x += __builtin_bit_cast(float, __builtin_amdgcn_update_dpp(0, __builtin_bit_cast(int, x), 0x114, 0xf, 0xf, true));
                            x += __builtin_bit_cast(float, __builtin_amdgcn_update_dpp(0, __builtin_bit_cast(int, x), 0x118, 0xf, 0xf, true));
                            x += carry;
                            v[m][q] = x;
                            carry = __shfl(x, lane | 15);
                        }
                    }
#pragma unroll
                    for (int m = 0; m < 4; ++m) {
                        const int row = row0 + ai * 128 + m * 16;
                        float* p = bcum + (size_t)row * 256 + bj * 128 + cl;
                        *(f32x4*)p = (f32x4){v[m][0], v[m][1], v[m][2], v[m][3]};
                        *(f32x4*)(p + 4) = (f32x4){v[m][4], v[m][5], v[m][6], v[m][7]};
                    }
                    asm volatile("" ::: "memory");
                }
        } else if (pn >= 6 && pn <= 9) {
            float inv[8];
#pragma unroll
            for (int q = 0; q < 8; ++q) inv[q] = exp2f(-(float)((cl + q) & 63) * 0.20762050593046014f);
            const int hh = cl >> 6;
            const float sc = (pn >= 8) ? 0.08838834764831845f : 1.0f;
            int pv[8];
#pragma unroll
            for (int i = 0; i < 8; ++i) pv[i] = *(const LAS int*)(ebuf + (wr * 64 + fr + (i >> 2) * 128 + (i & 3) * 16) * 4);
#pragma unroll
            for (int ai = 0; ai < 2; ++ai)
#pragma unroll
                for (int m = 0; m < 4; ++m) {
                    const int row = row0 + ai * 128 + m * 16;
                    const float p = (float)pv[ai * 4 + m];
                    float o1[8], o2[8];
#pragma unroll
                    for (int q = 0; q < 8; ++q) {
                        const float ang = p * inv[q];
                        const float t = rintf(ang * 0.15915493667125702f);
                        const float f = fmaf(ang, 0.15915493667125702f, -t) + ang * 6.4206382432985265e-09f;
                        const float sn = __builtin_amdgcn_sinf(f), cs = __builtin_amdgcn_cosf(f);
                        const float x1 = acc[ai][0][m][q >> 2][q & 3], x2 = acc[ai][1][m][q >> 2][q & 3];
                        o1[q] = (x1 * cs - x2 * sn) * sc; o2[q] = (x1 * sn + x2 * cs) * sc;
                    }
                    bf16_t* dst = proj + (size_t)row * NPROJ + pn * 256 + hh * 128 + (cl & 63);
                    store8_bf16(dst, o1); store8_bf16(dst + 64, o2);
                }
        } else {
            const bool silu = (pn == 4 || pn == 5 || pn == 12 || pn == 13);
#pragma unroll
            for (int ai = 0; ai < 2; ++ai)
#pragma unroll
                for (int m = 0; m < 4; ++m) {
                    const int row = row0 + ai * 128 + m * 16;
#pragma unroll
                    for (int bj = 0; bj < 2; ++bj) {
                        f32x4 v0 = acc[ai][bj][m][0], v1 = acc[ai][bj][m][1];
                        if (silu) {
                            const f32x4 t0 = v0 * (-1.4426950408889634f), t1 = v1 * (-1.4426950408889634f);
                            f32x4 d0, d1;
#pragma unroll
                            for (int i = 0; i < 4; ++i) { d0[i] = __builtin_amdgcn_exp2f(t0[i]); d1[i] = __builtin_amdgcn_exp2f(t1[i]); }
                            d0 = d0 + 1.0f; d1 = d1 + 1.0f;
#pragma unroll
                            for (int i = 0; i < 4; ++i) { d0[i] = __builtin_amdgcn_rcpf(d0[i]); d1[i] = __builtin_amdgcn_rcpf(d1[i]); }
                            v0 = v0 * d0; v1 = v1 * d1;
                        } else if (pn == 0) { v0 = v0 * 0.125f; v1 = v1 * 0.125f; }
                        u32x4 w; w.x = cvt_pk_bf16(v0[0], v0[1]); w.y = cvt_pk_bf16(v0[2], v0[3]); w.z = cvt_pk_bf16(v1[0], v1[1]); w.w = cvt_pk_bf16(v1[2], v1[3]);
                        *(u32x4*)(proj + (size_t)row * NPROJ + pn * 256 + bj * 128 + cl) = w;
                    }
                }
        }
    }
};

struct EpiRes1 {
    const float* x; const float* mod; float* x1;
    DI void bias(const pg8::Unit&, int, int, f32x4 (&bia)[2][2]) const { bia[0][0] = bia[0][1] = bia[1][0] = bia[1][1] = (f32x4){0.f, 0.f, 0.f, 0.f}; }
    DI void pre_load(const pg8::Unit&, int, u32x2&) const {}
    DI void pre_store(const u32x2&, int, LAS unsigned char*) const {}
    DI void operator()(const AccT& acc, const pg8::Unit& u, const LAS unsigned char* ebuf, int wr, int wc, int fr, int fq) const {
        const int cl = wc * 64 + 16 * fq, row0 = u.arow0 + wr * 64 + fr;
        const int b = u.arow0 >= SEQ ? 1 : 0;
        const float* g = mod + b * 6144 + 2048 + u.pn * 256 + cl;
        f32x4 gv[2][2];
#pragma unroll
        for (int bj = 0; bj < 2; ++bj) { gv[bj][0] = *(const f32x4*)(g + 8 * bj); gv[bj][1] = *(const f32x4*)(g + 8 * bj + 4); }
        f32x4 xa[4], xb[4];
        const size_t off0 = (size_t)row0 * D + u.pn * 256 + cl;
#define RES_LOAD(X_, i_) do { const size_t o_ = off0 + (size_t)(((i_) >> 2) * 128 + ((i_) & 3) * 16) * D; \
        X_[0] = *(const f32x4*)(x + o_); X_[1] = *(const f32x4*)(x + o_ + 4); X_[2] = *(const f32x4*)(x + o_ + 8); X_[3] = *(const f32x4*)(x + o_ + 12); } while (0)
#if X1_BF16
#define RES_STORE(X_, i_) do { const size_t o_ = off0 + (size_t)(((i_) >> 2) * 128 + ((i_) & 3) * 16) * D; \
        const f32x4 r0_ = X_[0] + gv[0][0] * acc[(i_) >> 2][0][(i_) & 3][0], r1_ = X_[1] + gv[0][1] * acc[(i_) >> 2][0][(i_) & 3][1]; \
        const f32x4 r2_ = X_[2] + gv[1][0] * acc[(i_) >> 2][1][(i_) & 3][0], r3_ = X_[3] + gv[1][1] * acc[(i_) >> 2][1][(i_) & 3][1]; \
        u32x4 w0_, w1_; w0_.x = cvt_pk_bf16(r0_[0], r0_[1]); w0_.y = cvt_pk_bf16(r0_[2], r0_[3]); w0_.z = cvt_pk_bf16(r1_[0], r1_[1]); w0_.w = cvt_pk_bf16(r1_[2], r1_[3]); \
        w1_.x = cvt_pk_bf16(r2_[0], r2_[1]); w1_.y = cvt_pk_bf16(r2_[2], r2_[3]); w1_.z = cvt_pk_bf16(r3_[0], r3_[1]); w1_.w = cvt_pk_bf16(r3_[2], r3_[3]); \
        bf16_t* xp_ = (bf16_t*)x1 + o_; *(u32x4*)xp_ = w0_; *(u32x4*)(xp_ + 8) = w1_; } while (0)
#else
#define RES_STORE(X_, i_) do { const size_t o_ = off0 + (size_t)(((i_) >> 2) * 128 + ((i_) & 3) * 16) * D; \
        *(f32x4*)(x1 + o_) = X_[0] + gv[0][0] * acc[(i_) >> 2][0][(i_) & 3][0]; *(f32x4*)(x1 + o_ + 4) = X_[1] + gv[0][1] * acc[(i_) >> 2][0][(i_) & 3][1]; \
        *(f32x4*)(x1 + o_ + 8) = X_[2] + gv[1][0] * acc[(i_) >> 2][1][(i_) & 3][0]; *(f32x4*)(x1 + o_ + 12) = X_[3] + gv[1][1] * acc[(i_) >> 2][1][(i_) & 3][1]; } while (0)
#endif
        RES_LOAD(xa, 0);
        RES_LOAD(xb, 1); RES_STORE(xa, 0);
        RES_LOAD(xa, 2); RES_STORE(xb, 1);
        RES_LOAD(xb, 3); RES_STORE(xa, 2);
        RES_LOAD(xa, 4); RES_STORE(xb, 3);
        RES_LOAD(xb, 5); RES_STORE(xa, 4);
        RES_LOAD(xa, 6); RES_STORE(xb, 5);
        RES_LOAD(xb, 7); RES_STORE(xa, 6);
        RES_STORE(xb, 7);
#undef RES_LOAD
#undef RES_STORE
    }
};

struct EpiGU {
    const float* bgu; bf16_t* act;
    DI void pre_load(const pg8::Unit&, int, u32x2&) const {}
    DI void pre_store(const u32x2&, int, LAS unsigned char*) const {}
    DI void bias(const pg8::Unit& u, int wc, int fq, f32x4 (&bia)[2][2]) const {
        const float* bg = bgu + (size_t)u.e * 2048 + u.pn * 128 + wc * 32 + 8 * fq;
        bia[0][0] = *(const f32x4*)bg; bia[0][1] = *(const f32x4*)(bg + 4); bia[1][0] = *(const f32x4*)(bg + 1024); bia[1][1] = *(const f32x4*)(bg + 1028);
    }
    DI void operator()(const AccT& acc, const pg8::Unit& u, const LAS unsigned char* ebuf, int wr, int wc, int fr, int fq) const {
        const int cl = wc * 32 + 8 * fq;
        constexpr float OS = MOE_FP8 ? A8_SCALE : 1.0f;
#pragma unroll
        for (int ai = 0; ai < 2; ++ai)
#pragma unroll
            for (int m = 0; m < 4; ++m) {
                const int r = ai * 128 + wr * 64 + m * 16 + fr;
                if (r < u.rows) {
                    f32x2 o[4];
#pragma unroll
                    for (int q = 0; q < 4; ++q) {
                        const f32x4 ag = acc[ai][0][m][q >> 1], au = acc[ai][1][m][q >> 1];
                        f32x2 gt = (q & 1) ? (f32x2){ag[2], ag[3]} : (f32x2){ag[0], ag[1]};
                        f32x2 up = (q & 1) ? (f32x2){au[2], au[3]} : (f32x2){au[0], au[1]};
                        gt.x = fminf(gt.x, 7.0f); gt.y = fminf(gt.y, 7.0f);
                        up.x = __builtin_amdgcn_fmed3f(up.x, -7.0f, 7.0f); up.y = __builtin_amdgcn_fmed3f(up.y, -7.0f, 7.0f);
                        const f32x2 t = gt * (-2.4554669595930157f);
                        f32x2 d; d.x = __builtin_amdgcn_exp2f(t.x); d.y = __builtin_amdgcn_exp2f(t.y);
                        d = d + 1.0f;
                        f32x2 rc; rc.x = __builtin_amdgcn_rcpf(d.x); rc.y = __builtin_amdgcn_rcpf(d.y);
                        o[q] = (up * OS + OS) * (gt * rc);
                    }
#if MOE_FP8
                    u32x2 w8; w8.x = pk4_fp8_nc(o[0].x, o[0].y, o[1].x, o[1].y); w8.y = pk4_fp8_nc(o[2].x, o[2].y, o[3].x, o[3].y);
                    *(u32x2*)((unsigned char*)act + (size_t)(u.arow0 + r) * D + u.pn * 128 + cl) = w8;
#else
                    const float ov[8] = {o[0].x, o[0].y, o[1].x, o[1].y, o[2].x, o[2].y, o[3].x, o[3].y};
                    store8_bf16(act + (size_t)(u.arow0 + r) * D + u.pn * 128 + cl, ov);
#endif
                }
            }
    }
};

struct EpiDown {
    const float* bd; const u32x2* perm; bf16_t* Y;
    DI void pre_load(const pg8::Unit& u, int tid, u32x2& pre) const { if (tid < 256) pre = perm[u.prow0 + (tid < u.rows ? tid : 0)]; }
    DI void pre_store(const u32x2& pre, int tid, LAS unsigned char* buf) const { if (tid < 256) *(LAS u32x2*)(buf + tid * 8) = pre; }
    DI void bias(const pg8::Unit& u, int wc, int fq, f32x4 (&bia)[2][2]) const {
        const float* b = bd + (size_t)u.e * D + u.pn * 256 + wc * 64 + 16 * fq;
        bia[0][0] = *(const f32x4*)b; bia[0][1] = *(const f32x4*)(b + 4); bia[1][0] = *(const f32x4*)(b + 8); bia[1][1] = *(const f32x4*)(b + 12);
    }
    DI void operator()(const AccT& acc, const pg8::Unit& u, const LAS unsigned char* ebuf, int wr, int wc, int fr, int fq) const {
        asm volatile("" : "+v"(fr), "+v"(fq));
        const int cl = wc * 64 + 16 * fq;
#pragma unroll
        for (int ai = 0; ai < 2; ++ai) {
            u32x2 rec[4];
#pragma unroll
            for (int m = 0; m < 4; ++m) { const int r = ai * 128 + wr * 64 + m * 16 + fr; rec[m] = *(const LAS u32x2*)(ebuf + r * 8); }
#pragma unroll
            for (int m = 0; m < 4; ++m) {
                const int r = ai * 128 + wr * 64 + m * 16 + fr;
                if (r < u.rows) {
                    const unsigned wbits = rec[m].y; const float wgt = __uint_as_float(wbits);
#if Y_FP8
                    const float wg8 = wgt * Y8_SCALE;
                    const f32x4 v00 = acc[ai][0][m][0] * wg8, v01 = acc[ai][0][m][1] * wg8, v10 = acc[ai][1][m][0] * wg8, v11 = acc[ai][1][m][1] * wg8;
                    u32x4 w; w.x = pk4_fp8(v00[0], v00[1], v00[2], v00[3]); w.y = pk4_fp8(v01[0], v01[1], v01[2], v01[3]); w.z = pk4_fp8(v10[0], v10[1], v10[2], v10[3]); w.w = pk4_fp8(v11[0], v11[1], v11[2], v11[3]);
                    *(u32x4*)((unsigned char*)Y + (size_t)rec[m].x * D + u.pn * 256 + cl) = w;
#else
                    const f32x4 v00 = acc[ai][0][m][0] * wgt, v01 = acc[ai][0][m][1] * wgt, v10 = acc[ai][1][m][0] * wgt, v11 = acc[ai][1][m][1] * wgt;
                    u32x4 w0, w1; w0.x = cvt_pk_bf16(v00[0], v00[1]); w0.y = cvt_pk_bf16(v00[2], v00[3]); w0.z = cvt_pk_bf16(v01[0], v01[1]); w0.w = cvt_pk_bf16(v01[2], v01[3]);
                    w1.x = cvt_pk_bf16(v10[0], v10[1]); w1.y = cvt_pk_bf16(v10[2], v10[3]); w1.z = cvt_pk_bf16(v11[0], v11[1]); w1.w = cvt_pk_bf16(v11[2], v11[3]);
                    bf16_t* yp = Y + (size_t)rec[m].x * D + u.pn * 256 + cl; *(u32x4*)yp = w0; *(u32x4*)(yp + 8) = w1;
#endif
                }
            }
            asm volatile("" ::: "memory");
        }
    }
};

#define XB_TMO      128
#define XB_XCNT(j)  (256  + 64 * (j))
#define XB_XSUB(j)  (1280 + 64 * (j))
#define XB_XGEN(j)  (2304 + 64 * (j))
#define XB_TOP      3328
#define XB_TOPGEN   3392
#define XCD_BAR_WORDS 3456
#define XB_SPIN_CAP (1u << 22)
DI unsigned xb_ld(unsigned* p)              { return __hip_atomic_load(p, __ATOMIC_RELAXED, __HIP_MEMORY_SCOPE_AGENT); }
DI unsigned xb_add(unsigned* p, unsigned v) { return __hip_atomic_fetch_add(p, v, __ATOMIC_RELAXED, __HIP_MEMORY_SCOPE_AGENT); }
DI unsigned xb_xcc_id() { return (unsigned)__builtin_amdgcn_s_getreg((3 << 11) | 20) & 0xFu; }
#define XB_SPIN(cond, bar) do { unsigned _sp = 0; while (cond) { __builtin_amdgcn_s_sleep(1); \
    if ((++_sp & 255u) == 0u) { if (xb_ld(&(bar)[XB_TMO])) break; if (_sp > XB_SPIN_CAP) { atomicAdd(&(bar)[XB_TMO], 1u); break; } } } } while (0)
struct XcdBarrier { unsigned* bar; unsigned x; volatile LAS unsigned* st; };
DI XcdBarrier xcd_barrier_post(unsigned* bar, volatile LAS unsigned* st) {
    XcdBarrier b; b.bar = bar; b.x = xb_xcc_id(); b.st = st;
    if (threadIdx.x == 0) (void)xb_add(&bar[XB_XCNT(b.x)], 1u);
    return b;
}
DI void xcd_barrier_complete(unsigned* bar, unsigned x, unsigned& nloc, unsigned& nx) {
    const unsigned G = gridDim.x * gridDim.y * gridDim.z;
    unsigned sum, cnt, mine, sp = 0u;
    for (;;) {
        sum = 0u; cnt = 0u; mine = 0u;
#pragma unroll
        for (unsigned j = 0; j < 16; ++j) { const unsigned c = xb_ld(&bar[XB_XCNT(j)]); sum += c; cnt += (c > 0u) ? 1u : 0u; mine = (j == x) ? c : mine; }
        if (sum == G) break;
        __builtin_amdgcn_s_sleep(1);
        if ((++sp & 255u) == 0u) { if (xb_ld(&bar[XB_TMO])) break; if (sp > XB_SPIN_CAP) { atomicAdd(&bar[XB_TMO], 1u); break; } }
    }
    nloc = mine > 0u ? mine : 1u; nx = cnt > 0u ? cnt : 1u;
}
DI void xcd_barrier(const XcdBarrier& b) {
    asm volatile("s_waitcnt vmcnt(0)" ::: "memory");
    __syncthreads();
    if (threadIdx.x == 0) {
        unsigned* bar = b.bar;
        __builtin_amdgcn_s_waitcnt(0);
        unsigned nloc = b.st[0], nx = b.st[1];
        if (nloc == 0u) { xcd_barrier_complete(bar, b.x, nloc, nx); b.st[0] = nloc; b.st[1] = nx; }
        const unsigned old = xb_add(&bar[XB_XSUB(b.x)], 1u);
        const unsigned gen = old / nloc;
        if (old + 1u == (gen + 1u) * nloc) {
            __builtin_amdgcn_fence(__ATOMIC_RELEASE, "agent");
            asm volatile("s_waitcnt vmcnt(0)" ::: "memory");
            const unsigned og = xb_add(&bar[XB_TOP], 1u);
            const unsigned tg = og / nx;
            if (og + 1u == (tg + 1u) * nx) xb_add(&bar[XB_TOPGEN], 1u);
            else XB_SPIN(xb_ld(&bar[XB_TOPGEN]) == tg, bar);
            __builtin_amdgcn_fence(__ATOMIC_ACQUIRE, "agent");
            xb_add(&bar[XB_XGEN(b.x)], 1u);
            asm volatile("s_waitcnt vmcnt(0)" ::: "memory");
        } else {
            XB_SPIN(xb_ld(&bar[XB_XGEN(b.x)]) == gen, bar);
            __builtin_amdgcn_fence(__ATOMIC_ACQUIRE, "agent");
            asm volatile("s_waitcnt vmcnt(0)" ::: "memory");
        }
    }
    __syncthreads();
}

struct Args { const void* in[20]; float* out; unsigned char* ws; int ph_lo, ph_hi; };

struct Frame {
    LAS unsigned char* lds;
    int tid, lane, wave, G, bid;
    const float *x, *c, *w_ada, *b_ada, *norm1, *w_in, *w_gk2, *b_gk, *gla_onorm, *ret_onorm, *w_out, *norm2, *w_router, *b_router, *w_gu, *b_gu, *w_down, *b_down, *norm_f;
    const int* positions;
    float* out; unsigned char* ws;
    unsigned* ctl; float* mod; bf16_t *win_t, *wout_t, *wgu_t, *wd_t, *hbuf, *obuf, *proj, *act, *Y; float *x1, *bcum, *pw; u32x2* perm;
};

DI void tr_item(const float* W, int ldw, int k0, int src_c0, bf16_t* dst, LAS float* scr, int lane) {
    { float t[32]; const float* wp = W + (size_t)(k0 + (lane >> 5)) * ldw + src_c0 + (lane & 31);
#pragma unroll
      for (int i = 0; i < 32; ++i) t[i] = wp[(size_t)(2 * i) * ldw];
#pragma unroll
      for (int i = 0; i < 32; ++i) scr[(2 * i + (lane >> 5)) * 33 + (lane & 31)] = t[i]; }
    LDS_WAIT(); asm volatile("" ::: "memory");
    const int c = lane & 7;
#pragma unroll
    for (int j = 0; j < 4; ++j) { const int n = (lane >> 3) + 8 * j; const LAS float* s = scr + (8 * c) * 33 + n;
        u32x4 o; o.x = pk2(s[0 * 33], s[1 * 33]); o.y = pk2(s[2 * 33], s[3 * 33]); o.z = pk2(s[4 * 33], s[5 * 33]); o.w = pk2(s[6 * 33], s[7 * 33]);
        *(u32x4*)(dst + (size_t)n * D + k0 + 8 * c) = o; }
    LDS_WAIT(); asm volatile("" ::: "memory");
}

DI void tr_item8(const float* W, int ldw, int k0, int src_c0, unsigned char* dst, LAS float* scr, int lane) {
    { float t[32]; const float* wp = W + (size_t)(k0 + (lane >> 5)) * ldw + src_c0 + (lane & 31);
#pragma unroll
      for (int i = 0; i < 32; ++i) t[i] = wp[(size_t)(2 * i) * ldw];
#pragma unroll
      for (int i = 0; i < 32; ++i) scr[(2 * i + (lane >> 5)) * 33 + (lane & 31)] = t[i]; }
    LDS_WAIT(); asm volatile("" ::: "memory");
    const int c = lane & 3;
#pragma unroll
    for (int j = 0; j < 2; ++j) { const int n = (lane >> 2) + 16 * j; const LAS float* s = scr + (16 * c) * 33 + n;
        u32x4 o;
        o.x = pk4_fp8(s[0 * 33] * W8_SCALE, s[1 * 33] * W8_SCALE, s[2 * 33] * W8_SCALE, s[3 * 33] * W8_SCALE);
        o.y = pk4_fp8(s[4 * 33] * W8_SCALE, s[5 * 33] * W8_SCALE, s[6 * 33] * W8_SCALE, s[7 * 33] * W8_SCALE);
        o.z = pk4_fp8(s[8 * 33] * W8_SCALE, s[9 * 33] * W8_SCALE, s[10 * 33] * W8_SCALE, s[11 * 33] * W8_SCALE);
        o.w = pk4_fp8(s[12 * 33] * W8_SCALE, s[13 * 33] * W8_SCALE, s[14 * 33] * W8_SCALE, s[15 * 33] * W8_SCALE);
        *(u32x4*)(dst + (size_t)n * D + k0 + 16 * c) = o; }
    LDS_WAIT(); asm volatile("" ::: "memory");
}

struct TrDesc { const float* W; int ldw, k0, src; unsigned char* dst; int fp8; };
constexpr int TR_I_IN = 112 * 16, TR_I_OUT = 32 * 16, TR_I_GU = 64 * 16, TR_I_D = 32 * 16, TR_NITEMS = TR_I_IN + TR_I_OUT + NE * TR_I_GU + NE * TR_I_D;
DI bool tr_decode(Frame& F, int it, TrDesc& d) {
    if (it >= TR_NITEMS) return false;
    int r = it;
    if (r < TR_I_IN) {
        const int kb = r / 112, nb = r % 112, n0 = nb * 32, pn = n0 >> 8, cl0 = n0 & 255;
        int src;
        if (pn < 6) src = n0;
        else if (pn <= 9) { const int bj = cl0 >> 7, o0 = cl0 & 127; src = pn * 256 + 16 + 128 * (o0 >> 6) + 64 * bj + (o0 & 63); }
        else src = n0 + 16;
        d.W = F.w_in; d.ldw = MIX_IN; d.k0 = kb * 64; d.src = src; d.dst = (unsigned char*)(F.win_t + (size_t)n0 * D); d.fp8 = 0; return true;
    }
    r -= TR_I_IN;
    if (r < TR_I_OUT) { const int kb = r / 32, nb = r % 32; d.W = F.w_out; d.ldw = D; d.k0 = kb * 64; d.src = nb * 32; d.dst = (unsigned char*)(F.wout_t + (size_t)nb * 32 * D); d.fp8 = 0; return true; }
    r -= TR_I_OUT;
    if (r < NE * TR_I_GU) {
        const int e = r / TR_I_GU, rr = r % TR_I_GU, kb = rr / 64, nb = rr % 64, n0 = nb * 32, pn = n0 >> 8, cl0 = n0 & 255, bj = cl0 >> 7, o0 = cl0 & 127;
        d.W = F.w_gu + (size_t)e * D * 2048; d.ldw = 2048; d.k0 = kb * 64; d.src = 1024 * bj + 128 * pn + o0; d.fp8 = MOE_FP8;
        d.dst = (unsigned char*)F.wgu_t + ((size_t)e * 2048 + n0) * D * (MOE_FP8 ? 1 : 2); return true;
    }
    r -= NE * TR_I_GU;
    { const int e = r / TR_I_D, rr = r % TR_I_D, kb = rr / 32, nb = rr % 32;
      d.W = F.w_down + (size_t)e * D * D; d.ldw = D; d.k0 = kb * 64; d.src = nb * 32; d.fp8 = MOE_FP8;
      d.dst = (unsigned char*)F.wd_t + ((size_t)e * D + nb * 32) * D * (MOE_FP8 ? 1 : 2); return true; }
}
DI void tr_load(float (&t)[32], const TrDesc& d, int lane) {
    const float* wp = d.W + (size_t)(d.k0 + (lane >> 5)) * d.ldw + d.src + (lane & 31);
#pragma unroll
    for (int i = 0; i < 32; ++i) t[i] = __builtin_nontemporal_load(wp + (size_t)(2 * i) * d.ldw);
}
DI void tr_finish(const float (&t)[32], const TrDesc& d, LAS float* scr, int lane) {
#pragma unroll
    for (int i = 0; i < 32; ++i) scr[(2 * i + (lane >> 5)) * 33 + (lane & 31)] = t[i];
    LDS_WAIT(); asm volatile("" ::: "memory");
    if (d.fp8) {
        const int c = lane & 3;
#pragma unroll
        for (int j = 0; j < 2; ++j) { const int n = (lane >> 2) + 16 * j; const LAS float* s = scr + (16 * c) * 33 + n;
            u32x4 o;
            o.x = pk4_fp8(s[0 * 33] * W8_SCALE, s[1 * 33] * W8_SCALE, s[2 * 33] * W8_SCALE, s[3 * 33] * W8_SCALE);
            o.y = pk4_fp8(s[4 * 33] * W8_SCALE, s[5 * 33] * W8_SCALE, s[6 * 33] * W8_SCALE, s[7 * 33] * W8_SCALE);
            o.z = pk4_fp8(s[8 * 33] * W8_SCALE, s[9 * 33] * W8_SCALE, s[10 * 33] * W8_SCALE, s[11 * 33] * W8_SCALE);
            o.w = pk4_fp8(s[12 * 33] * W8_SCALE, s[13 * 33] * W8_SCALE, s[14 * 33] * W8_SCALE, s[15 * 33] * W8_SCALE);
            *(u32x4*)(d.dst + (size_t)n * D + d.k0 + 16 * c) = o; }
    } else {
        const int c = lane & 7;
#pragma unroll
        for (int j = 0; j < 4; ++j) { const int n = (lane >> 3) + 8 * j; const LAS float* s = scr + (8 * c) * 33 + n;
            u32x4 o; o.x = pk2(s[0 * 33], s[1 * 33]); o.y = pk2(s[2 * 33], s[3 * 33]); o.z = pk2(s[4 * 33], s[5 * 33]); o.w = pk2(s[6 * 33], s[7 * 33]);
            *(u32x4*)((bf16_t*)d.dst + (size_t)n * D + d.k0 + 8 * c) = o; }
    }
    LDS_WAIT(); asm volatile("" ::: "memory");
}

constexpr int TR_SPLIT1 = TR_NITEMS - 9216 - 7168, TR_SPLIT2 = TR_NITEMS - 7168;
DI void tr_range(Frame& F, LAS float* scr, int first, int last, int widx, int nw) {
    int it = first + widx; TrDesc d0, d1; float t0[32], t1[32];
    bool v0 = it < last && tr_decode(F, it, d0);
    if (v0) tr_load(t0, d0, F.lane);
    while (v0) {
        const bool v1 = (it + nw) < last && tr_decode(F, it + nw, d1);
        if (v1) tr_load(t1, d1, F.lane);
        tr_finish(t0, d0, scr, F.lane);
        if (!v1) break;
        it += 2 * nw; v0 = it < last && tr_decode(F, it, d0);
        if (v0) tr_load(t0, d0, F.lane);
        tr_finish(t1, d1, scr, F.lane);
    }
}

DI void p0_prep(Frame& F) {
    { int t_ = threadIdx.x; asm volatile("" : "+v"(t_)); F.tid = t_; F.lane = t_ & 63; }
    LAS float* red = (LAS float*)F.lds;
    LAS float* sc_ = (LAS float*)(F.lds + 4096);
    for (int i = F.tid; i < 2 * D; i += NTHREADS) { const float cv = F.c[i]; sc_[i] = cv * sigmoidf_(cv); }
    __syncthreads();
    for (int cb = F.bid; cb < 256; cb += F.G) {
        if (F.tid < 504) {
            const int col = F.tid % 24, ks = F.tid / 24; float a0 = 0.f, a1 = 0.f;
            const float* wp = F.w_ada + (size_t)ks * 6144 + cb * 24 + col;
#pragma unroll 1
            for (int k0 = 0; k0 < 52; k0 += 13) {
                float w[13];
#pragma unroll
                for (int j = 0; j < 13; ++j) { const int k = ks + 21 * (k0 + j); w[j] = k < D ? wp[(size_t)(21 * (k0 + j)) * 6144] : 0.f; }
#pragma unroll
                for (int j = 0; j < 13; ++j) { const int k = ks + 21 * (k0 + j); if (k < D) { a0 += sc_[k] * w[j]; a1 += sc_[D + k] * w[j]; } }
            }
            red[ks * 24 + col] = a0; red[(21 + ks) * 24 + col] = a1;
        }
        __syncthreads();
        if (F.tid < 48) {
            const int b = F.tid / 24, col = F.tid % 24; float s = F.b_ada[cb * 24 + col];
            for (int ks = 0; ks < 21; ++ks) s += red[(b * 21 + ks) * 24 + col];
            F.mod[b * 6144 + cb * 24 + col] = s;
        }
        __syncthreads();
    }
    for (int it = F.bid * NTHREADS + F.tid; it < 256 * 128; it += F.G * NTHREADS) {
        const int c = it & 255, k8 = it >> 8;
        float w2[16];
#pragma unroll
        for (int j = 0; j < 16; ++j) w2[j] = F.w_gk2[j * 256 + c];
        float o[8];
#pragma unroll
        for (int kk = 0; kk < 8; ++kk) {
            const float* wi = F.w_in + (size_t)(k8 * 8 + kk) * MIX_IN + 1536; float s = 0.f;
#pragma unroll
            for (int j = 0; j < 16; ++j) s += wi[j] * w2[j];
            o[kk] = s;
        }
        u32x4 w; w.x = pk2(o[0], o[1]); w.y = pk2(o[2], o[3]); w.z = pk2(o[4], o[5]); w.w = pk2(o[6], o[7]);
        *(u32x4*)(F.win_t + (size_t)(3584 + c) * D + k8 * 8) = w;
    }
    tr_range(F, (LAS float*)(F.lds + 16384 + F.wave * 8704), 0, F.G == 256 ? TR_SPLIT1 : TR_NITEMS, F.bid * NWAVES + F.wave, F.G * NWAVES);
}

DI void p1_h1(Frame& F) {
    { int t_ = threadIdx.x; asm volatile("" : "+v"(t_)); F.tid = t_; F.lane = t_ & 63; }
    const int gw = F.bid * NWAVES + F.wave, NGW = F.G * NWAVES;
    f32x4 v[4], vn[4];
    if (gw < M) { const f32x4* xr = (const f32x4*)(F.x + (size_t)gw * D) + F.lane;
#pragma unroll
        for (int j = 0; j < 4; ++j) v[j] = xr[64 * j]; }
    for (int m = gw; m < M; m += NGW) {
        const int b = m >= SEQ;
        if (m + NGW < M) { const f32x4* xn = (const f32x4*)(F.x + (size_t)(m + NGW) * D) + F.lane;
#pragma unroll
            for (int j = 0; j < 4; ++j) vn[j] = xn[64 * j]; }
        const f32x4* nr = (const f32x4*)F.norm1 + F.lane;
        const f32x4* shr = (const f32x4*)(F.mod + b * 6144) + F.lane;
        const f32x4* scr = (const f32x4*)(F.mod + b * 6144 + 1024) + F.lane;
        float s = 0.f;
#pragma unroll
        for (int j = 0; j < 4; ++j) s += (v[j].x * v[j].x + v[j].y * v[j].y) + (v[j].z * v[j].z + v[j].w * v[j].w);
        const float rstd = __builtin_amdgcn_rsqf(wave_sum(s) * (1.0f / D) + EPS);
        u32x2* o8 = (u32x2*)(F.hbuf + (size_t)m * D) + F.lane;
#pragma unroll
        for (int j = 0; j < 4; ++j) {
            const f32x4 w = nr[64 * j], sc = scr[64 * j], sh = shr[64 * j];
            const f32x4 h = v[j] * rstd * w * (sc + 1.0f) + sh;
            u32x2 p; p.x = pk2(h.x, h.y); p.y = pk2(h.z, h.w); o8[64 * j] = p;
        }
#pragma unroll
        for (int j = 0; j < 4; ++j) v[j] = vn[j];
    }
}

template <int DK, bool GLA>
DI void la_naive_stream(Frame& F, int b, int h) {
    LAS float* qs = (LAS float*)F.lds;
    LAS float* ks = qs + 64 * DK;
    LAS float* as = ks + 64 * DK;
    LAS float* vs = (LAS float*)(F.lds + 3 * 64 * 128 * 4);
    const int qcol = GLA ? h * 64 : 1536 + h * 128, kcol = GLA ? 256 + h * 64 : 2048 + h * 128, vcol = GLA ? 512 + h * 128 : 2560 + h * 128, gcol = GLA ? 1024 + h * 128 : 3072 + h * 128;
    const float gamma = 1.0f - exp2f(-5.0f - (float)h);
    float S[DK];
#pragma unroll
    for (int d = 0; d < DK; ++d) S[d] = 0.f;
    for (int tile = 0; tile < SEQ / 64; ++tile) {
        const int row0 = b * SEQ + tile * 64;
        for (int i = F.tid; i < 64 * DK; i += NTHREADS) {
            const int t = i / DK, d = i % DK; const size_t r = (size_t)(row0 + t);
            qs[i] = bf2f(F.proj[r * NPROJ + qcol + d]); ks[i] = bf2f(F.proj[r * NPROJ + kcol + d]);
            if (GLA) { const float bc = F.bcum[r * 256 + h * 64 + d]; const float bp = t > 0 ? F.bcum[(r - 1) * 256 + h * 64 + d] : 0.f; as[i] = expf(bc - bp); }
        }
        for (int i = F.tid; i < 64 * 128; i += NTHREADS) { const int t = i >> 7, e = i & 127; vs[i] = bf2f(F.proj[(size_t)(row0 + t) * NPROJ + vcol + e]); }
        __syncthreads();
        if (F.tid < 128) {
            const int e = F.tid;
            for (int t = 0; t < 64; ++t) {
                const float v = vs[t * 128 + e]; float o = 0.f;
#pragma unroll
                for (int d = 0; d < DK; ++d) {
                    const float a = GLA ? as[t * DK + d] : gamma;
                    S[d] = a * S[d] + ks[t * DK + d] * v; o += qs[t * DK + d] * S[d];
                }
                vs[t * 128 + e] = o;
            }
        }
        __syncthreads();
        for (int tt = 0; tt < 8; ++tt) {
            const int t = F.wave * 8 + tt; const size_t r = (size_t)(row0 + t);
            const float o0 = vs[t * 128 + F.lane], o1 = vs[t * 128 + 64 + F.lane];
            float y0, y1;
            if (GLA) {
                const float rstd = 1.0f / sqrtf(wave_sum(o0 * o0 + o1 * o1) * (1.0f / 128.f) + EPS);
                y0 = o0 * rstd * F.gla_onorm[F.lane]; y1 = o1 * rstd * F.gla_onorm[64 + F.lane];
            } else {
                const float mu = wave_sum(o0 + o1) * (1.0f / 128.f); const float d0 = o0 - mu, d1 = o1 - mu;
                const float rstd = 1.0f / sqrtf(wave_sum(d0 * d0 + d1 * d1) * (1.0f / 128.f) + EPS);
                y0 = d0 * rstd * F.ret_onorm[F.lane]; y1 = d1 * rstd * F.ret_onorm[64 + F.lane];
            }
            y0 *= bf2f(F.proj[r * NPROJ + gcol + F.lane]); y1 *= bf2f(F.proj[r * NPROJ + gcol + 64 + F.lane]);
            const int oc = (GLA ? 0 : 512) + h * 128;
            F.obuf[r * D + oc + F.lane] = (bf16_t)f2bf(y0); F.obuf[r * D + oc + 64 + F.lane] = (bf16_t)f2bf(y1);
        }
        __syncthreads();
    }
}
DI void p3_la_naive(Frame& F) {
    { int t_ = threadIdx.x; asm volatile("" : "+v"(t_)); F.tid = t_; F.lane = t_ & 63; }
    for (int s = F.bid; s < 16; s += F.G) {
        const int type = s >> 3, b = (s >> 2) & 1, h = s & 3;
        if (type == 0) la_naive_stream<64, true>(F, b, h); else la_naive_stream<128, false>(F, b, h);
    }
}


typedef short s16x4 __attribute__((ext_vector_type(4)));
constexpr int LA_C = 128, LA_NC = SEQ / LA_C;
constexpr size_t U_RET_OFF = (size_t)8 * LA_NC * 128 * 64;
DI bf16x8 tr_pair(const LAS unsigned char* p0, const LAS unsigned char* p1) {
    const s16x4 lo = __builtin_amdgcn_ds_read_tr16_b64_v4i16((LAS s16x4*)p0);
    const s16x4 hi = __builtin_amdgcn_ds_read_tr16_b64_v4i16((LAS s16x4*)p1);
    return __builtin_shufflevector(lo, hi, 0, 1, 2, 3, 4, 5, 6, 7);
}
DI int slot_swap23(int t) { return (t & ~12) | ((t >> 1) & 4) | ((t << 1) & 8); }
DI float lg2_gamma(int h) { return log2f(1.0f - exp2f(-5.0f - (float)h)); }
DI bf16x8 scale8(u32x4 w, const float* f) {
    u32x4 o;
    o.x = cvt_pk_bf16(bflo(w.x) * f[0], bfhi(w.x) * f[1]); o.y = cvt_pk_bf16(bflo(w.y) * f[2], bfhi(w.y) * f[3]);
    o.z = cvt_pk_bf16(bflo(w.z) * f[4], bfhi(w.z) * f[5]); o.w = cvt_pk_bf16(bflo(w.w) * f[6], bfhi(w.w) * f[7]);
    return __builtin_bit_cast(bf16x8, o);
}
DI bf16x8 scale1(u32x4 w, float f) {
    u32x4 o;
    o.x = cvt_pk_bf16(bflo(w.x) * f, bfhi(w.x) * f); o.y = cvt_pk_bf16(bflo(w.y) * f, bfhi(w.y) * f);
    o.z = cvt_pk_bf16(bflo(w.z) * f, bfhi(w.z) * f); o.w = cvt_pk_bf16(bflo(w.w) * f, bfhi(w.w) * f);
    return __builtin_bit_cast(bf16x8, o);
}

template <int DK, int EB, bool GLA>
DI void la_pass1_unit(Frame& F, LAS unsigned char* wl, int b, int h, int n, int eh, bf16_t* Ubase) {
    int lane = F.lane; asm volatile("" : "+v"(lane), "+s"(n));
    const int g = lane >> 4, i16 = lane & 15, q = i16 >> 2, p = i16 & 3;
    constexpr int NDB = DK / 16, VCOLS = 16 * EB, VC = VCOLS / 8, KC = DK / 8, VI = 32 * VC / 64, KI = 32 * KC / 64;
    LAS unsigned char* vt = wl; LAS unsigned char* kt = wl + EB * 1024;
    const int r0 = b * SEQ + n * LA_C;
    const int kcol = GLA ? 256 + h * 64 : 2048 + h * 128, vcol = (GLA ? 512 : 2560) + h * 128 + eh * VCOLS, hd = h * 64;
    f32x4 acc[EB][NDB];
#pragma unroll
    for (int e = 0; e < EB; ++e)
#pragma unroll
        for (int d = 0; d < NDB; ++d) acc[e][d] = (f32x4){0.f, 0.f, 0.f, 0.f};
    const int kc = lane % KC, ktok = lane / KC, vch = lane % VC, vtok = lane / VC;
    float bl[8], b63[8]; const float lg2 = lg2_gamma(h);
    if (GLA) {
        const f32x4 a0 = *(const f32x4*)(F.bcum + (size_t)(r0 + 127) * 256 + hd + 8 * kc), a1 = *(const f32x4*)(F.bcum + (size_t)(r0 + 127) * 256 + hd + 8 * kc + 4);
        const f32x4 c0 = *(const f32x4*)(F.bcum + (size_t)(r0 + 63) * 256 + hd + 8 * kc), c1 = *(const f32x4*)(F.bcum + (size_t)(r0 + 63) * 256 + hd + 8 * kc + 4);
#pragma unroll
        for (int j = 0; j < 4; ++j) { bl[j] = a0[j]; bl[4 + j] = a1[j]; b63[j] = c0[j]; b63[4 + j] = c1[j]; }
    }
    if (GLA && eh == 0 && lane < KC) {
        float* dp = (float*)(F.ws + WS_DEC) + ((size_t)((b * 4 + h) * LA_NC + n) * 64) + 8 * kc;
        *(f32x4*)dp = (f32x4){__expf(bl[0] + b63[0]), __expf(bl[1] + b63[1]), __expf(bl[2] + b63[2]), __expf(bl[3] + b63[3])};
        *(f32x4*)(dp + 4) = (f32x4){__expf(bl[4] + b63[4]), __expf(bl[5] + b63[5]), __expf(bl[6] + b63[6]), __expf(bl[7] + b63[7])};
    }
    const int rbase = (((g >> 1) * 16 + (g & 1) * 4 + q) * 32) + 8 * p;
    u32x4 vr[VI], kr[KI]; f32x4 kbv[KI][2];
#define LA1_LOAD(step_) do { const int rs_ = r0 + 32 * (step_); \
        _Pragma("unroll") for (int i = 0; i < VI; ++i) vr[i] = *(const u32x4*)(F.proj + (size_t)(rs_ + vtok + i * (64 / VC)) * NPROJ + vcol + 8 * vch); \
        _Pragma("unroll") for (int i = 0; i < KI; ++i) { const size_t row = (size_t)(rs_ + ktok + i * (64 / KC)); kr[i] = *(const u32x4*)(F.proj + row * NPROJ + kcol + 8 * kc); \
            if (GLA) { kbv[i][0] = *(const f32x4*)(F.bcum + row * 256 + hd + 8 * kc); kbv[i][1] = *(const f32x4*)(F.bcum + row * 256 + hd + 8 * kc + 4); } } } while (0)
    LA1_LOAD(0);
#pragma unroll 1
    for (int step = 0; step < 4; ++step) {
#pragma unroll
        for (int i = 0; i < VI; ++i) { const int tau = vtok + i * (64 / VC); *(LAS u32x4*)(vt + (vch >> 1) * 1024 + slot_swap23(tau) * 32 + (vch & 1) * 16) = vr[i]; }
#pragma unroll
        for (int i = 0; i < KI; ++i) {
            const int tau = ktok + i * (64 / KC), t = 32 * step + tau;
            bf16x8 o;
            if (GLA) {
                float f[8];
#pragma unroll
                for (int j = 0; j < 8; ++j) f[j] = __expf(bl[j] - kbv[i][j >> 2][j & 3] + (t < 64 ? b63[j] : 0.f));
                o = scale8(kr[i], f);
            } else {
                o = scale1(kr[i], exp2f((float)(127 - t) * lg2));
            }
            *(LAS bf16x8*)(kt + (kc >> 1) * 1024 + slot_swap23(tau) * 32 + (kc & 1) * 16) = o;
        }
        if (step < 3) LA1_LOAD(step + 1);
        bf16x8 af[EB], bfr[NDB];
#pragma unroll
        for (int e = 0; e < EB; ++e) af[e] = tr_pair(vt + e * 1024 + rbase, vt + e * 1024 + rbase + 256);
#pragma unroll
        for (int d = 0; d < NDB; ++d) bfr[d] = tr_pair(kt + d * 1024 + rbase, kt + d * 1024 + rbase + 256);
#pragma unroll
        for (int e = 0; e < EB; ++e)
#pragma unroll
            for (int d = 0; d < NDB; ++d) acc[e][d] = __builtin_amdgcn_mfma_f32_16x16x32_bf16(bfr[d], af[e], acc[e][d], 0, 0, 0);
    }
#undef LA1_LOAD
    bf16_t* U = Ubase + (size_t)n * 128 * DK;
#pragma unroll
    for (int e = 0; e < EB; ++e)
#pragma unroll
        for (int d = 0; d < NDB; ++d)
            { u32x2 w; w.x = cvt_pk_bf16(acc[e][d][0], acc[e][d][1]); w.y = cvt_pk_bf16(acc[e][d][2], acc[e][d][3]);
              *(u32x2*)(U + (size_t)(eh * VCOLS + 16 * e + i16) * DK + 16 * d + 4 * g) = w; }
}

DI void p3_la_pass1(Frame& F) {
    { int t_ = threadIdx.x; asm volatile("" : "+v"(t_)); F.tid = t_; F.lane = t_ & 63; }
    LAS unsigned char* wl = F.lds + F.wave * 16384;
    const int gw = F.bid * NWAVES + F.wave, NGW = F.G * NWAVES;
    bf16_t* Ug = (bf16_t*)(F.ws + WS_U); bf16_t* Ur = Ug + U_RET_OFF;
    for (int u = gw; u < 2048 + 4096; u += NGW) {
        if (u < 2048) { const int eh = u & 1, n = (u >> 1) & 127, st = u >> 8; la_pass1_unit<64, 4, true>(F, wl, st >> 2, st & 3, n, eh, Ug + (size_t)st * LA_NC * 128 * 64); }
        else { const int v = u - 2048, eh = v & 3, n = (v >> 2) & 127, st = v >> 9; la_pass1_unit<128, 2, false>(F, wl, st >> 2, st & 3, n, eh, Ur + (size_t)st * LA_NC * 128 * 128); }
    }
}

DI void p4_la_scan(Frame& F) {
    { int t_ = threadIdx.x; asm volatile("" : "+v"(t_)); F.tid = t_; F.lane = t_ & 63; }
    const bf16_t* Ug = (const bf16_t*)(F.ws + WS_U); bf16_t* Sg = (bf16_t*)(F.ws + WS_SP);
    if (F.tid >= 384) { if (F.G == 256) tr_range(F, (LAS float*)(F.lds + 16384 + F.wave * 8704), TR_SPLIT2, TR_NITEMS, F.bid * 2 + (F.wave - 6), F.G * 2); return; }
    for (int it = F.bid * 384 + F.tid; it < 32768 + 65536; it += F.G * 384) {
        const bool gla = it < 32768;
        int st, e, d2, DK; size_t base;
        if (gla) { st = it >> 12; const int idx = it & 4095; e = idx >> 5; d2 = idx & 31; DK = 64; base = (size_t)st * LA_NC * 128 * 64; }
        else { const int v = it - 32768; st = v >> 13; const int idx = v & 8191; e = idx >> 6; d2 = idx & 63; DK = 128; base = U_RET_OFF + (size_t)st * LA_NC * 128 * 128; }
        const int b = st >> 2, h = st & 3;
        const size_t cstride = (size_t)128 * DK;
        const bf16_t* up = Ug + base + (size_t)e * DK + 2 * d2;
        bf16_t* sp = Sg + base + (size_t)e * DK + 2 * d2;
        const float* bc = (const float*)(F.ws + WS_DEC) + (size_t)(st & 7) * LA_NC * 64 + 2 * d2;
        const float dr = exp2f(128.0f * lg2_gamma(h));
        float s0 = 0.f, s1 = 0.f;
        unsigned uv[16], un[16]; f32x2 dv[16], dn[16];
#define LA4_LOAD(U_, D_, n0_) do { _Pragma("unroll") for (int j = 0; j < 16; ++j) { \
            U_[j] = *(const unsigned*)(up + (size_t)((n0_) + j) * cstride); \
            if (gla) D_[j] = *(const f32x2*)(bc + (size_t)((n0_) + j) * 64); } } while (0)
#define LA4_STEP(U_, D_, n0_) do { _Pragma("unroll") for (int j = 0; j < 16; ++j) { \
            *(unsigned*)(sp + (size_t)((n0_) + j) * cstride) = pk2(s0, s1); \
            const float d0 = gla ? D_[j].x : dr, d1 = gla ? D_[j].y : dr; \
            s0 = d0 * s0 + bflo(U_[j]); s1 = d1 * s1 + bfhi(U_[j]); } } while (0)
        LA4_LOAD(uv, dv, 0);
#pragma unroll 1
        for (int n0 = 0; n0 < LA_NC; n0 += 32) {
            LA4_LOAD(un, dn, n0 + 16);
            LA4_STEP(uv, dv, n0);
            if (n0 + 32 < LA_NC) LA4_LOAD(uv, dv, n0 + 32);
            LA4_STEP(un, dn, n0 + 16);
        }
#undef LA4_LOAD
#undef LA4_STEP
    }
}

template <int DK, bool GLA>
DI void la_pass3_unit(Frame& F, LAS unsigned char* wl, int b, int h, int n, int tq, const bf16_t* SpBase) {
    int lane = F.lane; asm volatile("" : "+v"(lane), "+s"(n), "+s"(tq));
    const int g = lane >> 4, i16 = lane & 15, q = i16 >> 2, p = i16 & 3;
    constexpr int NKS = DK / 32;
    const int r0 = b * SEQ + n * LA_C, t0 = 32 * tq, hd = h * 64;
    const int qcol = GLA ? h * 64 : 1536 + h * 128, kcol = GLA ? 256 + h * 64 : 2048 + h * 128, vcol = (GLA ? 512 : 2560) + h * 128, gcol = (GLA ? 1024 : 3072) + h * 128, ocol = (GLA ? 0 : 512) + h * 128;
    const float lg2 = lg2_gamma(h);
    u32x4 qraw[2][NKS]; f32x4 qb[2][NKS][2]; f32x4 c63[NKS][2];
    u32x4 kraw[2][NKS]; f32x4 kb[2][NKS][2]; u32x4 vraw[8];
#pragma unroll
    for (int tb = 0; tb < 2; ++tb)
#pragma unroll
        for (int ks = 0; ks < NKS; ++ks) {
            const size_t row = (size_t)(r0 + t0 + 16 * tb + i16);
            qraw[tb][ks] = *(const u32x4*)(F.proj + row * NPROJ + qcol + 32 * ks + 8 * g);
            if (GLA) { const float* bp = F.bcum + row * 256 + hd + 32 * ks + 8 * g; qb[tb][ks][0] = *(const f32x4*)bp; qb[tb][ks][1] = *(const f32x4*)(bp + 4); }
        }
    if (GLA) {
#pragma unroll
        for (int ks = 0; ks < NKS; ++ks) { const float* cp = F.bcum + (size_t)(r0 + 63) * 256 + hd + 32 * ks + 8 * g; c63[ks][0] = *(const f32x4*)cp; c63[ks][1] = *(const f32x4*)(cp + 4); }
    }
#define LA3_LOAD_KV(sp_) do { const int rs_ = r0 + 32 * (sp_); \
        _Pragma("unroll") for (int sb = 0; sb < 2; ++sb) _Pragma("unroll") for (int ks = 0; ks < NKS; ++ks) { const size_t row = (size_t)(rs_ + 16 * sb + i16); \
            kraw[sb][ks] = *(const u32x4*)(F.proj + row * NPROJ + kcol + 32 * ks + 8 * g); \
            if (GLA) { const float* bp = F.bcum + row * 256 + hd + 32 * ks + 8 * g; kb[sb][ks][0] = *(const f32x4*)bp; kb[sb][ks][1] = *(const f32x4*)(bp + 4); } } \
        _Pragma("unroll") for (int i = 0; i < 8; ++i) vraw[i] = *(const u32x4*)(F.proj + (size_t)(rs_ + (lane >> 4) + 4 * i) * NPROJ + vcol + 8 * (lane & 15)); } while (0)
    LA3_LOAD_KV(0);
    bf16x8 qf[2][NKS];
#pragma unroll
    for (int tb = 0; tb < 2; ++tb)
#pragma unroll
        for (int ks = 0; ks < NKS; ++ks) {
            if (GLA) {
                float f[8];
#pragma unroll
                for (int j = 0; j < 8; ++j) f[j] = __expf(qb[tb][ks][j >> 2][j & 3] + (t0 >= 64 ? c63[ks][j >> 2][j & 3] : 0.f));
                qf[tb][ks] = scale8(qraw[tb][ks], f);
            } else qf[tb][ks] = scale1(qraw[tb][ks], exp2f((float)(t0 + 16 * tb + i16 + 1) * lg2));
        }
    f32x4 o[2][8];
#pragma unroll
    for (int tb = 0; tb < 2; ++tb)
#pragma unroll
        for (int eb = 0; eb < 8; ++eb) o[tb][eb] = (f32x4){0.f, 0.f, 0.f, 0.f};
    const int vbase = (4 * g + q) * 32 + 8 * p;
#pragma unroll 1
    for (int sp = 0; sp <= tq; ++sp) {
#pragma unroll
        for (int i = 0; i < 8; ++i) { const int tau = (lane >> 4) + 4 * i, ch = lane & 15; *(LAS u32x4*)(wl + (ch >> 1) * 1024 + tau * 32 + (ch & 1) * 16) = vraw[i]; }
        bf16x8 kf[2][NKS];
#pragma unroll
        for (int sb = 0; sb < 2; ++sb)
#pragma unroll
            for (int ks = 0; ks < NKS; ++ks) {
                if (GLA) {
                    float f[8];
#pragma unroll
                    for (int j = 0; j < 8; ++j) f[j] = __expf(-(kb[sb][ks][j >> 2][j & 3] + (sp >= 2 ? c63[ks][j >> 2][j & 3] : 0.f)));
                    kf[sb][ks] = scale8(kraw[sb][ks], f);
                } else kf[sb][ks] = scale1(kraw[sb][ks], exp2f(-(float)(32 * sp + 16 * sb + i16 + 1) * lg2));
            }
        if (sp < tq) LA3_LOAD_KV(sp + 1);
        bf16x8 pf[2];
#pragma unroll
        for (int tb = 0; tb < 2; ++tb) {
            const int T = 2 * tq + tb;
            f32x4 s0 = (f32x4){0.f, 0.f, 0.f, 0.f}, s1 = s0;
#pragma unroll
            for (int ks = 0; ks < NKS; ++ks) {
                s0 = __builtin_amdgcn_mfma_f32_16x16x32_bf16(kf[0][ks], qf[tb][ks], s0, 0, 0, 0);
                s1 = __builtin_amdgcn_mfma_f32_16x16x32_bf16(kf[1][ks], qf[tb][ks], s1, 0, 0, 0);
            }
            const int S0 = 2 * sp, S1 = 2 * sp + 1;
#pragma unroll
            for (int r = 0; r < 4; ++r) {
                const bool keep = (4 * g + r) <= i16;
                if (S0 == T && !keep) s0[r] = 0.f;
                if (S1 > T || (S1 == T && !keep)) s1[r] = 0.f;
            }
            u32x4 pw_; pw_.x = cvt_pk_bf16(s0[0], s0[1]); pw_.y = cvt_pk_bf16(s0[2], s0[3]); pw_.z = cvt_pk_bf16(s1[0], s1[1]); pw_.w = cvt_pk_bf16(s1[2], s1[3]);
            pf[tb] = __builtin_bit_cast(bf16x8, pw_);
        }
#pragma unroll
        for (int eb = 0; eb < 8; ++eb) {
            const bf16x8 vf = tr_pair(wl + eb * 1024 + vbase, wl + eb * 1024 + vbase + 512);
            o[0][eb] = __builtin_amdgcn_mfma_f32_16x16x32_bf16(pf[0], vf, o[0][eb], 0, 0, 0);
            o[1][eb] = __builtin_amdgcn_mfma_f32_16x16x32_bf16(pf[1], vf, o[1][eb], 0, 0, 0);
        }
    }
#undef LA3_LOAD_KV
    u32x4 gt[8];
#pragma unroll
    for (int i = 0; i < 8; ++i) gt[i] = *(const u32x4*)(F.proj + (size_t)(r0 + t0 + 4 * i + (lane >> 4)) * NPROJ + gcol + 8 * (lane & 15));
    const bf16_t* Sp = SpBase + (size_t)n * 128 * DK;
#pragma unroll
    for (int eb = 0; eb < 8; ++eb)
#pragma unroll
        for (int ks = 0; ks < NKS; ++ks) {
            const bf16x8 sf = *(const bf16x8*)(Sp + (size_t)(16 * eb + i16) * DK + 32 * ks + 8 * g);
            o[0][eb] = __builtin_amdgcn_mfma_f32_16x16x32_bf16(qf[0][ks], sf, o[0][eb], 0, 0, 0);
            o[1][eb] = __builtin_amdgcn_mfma_f32_16x16x32_bf16(qf[1][ks], sf, o[1][eb], 0, 0, 0);
        }
#pragma unroll
    for (int tb = 0; tb < 2; ++tb)
#pragma unroll
        for (int r = 0; r < 4; ++r) {
            float mu = 0.f;
            if (!GLA) {
                float s = 0.f;
#pragma unroll
                for (int eb = 0; eb < 8; ++eb) s += o[tb][eb][r];
                s = row16_sum(s);
                mu = s * (1.0f / 128.f);
            }
            float ss = 0.f;
#pragma unroll
            for (int eb = 0; eb < 8; ++eb) { const float dlt = o[tb][eb][r] - mu; o[tb][eb][r] = dlt; ss += dlt * dlt; }
            ss = row16_sum(ss);
            const float rstd = __builtin_amdgcn_rsqf(ss * (1.0f / 128.f) + EPS);
#pragma unroll
            for (int eb = 0; eb < 8; ++eb) *(LAS float*)(wl + ((16 * tb + 4 * g + r) * 128 + 16 * eb + i16) * 4) = o[tb][eb][r] * rstd;
        }
    {
        const int ch = lane & 15; const float* onw = (GLA ? F.gla_onorm : F.ret_onorm) + 8 * ch;
        const f32x4 w0 = *(const f32x4*)onw, w1 = *(const f32x4*)(onw + 4);
#pragma unroll
        for (int i = 0; i < 8; ++i) {
            const int t = 4 * i + (lane >> 4); const size_t row = (size_t)(r0 + t0 + t);
            const f32x4 y0 = *(const LAS f32x4*)(wl + (t * 128 + 8 * ch) * 4), y1 = *(const LAS f32x4*)(wl + (t * 128 + 8 * ch + 4) * 4);
            const u32x4 gg = gt[i];
            float ov[8];
            ov[0] = y0[0] * w0[0] * bflo(gg.x); ov[1] = y0[1] * w0[1] * bfhi(gg.x); ov[2] = y0[2] * w0[2] * bflo(gg.y); ov[3] = y0[3] * w0[3] * bfhi(gg.y);
            ov[4] = y1[0] * w1[0] * bflo(gg.z); ov[5] = y1[1] * w1[1] * bfhi(gg.z); ov[6] = y1[2] * w1[2] * bflo(gg.w); ov[7] = y1[3] * w1[3] * bfhi(gg.w);
            store8_bf16(F.obuf + row * D + ocol + 8 * ch, ov);
        }
    }
}

DI void p5_la_pass3(Frame& F) {
    { int t_ = threadIdx.x; asm volatile("" : "+v"(t_)); F.tid = t_; F.lane = t_ & 63; }
    LAS unsigned char* wl = F.lds + F.wave * 16384;
    const int gw = F.bid * NWAVES + F.wave, NGW = F.G * NWAVES;
    const bf16_t* Sg = (const bf16_t*)(F.ws + WS_SP); const bf16_t* Sr = Sg + U_RET_OFF;
    const int ntask_round = NGW >> 2;
#pragma unroll 1
    for (int i = 0; i * ntask_round < 2048; ++i) {
        const int task = i * ntask_round + (gw >> 2); if (task >= 2048) break;
        const int tq = (gw + i) & 3, type = task & 1, idx = task >> 1, st = idx >> 7, n = idx & 127;
        if (type == 0) la_pass3_unit<64, true>(F, wl, st >> 2, st & 3, n, tq, Sg + (size_t)st * LA_NC * 128 * 64);
        else la_pass3_unit<128, false>(F, wl, st >> 2, st & 3, n, tq, Sr + (size_t)st * LA_NC * 128 * 128);
    }
}

#define DPPF(v, ctrl) __builtin_bit_cast(float, __builtin_amdgcn_update_dpp(__builtin_bit_cast(int, v), __builtin_bit_cast(int, v), ctrl, 0xf, 0xf, false))
DI float row16_max(float v) {
    v = fmaxf(v, DPPF(v, 0xB1)); v = fmaxf(v, DPPF(v, 0x4E)); v = fmaxf(v, DPPF(v, 0x141)); v = fmaxf(v, DPPF(v, 0x140)); return v;
}
DI void p7_router(Frame& F) {
    { int t_ = threadIdx.x; asm volatile("" : "+v"(t_)); F.tid = t_; F.lane = t_ & 63; }
    constexpr int RS = 2064;
    LAS unsigned char* hh = F.lds;
    LAS unsigned char* hlo = F.lds + 16 * RS;
    LAS float* part = (LAS float*)(F.lds + 69632);
    LAS int* hist = (LAS int*)(F.lds + 98304);
    LAS int* basearr = hist + 32;
    LAS int* pinfo = hist + 64;
    LAS float* pwl = (LAS float*)(pinfo + 512);
    const int e = F.lane & 31, g = F.lane >> 4, i16 = F.lane & 15;
    for (int rb = F.bid; rb < M / 128; rb += F.G) {
        const int row0 = rb * 128, b = row0 >= SEQ;
        bf16x8 wh[4][2], wl[4][2];
#pragma unroll
        for (int ks = 0; ks < 4; ++ks)
#pragma unroll
            for (int eb = 0; eb < 2; ++eb) {
                const float* wp = F.w_router + (size_t)(128 * F.wave + 32 * ks + 8 * g) * NE + 16 * eb + i16;
                float w[8];
#pragma unroll
                for (int j = 0; j < 8; ++j) w[j] = wp[j * NE];
                u32x4 hi, lo;
                hi.x = pk2(w[0], w[1]); hi.y = pk2(w[2], w[3]); hi.z = pk2(w[4], w[5]); hi.w = pk2(w[6], w[7]);
                lo.x = pk2(w[0] - bflo(hi.x), w[1] - bfhi(hi.x)); lo.y = pk2(w[2] - bflo(hi.y), w[3] - bfhi(hi.y));
                lo.z = pk2(w[4] - bflo(hi.z), w[5] - bfhi(hi.z)); lo.w = pk2(w[6] - bflo(hi.w), w[7] - bfhi(hi.w));
                wh[ks][eb] = __builtin_bit_cast(bf16x8, hi); wl[ks][eb] = __builtin_bit_cast(bf16x8, lo);
            }
        f32x4 cs[4], sh[4];
#pragma unroll
        for (int j = 0; j < 4; ++j) {
            const f32x4 w = ((const f32x4*)F.norm2)[F.lane + 64 * j], sc = ((const f32x4*)(F.mod + b * 6144 + 4096))[F.lane + 64 * j];
            cs[j] = w * (sc + 1.0f); sh[j] = ((const f32x4*)(F.mod + b * 6144 + 3072))[F.lane + 64 * j];
        }
        const float brt = F.b_router[e];
        if (F.tid < 32) hist[F.tid] = 0;
        f32x4 va[4], vb[4];
#if X1_BF16
        { const u32x2* xa = (const u32x2*)((const bf16_t*)F.x1 + (size_t)(row0 + 2 * F.wave) * D) + F.lane;
#pragma unroll
          for (int j = 0; j < 4; ++j) { va[j] = bf4_to_f32(xa[64 * j]); vb[j] = bf4_to_f32(xa[256 + 64 * j]); } }
#else
        { const f32x4* xa = (const f32x4*)(F.x1 + (size_t)(row0 + 2 * F.wave) * D) + F.lane;
#pragma unroll
          for (int j = 0; j < 4; ++j) { va[j] = xa[64 * j]; vb[j] = xa[256 + 64 * j]; } }
#endif
        __syncthreads();
#pragma unroll 1
        for (int batch = 0; batch < 8; ++batch) {
            {
                const int rl0 = 2 * F.wave, rowa = row0 + batch * 16 + rl0;
                float sa = 0.f, sb = 0.f;
#pragma unroll
                for (int j = 0; j < 4; ++j) { sa += (va[j].x * va[j].x + va[j].y * va[j].y) + (va[j].z * va[j].z + va[j].w * va[j].w); sb += (vb[j].x * vb[j].x + vb[j].y * vb[j].y) + (vb[j].z * vb[j].z + vb[j].w * vb[j].w); }
                const float ra = __builtin_amdgcn_rsqf(wave_sum(sa) * (1.0f / D) + EPS), rbb = __builtin_amdgcn_rsqf(wave_sum(sb) * (1.0f / D) + EPS);
#if MOE_FP8
                unsigned* oa = (unsigned*)((unsigned char*)F.hbuf + (size_t)rowa * D) + F.lane;
#else
                u32x2* oa = (u32x2*)(F.hbuf + (size_t)rowa * D) + F.lane;
#endif
#pragma unroll
                for (int j = 0; j < 4; ++j) {
                    const f32x4 ha = va[j] * ra * cs[j] + sh[j], hb = vb[j] * rbb * cs[j] + sh[j];
#if MOE_FP8
                    oa[64 * j] = pk4_fp8(ha.x * H8_SCALE, ha.y * H8_SCALE, ha.z * H8_SCALE, ha.w * H8_SCALE);
                    oa[256 + 64 * j] = pk4_fp8(hb.x * H8_SCALE, hb.y * H8_SCALE, hb.z * H8_SCALE, hb.w * H8_SCALE);
#else
                    u32x2 p; p.x = pk2(ha.x, ha.y); p.y = pk2(ha.z, ha.w); oa[64 * j] = p;
                    p.x = pk2(hb.x, hb.y); p.y = pk2(hb.z, hb.w); oa[256 + 64 * j] = p;
#endif
                    u32x2 h1, l1, h2_, l2_;
                    h1.x = pk2(ha.x, ha.y); h1.y = pk2(ha.z, ha.w); l1.x = pk2(ha.x - bflo(h1.x), ha.y - bfhi(h1.x)); l1.y = pk2(ha.z - bflo(h1.y), ha.w - bfhi(h1.y));
                    h2_.x = pk2(hb.x, hb.y); h2_.y = pk2(hb.z, hb.w); l2_.x = pk2(hb.x - bflo(h2_.x), hb.y - bfhi(h2_.x)); l2_.y = pk2(hb.z - bflo(h2_.y), hb.w - bfhi(h2_.y));
                    const int co = (4 * F.lane + 256 * j) * 2;
                    *(LAS u32x2*)(hh + rl0 * RS + co) = h1; *(LAS u32x2*)(hlo + rl0 * RS + co) = l1;
                    *(LAS u32x2*)(hh + (rl0 + 1) * RS + co) = h2_; *(LAS u32x2*)(hlo + (rl0 + 1) * RS + co) = l2_;
                }
                if (batch < 7) {
#if X1_BF16
                    const u32x2* xn = (const u32x2*)((const bf16_t*)F.x1 + (size_t)(rowa + 16) * D) + F.lane;
#pragma unroll
                    for (int j = 0; j < 4; ++j) { va[j] = bf4_to_f32(xn[64 * j]); vb[j] = bf4_to_f32(xn[256 + 64 * j]); }
#else
                    const f32x4* xn = (const f32x4*)(F.x1 + (size_t)(rowa + 16) * D) + F.lane;
#pragma unroll
                    for (int j = 0; j < 4; ++j) { va[j] = xn[64 * j]; vb[j] = xn[256 + 64 * j]; }
#endif
                }
            }
            __syncthreads();
            {
                f32x4 acc0 = (f32x4){0.f, 0.f, 0.f, 0.f}, acc1 = acc0;
#pragma unroll
                for (int ks = 0; ks < 4; ++ks) {
                    const int off = i16 * RS + (128 * F.wave + 32 * ks + 8 * g) * 2;
                    const bf16x8 ah = *(const LAS bf16x8*)(hh + off), al = *(const LAS bf16x8*)(hlo + off);
                    acc0 = __builtin_amdgcn_mfma_f32_16x16x32_bf16(ah, wh[ks][0], acc0, 0, 0, 0);
                    acc0 = __builtin_amdgcn_mfma_f32_16x16x32_bf16(ah, wl[ks][0], acc0, 0, 0, 0);
                    acc0 = __builtin_amdgcn_mfma_f32_16x16x32_bf16(al, wh[ks][0], acc0, 0, 0, 0);
                    acc1 = __builtin_amdgcn_mfma_f32_16x16x32_bf16(ah, wh[ks][1], acc1, 0, 0, 0);
                    acc1 = __builtin_amdgcn_mfma_f32_16x16x32_bf16(ah, wl[ks][1], acc1, 0, 0, 0);
                    acc1 = __builtin_amdgcn_mfma_f32_16x16x32_bf16(al, wh[ks][1], acc1, 0, 0, 0);
                }
#pragma unroll
                for (int r = 0; r < 4; ++r) { part[((4 * g + r) * 8 + F.wave) * 32 + i16] = acc0[r]; part[((4 * g + r) * 8 + F.wave) * 32 + 16 + i16] = acc1[r]; }
            }
            __syncthreads();
#pragma unroll
            for (int rr = 0; rr < 2; ++rr) {
                const int rl = 2 * F.wave + rr, rloc = batch * 16 + rl;
                float val = brt;
#pragma unroll
                for (int p = 0; p < 8; ++p) val += part[(rl * 8 + p) * 32 + e];
                if (F.lane >= 32) val = -INFINITY;
                int sel[4]; float sv[4];
#pragma unroll
                for (int k = 0; k < 4; ++k) {
                    const float rm = row16_max(val);
                    const float mx = fmaxf(__builtin_bit_cast(float, __builtin_amdgcn_readlane(__builtin_bit_cast(int, rm), 0)), __builtin_bit_cast(float, __builtin_amdgcn_readlane(__builtin_bit_cast(int, rm), 16)));
                    const unsigned long long bal = __ballot(val == mx && F.lane < 32);
                    const int idx = bal ? (int)__builtin_ctzll(bal) : 0;
                    sel[k] = idx; sv[k] = mx;
                    if (F.lane == idx) val = -INFINITY;
                }
                const float e1 = __expf(sv[1] - sv[0]), e2 = __expf(sv[2] - sv[0]), e3 = __expf(sv[3] - sv[0]);
                const float inv = 1.0f / (1.0f + e1 + e2 + e3);
                if (F.lane < 4) {
                    const int k = F.lane;
                    const int se = k == 0 ? sel[0] : k == 1 ? sel[1] : k == 2 ? sel[2] : sel[3];
                    const float wv = (k == 0 ? 1.0f : k == 1 ? e1 : k == 2 ? e2 : e3) * inv;
                    const int lr = __hip_atomic_fetch_add(hist + se, 1, __ATOMIC_RELAXED, __HIP_MEMORY_SCOPE_WORKGROUP);
                    pinfo[rloc * 4 + k] = se | (lr << 8);
                    pwl[rloc * 4 + k] = wv;
                }
            }
            __syncthreads();
        }
        if (F.tid < 32) basearr[F.tid] = (int)atomicAdd(F.ctl + CW_CNT + 64 * F.tid, (unsigned)hist[F.tid]);
        __syncthreads();
        { const int info = pinfo[F.tid], ee = info & 255, lr = info >> 8; u32x2 rec; rec.x = (unsigned)(row0 * 4 + F.tid); rec.y = __builtin_bit_cast(unsigned, pwl[F.tid]); F.perm[(size_t)ee * ECAP + basearr[ee] + lr] = rec; }
        __syncthreads();
    }
}

DI void moe_order(Frame& F, pg8::MoeOrder& S, int NT, const void* Bt, size_t bstride, int ebytes, int sa, int sb) {
    LAS int* mi = (LAS int*)(F.lds + MISC_OFF);
    LAS int* ud = (LAS int*)(F.lds + UD_OFF);
    if (F.tid < 32) mi[F.tid] = (int)F.ctl[CW_CNT + 64 * F.tid];
    __syncthreads();
    if (F.tid == 0) { int o = 0, tp = 0; for (int i = 0; i < NE; ++i) { mi[32 + i] = o; mi[64 + i] = tp; o += mi[i]; tp += (mi[i] + 255) >> 8; } mi[96] = tp; }
    __syncthreads();
    const int x = F.bid & 7, JB = F.G >> 3, j = F.bid >> 3;
    const int ptot = mi[96], lo = ptot * x / 8, hi = ptot * (x + 1) / 8, U = (hi - lo) * NT;
    if (F.tid < 64) {
        const int q = j + F.tid * JB;
        if (q < U) {
            const int pl = q / NT, pn = q % NT, g = lo + pl;
            int e = 0;
            for (int k = 1; k < NE; ++k) e += (mi[64 + k] <= g) ? 1 : 0;
            const int p = g - mi[64 + e], left = mi[e] - p * 256;
            i32x4_ r; r.x = e | (pn << 8) | (((pn + 2 * pl) & 7) << 16); r.y = left < 256 ? left : 256; r.z = mi[32 + e] + p * 256; r.w = e * ECAP + p * 256;
            *(LAS i32x4_*)(ud + 4 * F.tid) = r;
        }
    }
    __syncthreads();
    const int nu = U > j ? (U - j + JB - 1) / JB : 0;
    S.n = __builtin_amdgcn_readfirstlane(nu < 64 ? nu : 64); S.ud = ud; S.Bt = Bt; S.bstride = bstride; S.ebytes = ebytes; S.sa = sa; S.sb = sb;
}
struct MoeBatch {
    pg8::MoeOrder S; int i0, n;
    DI bool next(int i, pg8::Unit& u) const { if (i >= n) return false; return S.next(i0 + i, u); }
    DI const char* bptr(const pg8::Unit& u) const { return S.bptr(u); }
    DI int scale_a() const { return S.sa; }
    DI int scale_b() const { return S.sb; }
};

DI void p8_gu(Frame& F) {
    { int t_ = threadIdx.x; asm volatile("" : "+v"(t_)); F.tid = t_; F.lane = t_ & 63; }
    pg8::MoeOrder S; moe_order(F, S, 8, F.wgu_t, (size_t)2048 * D, MOE_FP8 ? 1 : 2, H8_E8M0, W8_E8M0);
    LAS unsigned* tbl = (LAS unsigned*)(F.lds + TBL_OFF);
    EpiGU E{F.b_gu, F.act};
    for (int i0 = 0;; i0 += TBL_UNITS) {
        pg8::Unit u; if (!S.next(i0, u)) break;
        int n;
        {
            int t_ = threadIdx.x; asm volatile("" : "+v"(t_));
            const int ln = t_ & 63, half = __builtin_amdgcn_readfirstlane(t_ >> 8), idx = t_ & 255;
            pg8::Unit uk; uk.prow0 = 0; uk.rows = 0;
            const bool ok = ln < TBL_UNITS && S.next_lane(i0 + ln, uk);
            n = __builtin_popcountll(__ballot(ok));
            const int pv = ok ? uk.prow0 : 0, rv = ok ? uk.rows : 0;
            unsigned pr[TBL_UNITS / 2];
#pragma unroll
            for (int it = 0; it < TBL_UNITS / 2; ++it) {
                const int k = 2 * it + half; pr[it] = 0u;
                if (k < n) { const int p0 = __builtin_amdgcn_readlane(pv, k), rw = __builtin_amdgcn_readlane(rv, k); pr[it] = F.perm[p0 + (idx < rw ? idx : 0)].x; }
            }
#pragma unroll
            for (int it = 0; it < TBL_UNITS / 2; ++it) { const int k = 2 * it + half; if (k < n) tbl[k * 256 + idx] = (pr[it] >> 2) * (unsigned)(D * (MOE_FP8 ? 1 : 2)); }
        }
        __syncthreads();
        MoeBatch Bt{S, i0, n};
        pg8::gemm_phase<EpiGU, MoeBatch, true, (MOE_FP8 != 0)>(F.lds, F.hbuf, Bt, E, tbl);
        __syncthreads();
    }
}
DI void p9_down(Frame& F) {
    { int t_ = threadIdx.x; asm volatile("" : "+v"(t_)); F.tid = t_; F.lane = t_ & 63; }
    pg8::MoeOrder S; moe_order(F, S, 4, F.wd_t, (size_t)D * D, MOE_FP8 ? 1 : 2, A8_E8M0, W8_E8M0);
    LAS unsigned* tbl = (LAS unsigned*)(F.lds + TBL_OFF);
    EpiDown E{F.b_down, F.perm, F.Y};
    for (int i0 = 0;; i0 += TBL_UNITS) {
        pg8::Unit u; if (!S.next(i0, u)) break;
        int n = 0;
        for (; n < TBL_UNITS; ++n) {
            if (!S.next(i0 + n, u)) break;
            int t_ = threadIdx.x; asm volatile("" : "+v"(t_));
            if (t_ < 256) tbl[n * 256 + t_] = (unsigned)(u.arow0 + t_) * (unsigned)(D * (MOE_FP8 ? 1 : 2));
        }
        __syncthreads();
        MoeBatch Bt{S, i0, n};
        pg8::gemm_phase<EpiDown, MoeBatch, true, (MOE_FP8 != 0), true>(F.lds, F.act, Bt, E, tbl);
        __syncthreads();
    }
}

DI void p10_final(Frame& F) {
    { int t_ = threadIdx.x; asm volatile("" : "+v"(t_)); F.tid = t_; F.lane = t_ & 63; }
    const int gw = F.bid * NWAVES + F.wave, NGW = F.G * NWAVES;
    f32x4 xv[4], xn[4]; int yv[4][4], yn[4][4];
#if X1_BF16
#define P10_XLOAD(xr_, j_) bf4_to_f32(__builtin_nontemporal_load((const u32x2*)((const bf16_t*)(xr_)) + F.lane + 64 * (j_)))
#else
#define P10_XLOAD(xr_, j_) __builtin_nontemporal_load((const f32x4*)(xr_) + F.lane + 64 * (j_))
#endif
#define P10_LOAD(X_, Y_, m_) do { const void* xr_ = X1_BF16 ? (const void*)((const bf16_t*)F.x1 + (size_t)(m_) * D) : (const void*)(F.x1 + (size_t)(m_) * D); \
        _Pragma("unroll") for (int j = 0; j < 4; ++j) { X_[j] = P10_XLOAD(xr_, j); \
            _Pragma("unroll") for (int k = 0; k < 4; ++k) Y_[j][k] = __builtin_nontemporal_load((const int*)((const unsigned char*)F.Y + ((size_t)(m_) * 4 + k) * D * (Y_FP8 ? 1 : 2)) + F.lane + 64 * j); } } while (0)
    static_assert(Y_FP8, "p10_final reads fp8 rows");
    if (gw < M) P10_LOAD(xv, yv, gw);
    for (int m = gw; m < M; m += NGW) {
        const int b = m >= SEQ;
        if (m + NGW < M) P10_LOAD(xn, yn, m + NGW);
        const f32x4* gr = (const f32x4*)(F.mod + b * 6144 + 5120) + F.lane;
        f32x4 v[4]; float s = 0.f;
#pragma unroll
        for (int j = 0; j < 4; ++j) {
            f32x4 y = (f32x4){0.f, 0.f, 0.f, 0.f};
#pragma unroll
            for (int k = 0; k < 4; ++k) {
                const f32x2 lo = __builtin_amdgcn_cvt_pk_f32_fp8(yv[j][k], false), hi = __builtin_amdgcn_cvt_pk_f32_fp8(yv[j][k], true);
                y += (f32x4){lo.x, lo.y, hi.x, hi.y};
            }
            v[j] = xv[j] + gr[64 * j] * (y * Y8_INV);
            s += (v[j].x * v[j].x + v[j].y * v[j].y) + (v[j].z * v[j].z + v[j].w * v[j].w);
        }
        const float rstd = __builtin_amdgcn_rsqf(wave_sum(s) * (1.0f / D) + EPS);
        f32x4* o = (f32x4*)(F.out + (size_t)m * D) + F.lane;
#pragma unroll
        for (int j = 0; j < 4; ++j) __builtin_nontemporal_store(v[j] * rstd * ((const f32x4*)F.norm_f)[F.lane + 64 * j], o + 64 * j);
#pragma unroll
        for (int j = 0; j < 4; ++j) { xv[j] = xn[j];
#pragma unroll
            for (int k = 0; k < 4; ++k) yv[j][k] = yn[j][k]; }
    }
#undef P10_LOAD
}

constexpr int NPH = 11;
template <int LO, int HI>
__global__ void __launch_bounds__(NTHREADS, 2) fwd_kernel(Args args) {
    extern __shared__ __attribute__((aligned(16))) unsigned char lds[];
    Frame F;
    F.lds = (LAS unsigned char*)lds;
    F.tid = threadIdx.x; F.lane = F.tid & 63; F.wave = __builtin_amdgcn_readfirstlane(F.tid >> 6);
    F.G = gridDim.x; F.bid = blockIdx.x;
    F.x = (const float*)args.in[0]; F.c = (const float*)args.in[1]; F.positions = (const int*)args.in[2]; F.w_ada = (const float*)args.in[3]; F.b_ada = (const float*)args.in[4];
    F.norm1 = (const float*)args.in[5]; F.w_in = (const float*)args.in[6]; F.w_gk2 = (const float*)args.in[7]; F.b_gk = (const float*)args.in[8]; F.gla_onorm = (const float*)args.in[9];
    F.ret_onorm = (const float*)args.in[10]; F.w_out = (const float*)args.in[11]; F.norm2 = (const float*)args.in[12]; F.w_router = (const float*)args.in[13]; F.b_router = (const float*)args.in[14];
    F.w_gu = (const float*)args.in[15]; F.b_gu = (const float*)args.in[16]; F.w_down = (const float*)args.in[17]; F.b_down = (const float*)args.in[18]; F.norm_f = (const float*)args.in[19];
    F.out = args.out; F.ws = args.ws;
    unsigned char* ws = args.ws;
    F.ctl = (unsigned*)(ws + WS_CTL); F.mod = (float*)(ws + WS_MOD); F.win_t = (bf16_t*)(ws + WS_WIN); F.wout_t = (bf16_t*)(ws + WS_WOUT); F.wgu_t = (bf16_t*)(ws + WS_WGU); F.wd_t = (bf16_t*)(ws + WS_WD);
    F.hbuf = (bf16_t*)(ws + WS_H); F.obuf = (bf16_t*)(ws + WS_O); F.proj = (bf16_t*)(ws + WS_PROJ); F.act = (bf16_t*)(ws + WS_ACT); F.Y = (bf16_t*)(ws + WS_Y);
    F.x1 = (float*)(ws + WS_X1); F.bcum = (float*)(ws + WS_BCUM); F.pw = (float*)(ws + WS_PW); F.perm = (u32x2*)(ws + WS_PERM);

#define IN(k) (LO <= (k) && (k) < HI)
#if ONE_LAUNCH && USE_CG_SYNC
#define GSYNC(k) do { if (IN(k) && IN((k) + 1)) { cg::this_grid().sync(); } } while (0)
#elif ONE_LAUNCH
    { volatile LAS unsigned* st = (volatile LAS unsigned*)(F.lds + MISC_OFF + 512); if (F.tid < 2) st[F.tid] = 0u; }
    __syncthreads();
    const XcdBarrier bar = xcd_barrier_post(F.ctl + CW_BAR, (volatile LAS unsigned*)(F.lds + MISC_OFF + 512));
#define GSYNC(k) do { if (IN(k) && IN((k) + 1)) { xcd_barrier(bar); } } while (0)
#else
#define GSYNC(k) do { } while (0)
#endif
    if (IN(0)) { p0_prep(F); if (DUP(0)) p0_prep(F); } GSYNC(0);
    if (IN(1)) { p1_h1(F); if (DUP(1)) p1_h1(F); } GSYNC(1);
    if (IN(2)) {
        pg8::DenseOrder S; S.init(M, NIN_T, F.G, F.bid, F.win_t);
        EpiProj E{F.proj, F.bcum, F.positions, F.b_gk};
        pg8::gemm_phase<EpiProj, pg8::DenseOrder, false>(F.lds, F.hbuf, S, E, nullptr);
        if (DUP(2)) pg8::gemm_phase<EpiProj, pg8::DenseOrder, false>(F.lds, F.hbuf, S, E, nullptr);
        { pg8::Unit u8; if (F.G == 256 && !S.next(7, u8)) {
            { int t_ = threadIdx.x; asm volatile("" : "+v"(t_)); F.tid = t_; F.lane = t_ & 63; }
            const int nidle = F.G - (1920 - 7 * F.G), widx = (F.bid - (1920 - 7 * F.G)) * NWAVES + F.wave;
            if (nidle > 0 && widx >= 0) tr_range(F, (LAS float*)(F.lds + 16384 + F.wave * 8704), TR_SPLIT1, TR_SPLIT2, widx, nidle * NWAVES); } }
    } GSYNC(2);
#if NAIVE_LA
    if (IN(3)) { p3_la_naive(F); } GSYNC(3);
    GSYNC(4);
    GSYNC(5);
#else
    if (IN(3)) { p3_la_pass1(F); if (DUP(3)) p3_la_pass1(F); } GSYNC(3);
    if (IN(4)) { p4_la_scan(F); if (DUP(4)) p4_la_scan(F); } GSYNC(4);
    if (IN(5)) { p5_la_pass3(F); if (DUP(5)) p5_la_pass3(F); } GSYNC(5);
#endif
    if (IN(6)) {
        pg8::DenseOrder S; S.init(M, D, F.G, F.bid, F.wout_t);
        EpiRes1 E{F.x, F.mod, F.x1};
        pg8::gemm_phase<EpiRes1, pg8::DenseOrder, false, false, true>(F.lds, F.obuf, S, E, nullptr);
        if (DUP(6)) pg8::gemm_phase<EpiRes1, pg8::DenseOrder, false, false, true>(F.lds, F.obuf, S, E, nullptr);
    } GSYNC(6);
    if (IN(7)) { p7_router(F); } GSYNC(7);
    if (IN(8)) { p8_gu(F); if (DUP(8)) p8_gu(F); } GSYNC(8);
    if (IN(9)) { p9_down(F); if (DUP(9)) p9_down(F); } GSYNC(9);
    if (IN(10)) { p10_final(F); if (DUP(10)) p10_final(F); }
}

extern "C" void kernel_launch(void* const* d_in, const int* in_sizes, int n_in, void* d_out, int out_size, void* d_ws, size_t ws_size, hipStream_t stream) {
    static int grid = 0;
    if (grid == 0) {
        if (n_in != 20 || out_size != M * D || ws_size < WS_END) { fprintf(stderr, "kernel_launch: unexpected shapes (n_in %d out %d ws %zu)\n", n_in, out_size, ws_size); grid = -1; return; }
        int dev = 0, cus = 0, per_cu = 0;
        hipGetDevice(&dev); hipDeviceGetAttribute(&cus, hipDeviceAttributeMultiprocessorCount, dev);
#if ONE_LAUNCH
        hipFuncSetAttribute((const void*)fwd_kernel<0, NPH>, hipFuncAttributeMaxDynamicSharedMemorySize, LDS_BYTES);
        hipOccupancyMaxActiveBlocksPerMultiprocessor(&per_cu, (const void*)fwd_kernel<0, NPH>, NTHREADS, LDS_BYTES);
#else
        per_cu = 1;
#define SETATTR(k) hipFuncSetAttribute((const void*)fwd_kernel<k, k + 1>, hipFuncAttributeMaxDynamicSharedMemorySize, LDS_BYTES)
        SETATTR(0); SETATTR(1); SETATTR(2); SETATTR(3); SETATTR(4); SETATTR(5); SETATTR(6); SETATTR(7); SETATTR(8); SETATTR(9); SETATTR(10);
#endif
        (void)hipGetLastError();
        if (per_cu < 1) { fprintf(stderr, "kernel_launch: occupancy query says %d blocks/CU\n", per_cu); per_cu = 1; }
        grid = cus;
        if (grid != 256) fprintf(stderr, "kernel_launch: %d CUs (expected 256)\n", grid);
    }
    if (grid < 0) return;
    hipMemsetAsync((char*)d_ws + WS_CTL, 0, CTL_ZERO_BYTES, stream);
    Args a{};
    for (int i = 0; i < 20; ++i) a.in[i] = d_in[i];
    a.out = (float*)d_out; a.ws = (unsigned char*)d_ws;
#if ONE_LAUNCH
    a.ph_lo = 0; a.ph_hi = NPH;
#if USE_CG_SYNC
    void* params[] = {&a};
    hipError_t e = hipLaunchCooperativeKernel((const void*)fwd_kernel<0, NPH>, dim3(grid), dim3(NTHREADS), params, LDS_BYTES, stream);
    if (e != hipSuccess) fprintf(stderr, "cooperative launch failed: %s (grid %d)\n", hipGetErrorString(e), grid);
#else
    hipLaunchKernelGGL((fwd_kernel<0, NPH>), dim3(grid), dim3(NTHREADS), LDS_BYTES, stream, a);
#endif
#else
#define LAUNCH(k) hipLaunchKernelGGL((fwd_kernel<k, k + 1>), dim3(grid), dim3(NTHREADS), LDS_BYTES, stream, a)
    LAUNCH(0); LAUNCH(1); LAUNCH(2); LAUNCH(3); LAUNCH(4); LAUNCH(5); LAUNCH(6); LAUNCH(7); LAUNCH(8); LAUNCH(9); LAUNCH(10);
#endif
}
```

```cpp
#include <hip/hip_runtime.h>
#include <hip/hip_cooperative_groups.h>
#include <cstdio>
#include <cstdint>
namespace cg = cooperative_groups;

#ifndef ONE_LAUNCH
#define ONE_LAUNCH 1
#endif
#ifndef USE_CG_SYNC
#define USE_CG_SYNC 0
#endif
#ifndef PROBE_DUP
#define PROBE_DUP -1
#endif
#define DUP(k) (PROBE_DUP == (k))
#ifndef MOE_FP8
#define MOE_FP8 1
#endif
#ifndef Y_FP8
#define Y_FP8 1
#endif
#ifndef X1_BF16
#define X1_BF16 1
#endif
#ifndef NAIVE_LA
#define NAIVE_LA 0
#endif

#define LAS __attribute__((address_space(3)))
#define DI __device__ __forceinline__
typedef unsigned short bf16_t;
typedef short bf16x8 __attribute__((ext_vector_type(8)));
typedef float f32x4 __attribute__((ext_vector_type(4)));
typedef float f32x2 __attribute__((ext_vector_type(2)));
typedef unsigned u32x4 __attribute__((ext_vector_type(4)));
typedef unsigned u32x2 __attribute__((ext_vector_type(2)));
typedef int i32x4 __attribute__((ext_vector_type(4)));
typedef int i32x8 __attribute__((ext_vector_type(8)));

constexpr int D = 1024, BATCH = 2, SEQ = 16384, M = BATCH * SEQ;
constexpr int NPROJ = 3584;
constexpr int NIN_T = 3840;
constexpr int MIX_IN = 3600;
constexpr int NE = 32, TOPK = 4, NPAIR = M * TOPK;
constexpr int ECAP = 32768;
constexpr float EPS = 1e-6f;
constexpr int NWAVES = 8, NTHREADS = 512;

constexpr size_t MiB = 1u << 20;
constexpr size_t WS_CTL = 0, CTL_ZERO_BYTES = 65536;
constexpr size_t WS_MOD = 1 * MiB;
constexpr size_t WS_DEC = 1 * MiB + 65536;
constexpr size_t WS_WIN = 2 * MiB;
constexpr size_t WS_WOUT = 10 * MiB;
constexpr size_t WS_WGU = 12 * MiB;
constexpr size_t WS_WD = 140 * MiB;
constexpr size_t WS_H = 204 * MiB;
constexpr size_t WS_O = 268 * MiB;
constexpr size_t WS_X1 = 332 * MiB;
constexpr size_t WS_PROJ = 460 * MiB;
constexpr size_t WS_BCUM = 684 * MiB;
constexpr size_t WS_U = 716 * MiB;
constexpr size_t WS_SP = 812 * MiB;
constexpr size_t WS_ACT = 460 * MiB;
constexpr size_t WS_Y = 717 * MiB;
constexpr size_t WS_PERM = 973 * MiB;
constexpr size_t WS_PW = 981 * MiB;
constexpr size_t WS_END = 982 * MiB;
constexpr int CW_CNT = 1024;
constexpr int CW_BAR = 8192;

constexpr int RING_BYTES = 131072;
constexpr int TBL_OFF = RING_BYTES, TBL_UNITS = 22, UD_OFF = TBL_OFF + TBL_UNITS * 1024, TBL_BYTES = 24 * 1024;
constexpr int MISC_OFF = TBL_OFF + TBL_BYTES;
constexpr int EPI_OFF = MISC_OFF + 1024;
constexpr int LDS_BYTES = EPI_OFF + 4096;

DI unsigned f2bf(float f) { unsigned u = __builtin_bit_cast(unsigned, f); return (u + 0x7fffu + ((u >> 16) & 1u)) >> 16; }
DI unsigned pk2(float lo, float hi) { return f2bf(lo) | (f2bf(hi) << 16); }
DI float bf2f(unsigned h) { return __builtin_bit_cast(float, h << 16); }
DI float bflo(unsigned w) { return __builtin_bit_cast(float, w << 16); }
DI float bfhi(unsigned w) { return __builtin_bit_cast(float, w & 0xffff0000u); }
DI f32x4 bf4_to_f32(u32x2 w) { return (f32x4){bflo(w.x), bfhi(w.x), bflo(w.y), bfhi(w.y)}; }
DI unsigned cvt_pk_bf16(float lo, float hi) { unsigned r; asm volatile("v_cvt_pk_bf16_f32 %0, %1, %2" : "=v"(r) : "v"(lo), "v"(hi)); return r; }
#define DPPF_(v, ctrl) __builtin_bit_cast(float, __builtin_amdgcn_update_dpp(__builtin_bit_cast(int, v), __builtin_bit_cast(int, v), ctrl, 0xf, 0xf, false))
DI float row16_sum(float v) {
    v += DPPF_(v, 0xB1); v += DPPF_(v, 0x4E); v += DPPF_(v, 0x141); v += DPPF_(v, 0x140); return v;
}
DI float wave_sum(float v) {
    v = row16_sum(v);
    const int iv = __builtin_bit_cast(int, v);
    const float a = __builtin_bit_cast(float, __builtin_amdgcn_readlane(iv, 0)), b = __builtin_bit_cast(float, __builtin_amdgcn_readlane(iv, 16));
    const float c = __builtin_bit_cast(float, __builtin_amdgcn_readlane(iv, 32)), d = __builtin_bit_cast(float, __builtin_amdgcn_readlane(iv, 48));
    return (a + b) + (c + d);
}
DI float wave_max(float v) {
#pragma unroll
    for (int o = 1; o < 64; o <<= 1) v = fmaxf(v, __shfl_xor(v, o));
    return v;
}
DI float sigmoidf_(float x) { return __builtin_amdgcn_rcpf(1.0f + __builtin_amdgcn_exp2f(-1.4426950408889634f * x)); }
DI float logsigmoidf_(float x) { return fminf(x, 0.f) - 0.6931471805599453f * __builtin_amdgcn_logf(1.0f + __builtin_amdgcn_exp2f(-1.4426950408889634f * fabsf(x))); }
#define LDS_WAIT() asm volatile("s_waitcnt lgkmcnt(0)" ::: "memory")
DI unsigned pk4_fp8(float a, float b, float c, float d) {
    a = __builtin_amdgcn_fmed3f(a, -448.f, 448.f); b = __builtin_amdgcn_fmed3f(b, -448.f, 448.f); c = __builtin_amdgcn_fmed3f(c, -448.f, 448.f); d = __builtin_amdgcn_fmed3f(d, -448.f, 448.f);
    int p = __builtin_amdgcn_cvt_pk_fp8_f32(a, b, 0, false); p = __builtin_amdgcn_cvt_pk_fp8_f32(c, d, p, true); return (unsigned)p;
}
DI unsigned pk4_fp8_nc(float a, float b, float c, float d) { int p = __builtin_amdgcn_cvt_pk_fp8_f32(a, b, 0, false); p = __builtin_amdgcn_cvt_pk_fp8_f32(c, d, p, true); return (unsigned)p; }
constexpr float Y8_SCALE = 32.f, Y8_INV = 1.0f / 32.f;
constexpr float W8_SCALE = 512.f, H8_SCALE = 16.f, A8_SCALE = 4.f;
constexpr int W8_E8M0 = 0x76767676, H8_E8M0 = 0x7B7B7B7B, A8_E8M0 = 0x7D7D7D7D;

typedef int i32x4_ __attribute__((ext_vector_type(4)));
namespace pg8 {
constexpr int BM = 256, BK = 64, HALF = 128, HTB = HALF * BK * 2, STAGE_BYTES = 8 * HTB, NXCD = 8, WGM = 8, K = 1024;
__host__ __device__ __forceinline__ int lds_byte(int r, int c) { const int st = (r >> 4) * 2 + (c >> 5), rr = r & 15, cc = c & 31, ob = rr * 64 + cc * 2; return st * 1024 + (ob ^ (((ob >> 9) & 1) << 5)); }
__host__ __device__ __forceinline__ void stage_rc(int b, int& R, int& C) { const int st = b / 1024, sb = b % 1024, swz = sb ^ (((sb >> 9) & 1) << 5); R = (st >> 1) * 16 + swz / 64; C = (st & 1) * 32 + (swz % 64) / 2; }
__host__ __device__ __forceinline__ int perm32(int rho) { const int n = rho >> 4, i = rho & 15; return 8 * (i >> 2) + 4 * n + (i & 3); }

struct Unit { int arow0, pn, e, rows, prow0, rot; };

struct DenseOrder {
    int nM, nN, nwg, G, c;
    const bf16_t* Bt;
    DI void init(int M_, int N_, int G_, int c_, const bf16_t* Bt_) { nM = M_ / BM; nN = N_ / BM; nwg = nM * nN; G = G_; c = c_; Bt = Bt_; }
    DI bool next(int i, Unit& u) const {
        const long L = (long)i * G + c; if (L >= nwg) return false;
        int wgid = (int)L; { const int q = nwg / NXCD, r = nwg % NXCD, xcd = wgid % NXCD, off = wgid / NXCD; wgid = (xcd < r ? xcd * (q + 1) : r * (q + 1) + (xcd - r) * q) + off; }
        const int nig = WGM * nN, gid = wgid / nig, fm = gid * WGM, gsz = (nM - fm) < WGM ? (nM - fm) : WGM;
        const int pm = fm + ((wgid % nig) % gsz); u.pn = (wgid % nig) / gsz; u.arow0 = pm * BM; u.e = 0; u.rows = BM; u.prow0 = 0; u.rot = (pm + 3 * u.pn) & 15; return true;
    }
    DI const char* bptr(const Unit& u) const { return (const char*)Bt + (size_t)u.pn * BM * K * 2; }
    DI int scale_a() const { return 0x7f7f7f7f; }
    DI int scale_b() const { return 0x7f7f7f7f; }
};

struct MoeOrder {
    int n;
    const LAS int* ud;
    const void* Bt; size_t bstride;
    int ebytes, sa, sb;
    DI bool next(int i, Unit& u) const {
        if (i >= n) return false;
        const i32x4_ r = *(const LAS i32x4_*)(ud + 4 * i);
        const int r0 = __builtin_amdgcn_readfirstlane(r.x);
        u.e = r0 & 255; u.pn = (r0 >> 8) & 255; u.rot = r0 >> 16;
        u.rows = __builtin_amdgcn_readfirstlane(r.y); u.arow0 = __builtin_amdgcn_readfirstlane(r.z); u.prow0 = __builtin_amdgcn_readfirstlane(r.w); return true;
    }
    DI bool next_lane(int i, Unit& u) const {
        if (i >= n) return false;
        const i32x4_ r = *(const LAS i32x4_*)(ud + 4 * i);
        u.e = r.x & 255; u.pn = (r.x >> 8) & 255; u.rot = r.x >> 16; u.rows = r.y; u.arow0 = r.z; u.prow0 = r.w; return true;
    }
    DI const char* bptr(const Unit& u) const { return (const char*)Bt + ((size_t)u.e * bstride + (size_t)u.pn * BM * K) * ebytes; }
    DI int scale_a() const { return sa; }
    DI int scale_b() const { return sb; }
};

DI const char* uniform_ptr(const char* p) {
    const unsigned long long v = (unsigned long long)p;
    const unsigned lo = __builtin_amdgcn_readfirstlane((unsigned)v), hi = __builtin_amdgcn_readfirstlane((unsigned)(v >> 32));
    return (const char*)(((unsigned long long)hi << 32) | lo);
}
template <class Epi, class Sched, bool GATHER, bool FP8 = false, bool BMAP16 = false>
DI void gemm_phase(LAS unsigned char* lds, const bf16_t* Abase, const Sched& S, const Epi& E, const LAS unsigned* tbl) {
    int tid = threadIdx.x; asm volatile("" : "+v"(tid));
    const int wid = __builtin_amdgcn_readfirstlane(tid >> 6), lane = tid & 63, wr = wid >> 2, wc = wid & 3, fr = lane & 15, fq = lane >> 4;
    constexpr int KB = FP8 ? K : 2 * K;
    constexpr int nt = KB / 128;
    unsigned voffB[2]; int Rr[2], Cc[2];
#pragma unroll
    for (int i = 0; i < 2; ++i) { int R, C; stage_rc(tid * 16 + i * 8192, R, C);
        const int Rb = BMAP16 ? (64 * (R >> 5) + 16 * ((R & 15) >> 2) + 4 * ((R >> 4) & 1) + (R & 3)) : ((R & ~31) + perm32(R & 31));
        voffB[i] = (unsigned)(Rb * KB + C * 2); Rr[i] = R; Cc[i] = C; }
    const size_t kstep = (size_t)(BK * 2);
    const size_t hstep = BMAP16 ? (size_t)8 * KB : (size_t)HALF * KB;
    const unsigned ldsw = (unsigned)wid * 1024u;
    const int aoff = lds_byte(wr * 64 + fr, fq * 8), boff = lds_byte(wc * 32 + fr, fq * 8);
#define PG8_SA(b, h) (((b) * 2 + (h)) * HTB)
#define PG8_SB(b, h) ((4 + (b) * 2 + (h)) * HTB)
#define PG8_STAGE2(bufoff, gbase, v0, v1) do { \
        __builtin_amdgcn_global_load_lds((const unsigned*)((const char*)(gbase) + (v0)), (LAS unsigned*)(lds + (bufoff) + ldsw), 16, 0, 0); \
        __builtin_amdgcn_global_load_lds((const unsigned*)((const char*)(gbase) + (v1)), (LAS unsigned*)(lds + (bufoff) + ldsw + 8192), 16, 0, 0); } while (0)
#define PG8_STAGEB(bufoff, gbase) PG8_STAGE2(bufoff, gbase, voffB[0], voffB[1])
#define PG8_RD16(off) (*(const LAS i32x4*)(lds + (off)))
#define PG8_LDA(dst, b, h) do { if constexpr (FP8) { _Pragma("unroll") for (int m = 0; m < 4; ++m) dst##8[m] = __builtin_shufflevector(PG8_RD16(PG8_SA(b, h) + aop + m * 2048), PG8_RD16(PG8_SA(b, h) + aop + m * 2048 + 1024), 0, 1, 2, 3, 4, 5, 6, 7); } \
        else { _Pragma("unroll") for (int m = 0; m < 4; ++m) _Pragma("unroll") for (int k = 0; k < 2; ++k) dst[m][k] = *(const LAS bf16x8*)(lds + PG8_SA(b, h) + aoff + m * 2048 + k * 1024); } } while (0)
#define PG8_LDB(dst, b, h) do { if constexpr (FP8) { _Pragma("unroll") for (int n = 0; n < 2; ++n) dst##8[n] = __builtin_shufflevector(PG8_RD16(PG8_SB(b, h) + bop + n * 2048), PG8_RD16(PG8_SB(b, h) + bop + n * 2048 + 1024), 0, 1, 2, 3, 4, 5, 6, 7); } \
        else { _Pragma("unroll") for (int n = 0; n < 2; ++n) _Pragma("unroll") for (int k = 0; k < 2; ++k) dst[n][k] = *(const LAS bf16x8*)(lds + PG8_SB(b, h) + boff + n * 2048 + k * 1024); } } while (0)
#define PG8_MMA(ai, bj, At, Bt) do { __builtin_amdgcn_s_setprio(1); \
        if constexpr (FP8) { _Pragma("unroll") for (int m = 0; m < 4; ++m) _Pragma("unroll") for (int n = 0; n < 2; ++n) \
            acc[ai][bj][m][n] = __builtin_amdgcn_mfma_scale_f32_16x16x128_f8f6f4(Bt##8[n], At##8[m], acc[ai][bj][m][n], 0, 0, 0, sclB, 0, sclA); } \
        else { _Pragma("unroll") for (int m = 0; m < 4; ++m) _Pragma("unroll") for (int n = 0; n < 2; ++n) _Pragma("unroll") for (int k = 0; k < 2; ++k) \
            acc[ai][bj][m][n] = __builtin_amdgcn_mfma_f32_16x16x32_bf16(Bt[n][k], At[m][k], acc[ai][bj][m][n], 0, 0, 0); } \
        __builtin_amdgcn_s_setprio(0); } while (0)
#define PG8_WAIT_V(n) asm volatile("s_waitcnt vmcnt(" #n ")" ::: "memory")
#define PG8_WAIT_L(n) asm volatile("s_waitcnt lgkmcnt(" #n ")" ::: "memory")
#define PG8_BAR __builtin_amdgcn_s_barrier()
#define PG8_SCHED __builtin_amdgcn_sched_barrier(0)
#define PG8_LOADVA(dst00, dst01, dst10, dst11, ui_) do { \
        if constexpr (GATHER) { const LAS unsigned* t_ = tbl + (ui_) * 256; \
            dst00 = t_[Rr[0]] + (unsigned)Cc[0] * 2u; dst01 = t_[Rr[1]] + (unsigned)Cc[1] * 2u; dst10 = t_[128 + Rr[0]] + (unsigned)Cc[0] * 2u; dst11 = t_[128 + Rr[1]] + (unsigned)Cc[1] * 2u; } \
        else { dst00 = (unsigned)(Rr[0] * KB + Cc[0] * 2); dst01 = (unsigned)(Rr[1] * KB + Cc[1] * 2); dst10 = (unsigned)((128 + Rr[0]) * KB + Cc[0] * 2); dst11 = (unsigned)((128 + Rr[1]) * KB + Cc[1] * 2); } } while (0)
    Unit cur, nxt; int ui = 0;
    if (!S.next(0, cur)) return;
    f32x4 acc[2][2][4][2];
    f32x4 bia[2][2];
    E.bias(cur, wc, fq, bia);
    u32x2 pre;
    E.pre_load(cur, tid, pre);
    bf16x8 At[4][2], B0[2][2], B1[2][2];
    i32x8 At8[4], B08[2], B18[2];
    const int sclA = S.scale_a(), sclB = S.scale_b();
    unsigned vA00, vA01, vA10, vA11;
    PG8_LOADVA(vA00, vA01, vA10, vA11, 0);
    const char* cA = GATHER ? (const char*)Abase : (const char*)Abase + (size_t)cur.arow0 * KB;
    const char* cB = S.bptr(cur);
#define PG8_KOFF(rot_, i_) ((size_t)(((i_) + (rot_)) & (nt - 1)) * kstep)
    { const size_t k0_ = PG8_KOFF(cur.rot, 0);
    PG8_STAGEB(PG8_SB(0, 0), cB + k0_); PG8_STAGEB(PG8_SB(0, 1), cB + hstep + k0_); PG8_STAGE2(PG8_SA(0, 0), cA + k0_, vA00, vA01); PG8_STAGE2(PG8_SA(0, 1), cA + k0_, vA10, vA11); }
#define PG8_ACC_INIT() do { _Pragma("unroll") for (int a = 0; a < 2; ++a) _Pragma("unroll") for (int b = 0; b < 2; ++b) _Pragma("unroll") for (int m = 0; m < 4; ++m) _Pragma("unroll") for (int n = 0; n < 2; ++n) acc[a][b][m][n] = bia[b][n]; } while (0)
    PG8_ACC_INIT();
    E.pre_store(pre, tid, lds + EPI_OFF);
    if (wr == 1) PG8_BAR;
    PG8_WAIT_V(2); PG8_BAR;
    { const size_t k1_ = PG8_KOFF(cur.rot, 1);
    PG8_STAGEB(PG8_SB(1, 0), cB + k1_); PG8_STAGE2(PG8_SA(1, 0), cA + k1_, vA00, vA01); PG8_STAGEB(PG8_SB(1, 1), cB + hstep + k1_); }
    PG8_WAIT_V(6); PG8_BAR;
    for (;;) {
        const bool has_next = S.next(ui + 1, nxt);
        const char* nA = cA; const char* nB = cB;
        if (has_next) { nB = S.bptr(nxt); if constexpr (!GATHER) nA = (const char*)Abase + (size_t)nxt.arow0 * KB; }
        const int nrot = has_next ? nxt.rot : cur.rot;
#pragma unroll 1
        for (int t = 0; t < nt; t += 2) {
            const bool last = (t == nt - 2);
            int aop = aoff, bop = boff; asm volatile("" : "+v"(aop), "+v"(bop));
            const size_t o1 = PG8_KOFF(cur.rot, t + 1), o2 = last ? PG8_KOFF(nrot, 0) : PG8_KOFF(cur.rot, t + 2), o3 = last ? PG8_KOFF(nrot, 1) : PG8_KOFF(cur.rot, t + 3);
            const char* a1 = cA + o1; const char* b1x = cB + o1;
            const char* a2 = (last ? nA : cA) + o2; const char* b2 = (last ? nB : cB) + o2;
            const char* a3 = (last ? nA : cA) + o3; const char* b3 = (last ? nB : cB) + o3;
            (void)b1x;
            PG8_LDB(B0, 0, 0); PG8_LDB(B1, 0, 1); PG8_SCHED; PG8_LDA(At, 0, 0); PG8_STAGE2(PG8_SA(1, 1), a1, vA10, vA11);
            if constexpr (GATHER) { if (last && has_next) PG8_LOADVA(vA00, vA01, vA10, vA11, ui + 1); }
            PG8_WAIT_V(8); PG8_WAIT_L(0); PG8_BAR; PG8_MMA(0, 0, At, B0); PG8_MMA(0, 1, At, B1); PG8_BAR; PG8_SCHED;
            PG8_LDA(At, 0, 1); PG8_STAGEB(PG8_SB(0, 0), b2); PG8_STAGEB(PG8_SB(0, 1), b2 + hstep); PG8_STAGE2(PG8_SA(0, 0), a2, vA00, vA01);
            PG8_WAIT_V(8); PG8_WAIT_L(0); PG8_BAR; PG8_MMA(1, 0, At, B0); PG8_MMA(1, 1, At, B1); PG8_BAR; PG8_SCHED;
            PG8_LDB(B0, 1, 0); PG8_LDB(B1, 1, 1); PG8_SCHED; PG8_LDA(At, 1, 0); PG8_STAGE2(PG8_SA(0, 1), a2, vA10, vA11);
            PG8_WAIT_V(8); PG8_WAIT_L(0); PG8_BAR; PG8_MMA(0, 0, At, B0); PG8_MMA(0, 1, At, B1); PG8_BAR; PG8_SCHED;
            PG8_LDA(At, 1, 1); PG8_STAGEB(PG8_SB(1, 0), b3); PG8_STAGEB(PG8_SB(1, 1), b3 + hstep); PG8_STAGE2(PG8_SA(1, 0), a3, vA00, vA01);
            PG8_WAIT_V(8); PG8_WAIT_L(0); PG8_BAR; PG8_MMA(1, 0, At, B0); PG8_MMA(1, 1, At, B1); PG8_BAR; PG8_SCHED;
        }
        if (wr == 0) PG8_BAR;
        if (has_next) { E.bias(nxt, wc, fq, bia); E.pre_load(nxt, tid, pre); }
        E(acc, cur, lds + EPI_OFF + (ui & 1) * 2048, wr, wc, fr, fq);
        if (!has_next) break;
        PG8_ACC_INIT();
        E.pre_store(pre, tid, lds + EPI_OFF + ((ui + 1) & 1) * 2048);
        cur = nxt; cA = nA; cB = nB; ++ui;
        if (wr == 1) PG8_BAR;
    }
    PG8_WAIT_V(0);
    PG8_BAR;
#undef PG8_SA
#undef PG8_SB
#undef PG8_STAGE2
#undef PG8_STAGEB
#undef PG8_LDA
#undef PG8_LDB
#undef PG8_MMA
#undef PG8_RD16
#undef PG8_WAIT_V
#undef PG8_WAIT_L
#undef PG8_BAR
#undef PG8_SCHED
#undef PG8_LOADVA
#undef PG8_KOFF
#undef PG8_ACC_INIT
}
}

typedef f32x4 AccT[2][2][4][2];

DI void store8_bf16(bf16_t* p, const float* v) {
    u32x4 w; w.x = cvt_pk_bf16(v[0], v[1]); w.y = cvt_pk_bf16(v[2], v[3]); w.z = cvt_pk_bf16(v[4], v[5]); w.w = cvt_pk_bf16(v[6], v[7]);
    *(u32x4*)p = w;
}
DI float dpp_shr_f(float x, int ctrl_sel);

struct EpiProj {
    bf16_t* proj; float* bcum; const int* pos; const float* bgk;
    DI void bias(const pg8::Unit& u, int wc, int fq, f32x4 (&bia)[2][2]) const {
        bia[0][0] = bia[0][1] = bia[1][0] = bia[1][1] = (f32x4){0.f, 0.f, 0.f, 0.f};
        if (u.pn == 14) { const float* b = bgk + wc * 32 + 8 * fq; bia[0][0] = *(const f32x4*)b; bia[0][1] = *(const f32x4*)(b + 4); bia[1][0] = *(const f32x4*)(b + 128); bia[1][1] = *(const f32x4*)(b + 132); }
    }
    DI void pre_load(const pg8::Unit& u, int tid, u32x2& pre) const { if (u.pn >= 6 && u.pn <= 9 && tid < 256) pre.x = (unsigned)pos[u.arow0 + tid]; }
    DI void pre_store(const u32x2& pre, int tid, LAS unsigned char* buf) const { if (tid < 256) *(LAS unsigned*)(buf + tid * 4) = pre.x; }
    DI void operator()(const AccT& acc, const pg8::Unit& u, const LAS unsigned char* ebuf, int wr, int wc, int fr, int fq) const {
        const int pn = u.pn, cl = wc * 32 + 8 * fq, row0 = u.arow0 + wr * 64 + fr;
        if (pn == 14) {
            const int lane = threadIdx.x & 63;
#pragma unroll
            for (int ai = 0; ai < 2; ++ai)
#pragma unroll
                for (int bj = 0; bj < 2; ++bj) {
                    float v[4][8];
#pragma unroll
                    for (int q = 0; q < 8; ++q) {
                        float carry = 0.f;
#pragma unroll
                        for (int m = 0; m < 4; ++m) {
                            float x = logsigmoidf_(acc[ai][bj][m][q >> 2][q & 3]) * 0.0625f;
                            x += __builtin_bit_cast(float, __builtin_amdgcn_update_dpp(0, __builtin_bit_cast(int, x), 0x111, 0xf, 0xf, true));
                            x += __builtin_bit_cast(float, __builtin_amdgcn_update_dpp(0, __builtin_bit_cast(int, x), 0x112, 0xf, 0xf, true));
                            x += __builtin_bit_cast(float, __builtin_amdgcn_update_dpp(0, __builtin_bit_cast(int, x), 0x114, 0xf, 0xf, true));
                            x += __builtin_bit_cast(float, __builtin_amdgcn_update_dpp(0, __builtin_bit_cast(int, x), 0x118, 0xf, 0xf, true));
                            x += carry;
                            v[m][q] = x;
                            carry = __shfl(x, lane | 15);
                        }
                    }
#pragma unroll
                    for (int m = 0; m < 4; ++m) {
                        const int row = row0 + ai * 128 + m * 16;
                        float* p = bcum + (size_t)row * 256 + bj * 128 + cl;
                        *(f32x4*)p = (f32x4){v[m][0], v[m][1], v[m][2], v[m][3]};
                        *(f32x4*)(p + 4) = (f32x4){v[m][4], v[m][5], v[m][6], v[m][7]};
                    }
                    asm volatile("" ::: "memory");
                }
        } else if (pn >= 6 && pn <= 9) {
            float inv[8];
#pragma unroll
            for (int q = 0; q < 8; ++q) inv[q] = exp2f(-(float)((cl + q) & 63) * 0.20762050593046014f);
            const int hh = cl >> 6;
            const float sc = (pn >= 8) ? 0.08838834764831845f : 1.0f;
            int pv[8];
#pragma unroll
            for (int i = 0; i < 8; ++i) pv[i] = *(const LAS int*)(ebuf + (wr * 64 + fr + (i >> 2) * 128 + (i & 3) * 16) * 4);
#pragma unroll
            for (int ai = 0; ai < 2; ++ai)
#pragma unroll
                for (int m = 0; m < 4; ++m) {
                    const int row = row0 + ai * 128 + m * 16;
                    const float p = (float)pv[ai * 4 + m];
                    float o1[8], o2[8];
#pragma unroll
                    for (int q = 0; q < 8; ++q) {
                        const float ang = p * inv[q];
                        const float t = rintf(ang * 0.15915493667125702f);
                        const float f = fmaf(ang, 0.15915493667125702f, -t) + ang * 6.4206382432985265e-09f;
                        const float sn = __builtin_amdgcn_sinf(f), cs = __builtin_amdgcn_cosf(f);
                        const float x1 = acc[ai][0][m][q >> 2][q & 3], x2 = acc[ai][1][m][q >> 2][q & 3];
                        o1[q] = (x1 * cs - x2 * sn) * sc; o2[q] = (x1 * sn + x2 * cs) * sc;
                    }
                    bf16_t* dst = proj + (size_t)row * NPROJ + pn * 256 + hh * 128 + (cl & 63);
                    store8_bf16(dst, o1); store8_bf16(dst + 64, o2);
                }
        } else {
            const bool silu = (pn == 4 || pn == 5 || pn == 12 || pn == 13);
#pragma unroll
            for (int ai = 0; ai < 2; ++ai)
#pragma unroll
                for (int m = 0; m < 4; ++m) {
                    const int row = row0 + ai * 128 + m * 16;
#pragma unroll
                    for (int bj = 0; bj < 2; ++bj) {
                        f32x4 v0 = acc[ai][bj][m][0], v1 = acc[ai][bj][m][1];
                        if (silu) {
                            const f32x4 t0 = v0 * (-1.4426950408889634f), t1 = v1 * (-1.4426950408889634f);
                            f32x4 d0, d1;
#pragma unroll
                            for (int i = 0; i < 4; ++i) { d0[i] = __builtin_amdgcn_exp2f(t0[i]); d1[i] = __builtin_amdgcn_exp2f(t1[i]); }
                            d0 = d0 + 1.0f; d1 = d1 + 1.0f;
#pragma unroll
                            for (int i = 0; i < 4; ++i) { d0[i] = __builtin_amdgcn_rcpf(d0[i]); d1[i] = __builtin_amdgcn_rcpf(d1[i]); }
                            v0 = v0 * d0; v1 = v1 * d1;
                        } else if (pn == 0) { v0 = v0 * 0.125f; v1 = v1 * 0.125f; }
                        u32x4 w; w.x = cvt_pk_bf16(v0[0], v0[1]); w.y = cvt_pk_bf16(v0[2], v0[3]); w.z = cvt_pk_bf16(v1[0], v1[1]); w.w = cvt_pk_bf16(v1[2], v1[3]);
                        *(u32x4*)(proj + (size_t)row * NPROJ + pn * 256 + bj * 128 + cl) = w;
                    }
                }
        }
    }
};

struct EpiRes1 {
    const float* x; const float* mod; float* x1;
    DI void bias(const pg8::Unit&, int, int, f32x4 (&bia)[2][2]) const { bia[0][0] = bia[0][1] = bia[1][0] = bia[1][1] = (f32x4){0.f, 0.f, 0.f, 0.f}; }
    DI void pre_load(const pg8::Unit&, int, u32x2&) const {}
    DI void pre_store(const u32x2&, int, LAS unsigned char*) const {}
    DI void operator()(const AccT& acc, const pg8::Unit& u, const LAS unsigned char* ebuf, int wr, int wc, int fr, int fq) const {
        const int cl = wc * 64 + 16 * fq, row0 = u.arow0 + wr * 64 + fr;
        const int b = u.arow0 >= SEQ ? 1 : 0;
        const float* g = mod + b * 6144 + 2048 + u.pn * 256 + cl;
        f32x4 gv[2][2];
#pragma unroll
        for (int bj = 0; bj < 2; ++bj) { gv[bj][0] = *(const f32x4*)(g + 8 * bj); gv[bj][1] = *(const f32x4*)(g + 8 * bj + 4); }
        f32x4 xa[4], xb[4];
        const size_t off0 = (size_t)row0 * D + u.pn * 256 + cl;
#define RES_LOAD(X_, i_) do { const size_t o_ = off0 + (size_t)(((i_) >> 2) * 128 + ((i_) & 3) * 16) * D; \
        X_[0] = *(const f32x4*)(x + o_); X_[1] = *(const f32x4*)(x + o_ + 4); X_[2] = *(const f32x4*)(x + o_ + 8); X_[3] = *(const f32x4*)(x + o_ + 12); } while (0)
#if X1_BF16
#define RES_STORE(X_, i_) do { const size_t o_ = off0 + (size_t)(((i_) >> 2) * 128 + ((i_) & 3) * 16) * D; \
        const f32x4 r0_ = X_[0] + gv[0][0] * acc[(i_) >> 2][0][(i_) & 3][0], r1_ = X_[1] + gv[0][1] * acc[(i_) >> 2][0][(i_) & 3][1]; \
        const f32x4 r2_ = X_[2] + gv[1][0] * acc[(i_) >> 2][1][(i_) & 3][0], r3_ = X_[3] + gv[1][1] * acc[(i_) >> 2][1][(i_) & 3][1]; \
        u32x4 w0_, w1_; w0_.x = cvt_pk_bf16(r0_[0], r0_[1]); w0_.y = cvt_pk_bf16(r0_[2], r0_[3]); w0_.z = cvt_pk_bf16(r1_[0], r1_[1]); w0_.w = cvt_pk_bf16(r1_[2], r1_[3]); \
        w1_.x = cvt_pk_bf16(r2_[0], r2_[1]); w1_.y = cvt_pk_bf16(r2_[2], r2_[3]); w1_.z = cvt_pk_bf16(r3_[0], r3_[1]); w1_.w = cvt_pk_bf16(r3_[2], r3_[3]); \
        bf16_t* xp_ = (bf16_t*)x1 + o_; *(u32x4*)xp_ = w0_; *(u32x4*)(xp_ + 8) = w1_; } while (0)
#else
#define RES_STORE(X_, i_) do { const size_t o_ = off0 + (size_t)(((i_) >> 2) * 128 + ((i_) & 3) * 16) * D; \
        *(f32x4*)(x1 + o_) = X_[0] + gv[0][0] * acc[(i_) >> 2][0][(i_) & 3][0]; *(f32x4*)(x1 + o_ + 4) = X_[1] + gv[0][1] * acc[(i_) >> 2][0][(i_) & 3][1]; \
        *(f32x4*)(x1 + o_ + 8) = X_[2] + gv[1][0] * acc[(i_) >> 2][1][(i_) & 3][0]; *(f32x4*)(x1 + o_ + 12) = X_[3] + gv[1][1] * acc[(i_) >> 2][1][(i_) & 3][1]; } while (0)
#endif
        RES_LOAD(xa, 0);
        RES_LOAD(xb, 1); RES_STORE(xa, 0);
        RES_LOAD(xa, 2); RES_STORE(xb, 1);
        RES_LOAD(xb, 3); RES_STORE(xa, 2);
        RES_LOAD(xa, 4); RES_STORE(xb, 3);
        RES_LOAD(xb, 5); RES_STORE(xa, 4);
        RES_LOAD(xa, 6); RES_STORE(xb, 5);
        RES_LOAD(xb, 7); RES_STORE(xa, 6);
        RES_STORE(xb, 7);
#undef RES_LOAD
#undef RES_STORE
    }
};

struct EpiGU {
    const float* bgu; bf16_t* act;
    DI void pre_load(const pg8::Unit&, int, u32x2&) const {}
    DI void pre_store(const u32x2&, int, LAS unsigned char*) const {}
    DI void bias(const pg8::Unit& u, int wc, int fq, f32x4 (&bia)[2][2]) const {
        const float* bg = bgu + (size_t)u.e * 2048 + u.pn * 128 + wc * 32 + 8 * fq;
        bia[0][0] = *(const f32x4*)bg; bia[0][1] = *(const f32x4*)(bg + 4); bia[1][0] = *(const f32x4*)(bg + 1024); bia[1][1] = *(const f32x4*)(bg + 1028);
    }
    DI void operator()(const AccT& acc, const pg8::Unit& u, const LAS unsigned char* ebuf, int wr, int wc, int fr, int fq) const {
        const int cl = wc * 32 + 8 * fq;
        constexpr float OS = MOE_FP8 ? A8_SCALE : 1.0f;
#pragma unroll
        for (int ai = 0; ai < 2; ++ai)
#pragma unroll
            for (int m = 0; m < 4; ++m) {
                const int r = ai * 128 + wr * 64 + m * 16 + fr;
                if (r < u.rows) {
                    f32x2 o[4];
#pragma unroll
                    for (int q = 0; q < 4; ++q) {
                        const f32x4 ag = acc[ai][0][m][q >> 1], au = acc[ai][1][m][q >> 1];
                        f32x2 gt = (q & 1) ? (f32x2){ag[2], ag[3]} : (f32x2){ag[0], ag[1]};
                        f32x2 up = (q & 1) ? (f32x2){au[2], au[3]} : (f32x2){au[0], au[1]};
                        gt.x = fminf(gt.x, 7.0f); gt.y = fminf(gt.y, 7.0f);
                        up.x = __builtin_amdgcn_fmed3f(up.x, -7.0f, 7.0f); up.y = __builtin_amdgcn_fmed3f(up.y, -7.0f, 7.0f);
                        const f32x2 t = gt * (-2.4554669595930157f);
                        f32x2 d; d.x = __builtin_amdgcn_exp2f(t.x); d.y = __builtin_amdgcn_exp2f(t.y);
                        d = d + 1.0f;
                        f32x2 rc; rc.x = __builtin_amdgcn_rcpf(d.x); rc.y = __builtin_amdgcn_rcpf(d.y);
                        o[q] = (up * OS + OS) * (gt * rc);
                    }
#if MOE_FP8
                    u32x2 w8; w8.x = pk4_fp8_nc(o[0].x, o[0].y, o[1].x, o[1].y); w8.y = pk4_fp8_nc(o[2].x, o[2].y, o[3].x, o[3].y);
                    *(u32x2*)((unsigned char*)act + (size_t)(u.arow0 + r) * D + u.pn * 128 + cl) = w8;
#else
                    const float ov[8] = {o[0].x, o[0].y, o[1].x, o[1].y, o[2].x, o[2].y, o[3].x, o[3].y};
                    store8_bf16(act + (size_t)(u.arow0 + r) * D + u.pn * 128 + cl, ov);
#endif
                }
            }
    }
};

struct EpiDown {
    const float* bd; const u32x2* perm; bf16_t* Y;
    DI void pre_load(const pg8::Unit& u, int tid, u32x2& pre) const { if (tid < 256) pre = perm[u.prow0 + (tid < u.rows ? tid : 0)]; }
    DI void pre_store(const u32x2& pre, int tid, LAS unsigned char* buf) const { if (tid < 256) *(LAS u32x2*)(buf + tid * 8) = pre; }
    DI void bias(const pg8::Unit& u, int wc, int fq, f32x4 (&bia)[2][2]) const {
        const float* b = bd + (size_t)u.e * D + u.pn * 256 + wc * 64 + 16 * fq;
        bia[0][0] = *(const f32x4*)b; bia[0][1] = *(const f32x4*)(b + 4); bia[1][0] = *(const f32x4*)(b + 8); bia[1][1] = *(const f32x4*)(b + 12);
    }
    DI void operator()(const AccT& acc, const pg8::Unit& u, const LAS unsigned char* ebuf, int wr, int wc, int fr, int fq) const {
        asm volatile("" : "+v"(fr), "+v"(fq));
        const int cl = wc * 64 + 16 * fq;
#pragma unroll
        for (int ai = 0; ai < 2; ++ai) {
            u32x2 rec[4];
#pragma unroll
            for (int m = 0; m < 4; ++m) { const int r = ai * 128 + wr * 64 + m * 16 + fr; rec[m] = *(const LAS u32x2*)(ebuf + r * 8); }
#pragma unroll
            for (int m = 0; m < 4; ++m) {
                const int r = ai * 128 + wr * 64 + m * 16 + fr;
                if (r < u.rows) {
                    const unsigned wbits = rec[m].y; const float wgt = __uint_as_float(wbits);
#if Y_FP8
                    const float wg8 = wgt * Y8_SCALE;
                    const f32x4 v00 = acc[ai][0][m][0] * wg8, v01 = acc[ai][0][m][1] * wg8, v10 = acc[ai][1][m][0] * wg8, v11 = acc[ai][1][m][1] * wg8;
                    u32x4 w; w.x = pk4_fp8(v00[0], v00[1], v00[2], v00[3]); w.y = pk4_fp8(v01[0], v01[1], v01[2], v01[3]); w.z = pk4_fp8(v10[0], v10[1], v10[2], v10[3]); w.w = pk4_fp8(v11[0], v11[1], v11[2], v11[3]);
                    *(u32x4*)((unsigned char*)Y + (size_t)rec[m].x * D + u.pn * 256 + cl) = w;
#else
                    const f32x4 v00 = acc[ai][0][m][0] * wgt, v01 = acc[ai][0][m][1] * wgt, v10 = acc[ai][1][m][0] * wgt, v11 = acc[ai][1][m][1] * wgt;
                    u32x4 w0, w1; w0.x = cvt_pk_bf16(v00[0], v00[1]); w0.y = cvt_pk_bf16(v00[2], v00[3]); w0.z = cvt_pk_bf16(v01[0], v01[1]); w0.w = cvt_pk_bf16(v01[2], v01[3]);
                    w1.x = cvt_pk_bf16(v10[0], v10[1]); w1.y = cvt_pk_bf16(v10[2], v10[3]); w1.z = cvt_pk_bf16(v11[0], v11[1]); w1.w = cvt_pk_bf16(v11[2], v11[3]);
                    bf16_t* yp = Y + (size_t)rec[m].x * D + u.pn * 256 + cl; *(u32x4*)yp = w0; *(u32x4*)(yp + 8) = w1;
#endif
                }
            }
            asm volatile("" ::: "memory");
        }
    }
};

#define XB_TMO      128
#define XB_XCNT(j)  (256  + 64 * (j))
#define XB_XSUB(j)  (1280 + 64 * (j))
#define XB_XGEN(j)  (2304 + 64 * (j))
#define XB_TOP      3328
#define XB_TOPGEN   3392
#define XCD_BAR_WORDS 3456
#define XB_SPIN_CAP (1u << 22)
DI unsigned xb_ld(unsigned* p)              { return __hip_atomic_load(p, __ATOMIC_RELAXED, __HIP_MEMORY_SCOPE_AGENT); }
DI unsigned xb_add(unsigned* p, unsigned v) { return __hip_atomic_fetch_add(p, v, __ATOMIC_RELAXED, __HIP_MEMORY_SCOPE_AGENT); }
DI unsigned xb_xcc_id() { return (unsigned)__builtin_amdgcn_s_getreg((3 << 11) | 20) & 0xFu; }
#define XB_SPIN(cond, bar) do { unsigned _sp = 0; while (cond) { __builtin_amdgcn_s_sleep(1); \
    if ((++_sp & 255u) == 0u) { if (xb_ld(&(bar)[XB_TMO])) break; if (_sp > XB_SPIN_CAP) { atomicAdd(&(bar)[XB_TMO], 1u); break; } } } } while (0)
struct XcdBarrier { unsigned* bar; unsigned x; volatile LAS unsigned* st; };
DI XcdBarrier xcd_barrier_post(unsigned* bar, volatile LAS unsigned* st) {
    XcdBarrier b; b.bar = bar; b.x = xb_xcc_id(); b.st = st;
    if (threadIdx.x == 0) (void)xb_add(&bar[XB_XCNT(b.x)], 1u);
    return b;
}
DI void xcd_barrier_complete(unsigned* bar, unsigned x, unsigned& nloc, unsigned& nx) {
    const unsigned G = gridDim.x * gridDim.y * gridDim.z;
    unsigned sum, cnt, mine, sp = 0u;
    for (;;) {
        sum = 0u; cnt = 0u; mine = 0u;
#pragma unroll
        for (unsigned j = 0; j < 16; ++j) { const unsigned c = xb_ld(&bar[XB_XCNT(j)]); sum += c; cnt += (c > 0u) ? 1u : 0u; mine = (j == x) ? c : mine; }
        if (sum == G) break;
        __builtin_amdgcn_s_sleep(1);
        if ((++sp & 255u) == 0u) { if (xb_ld(&bar[XB_TMO])) break; if (sp > XB_SPIN_CAP) { atomicAdd(&bar[XB_TMO], 1u); break; } }
    }
    nloc = mine > 0u ? mine : 1u; nx = cnt > 0u ? cnt : 1u;
}
DI void xcd_barrier(const XcdBarrier& b) {
    asm volatile("s_waitcnt vmcnt(0)" ::: "memory");
    __syncthreads();
    if (threadIdx.x == 0) {
        unsigned* bar = b.bar;
        __builtin_amdgcn_s_waitcnt(0);
        unsigned nloc = b.st[0], nx = b.st[1];
        if (nloc == 0u) { xcd_barrier_complete(bar, b.x, nloc, nx); b.st[0] = nloc; b.st[1] = nx; }
        const unsigned old = xb_add(&bar[XB_XSUB(b.x)], 1u);
        const unsigned gen = old / nloc;
        if (old + 1u == (gen + 1u) * nloc) {
            __builtin_amdgcn_fence(__ATOMIC_RELEASE, "agent");
            asm volatile("s_waitcnt vmcnt(0)" ::: "memory");
            const unsigned og = xb_add(&bar[XB_TOP], 1u);
            const unsigned tg = og / nx;
            if (og + 1u == (tg + 1u) * nx) xb_add(&bar[XB_TOPGEN], 1u);
            else XB_SPIN(xb_ld(&bar[XB_TOPGEN]) == tg, bar);
            __builtin_amdgcn_fence(__ATOMIC_ACQUIRE, "agent");
            xb_add(&bar[XB_XGEN(b.x)], 1u);
            asm volatile("s_waitcnt vmcnt(0)" ::: "memory");
        } else {
            XB_SPIN(xb_ld(&bar[XB_XGEN(b.x)]) == gen, bar);
            __builtin_amdgcn_fence(__ATOMIC_ACQUIRE, "agent");
            asm volatile("s_waitcnt vmcnt(0)" ::: "memory");
        }
    }
    __syncthreads();
}

struct Args { const void* in[20]; float* out; unsigned char* ws; int ph_lo, ph_hi; };

struct Frame {
    LAS unsigned char* lds;
    int tid, lane, wave, G, bid;
    const float *x, *c, *w_ada, *b_ada, *norm1, *w_in, *w_gk2, *b_gk, *gla_onorm, *ret_onorm, *w_out, *norm2, *w_router, *b_router, *w_gu, *b_gu, *w_down, *b_down, *norm_f;
    const int* positions;
    float* out; unsigned char* ws;
    unsigned* ctl; float* mod; bf16_t *win_t, *wout_t, *wgu_t, *wd_t, *hbuf, *obuf, *proj, *act, *Y; float *x1, *bcum, *pw; u32x2* perm;
};

DI void tr_item(const float* W, int ldw, int k0, int src_c0, bf16_t* dst, LAS float* scr, int lane) {
    { float t[32]; const float* wp = W + (size_t)(k0 + (lane >> 5)) * ldw + src_c0 + (lane & 31);
#pragma unroll
      for (int i = 0; i < 32; ++i) t[i] = wp[(size_t)(2 * i) * ldw];
#pragma unroll
      for (int i = 0; i < 32; ++i) scr[(2 * i + (lane >> 5)) * 33 + (lane & 31)] = t[i]; }
    LDS_WAIT(); asm volatile("" ::: "memory");
    const int c = lane & 7;
#pragma unroll
    for (int j = 0; j < 4; ++j) { const int n = (lane >> 3) + 8 * j; const LAS float* s = scr + (8 * c) * 33 + n;
        u32x4 o; o.x = pk2(s[0 * 33], s[1 * 33]); o.y = pk2(s[2 * 33], s[3 * 33]); o.z = pk2(s[4 * 33], s[5 * 33]); o.w = pk2(s[6 * 33], s[7 * 33]);
        *(u32x4*)(dst + (size_t)n * D + k0 + 8 * c) = o; }
    LDS_WAIT(); asm volatile("" ::: "memory");
}

DI void tr_item8(const float* W, int ldw, int k0, int src_c0, unsigned char* dst, LAS float* scr, int lane) {
    { float t[32]; const float* wp = W + (size_t)(k0 + (lane >> 5)) * ldw + src_c0 + (lane & 31);
#pragma unroll
      for (int i = 0; i < 32; ++i) t[i] = wp[(size_t)(2 * i) * ldw];
#pragma unroll
      for (int i = 0; i < 32; ++i) scr[(2 * i + (lane >> 5)) * 33 + (lane & 31)] = t[i]; }
    LDS_WAIT(); asm volatile("" ::: "memory");
    const int c = lane & 3;
#pragma unroll
    for (int j = 0; j < 2; ++j) { const int n = (lane >> 2) + 16 * j; const LAS float* s = scr + (16 * c) * 33 + n;
        u32x4 o;
        o.x = pk4_fp8(s[0 * 33] * W8_SCALE, s[1 * 33] * W8_SCALE, s[2 * 33] * W8_SCALE, s[3 * 33] * W8_SCALE);
        o.y = pk4_fp8(s[4 * 33] * W8_SCALE, s[5 * 33] * W8_SCALE, s[6 * 33] * W8_SCALE, s[7 * 33] * W8_SCALE);
        o.z = pk4_fp8(s[8 * 33] * W8_SCALE, s[9 * 33] * W8_SCALE, s[10 * 33] * W8_SCALE, s[11 * 33] * W8_SCALE);
        o.w = pk4_fp8(s[12 * 33] * W8_SCALE, s[13 * 33] * W8_SCALE, s[14 * 33] * W8_SCALE, s[15 * 33] * W8_SCALE);
        *(u32x4*)(dst + (size_t)n * D + k0 + 16 * c) = o; }
    LDS_WAIT(); asm volatile("" ::: "memory");
}

struct TrDesc { const float* W; int ldw, k0, src; unsigned char* dst; int fp8; };
constexpr int TR_I_IN = 112 * 16, TR_I_OUT = 32 * 16, TR_I_GU = 64 * 16, TR_I_D = 32 * 16, TR_NITEMS = TR_I_IN + TR_I_OUT + NE * TR_I_GU + NE * TR_I_D;
DI bool tr_decode(Frame& F, int it, TrDesc& d) {
    if (it >= TR_NITEMS) return false;
    int r = it;
    if (r < TR_I_IN) {
        const int kb = r / 112, nb = r % 112, n0 = nb * 32, pn = n0 >> 8, cl0 = n0 & 255;
        int src;
        if (pn < 6) src = n0;
        else if (pn <= 9) { const int bj = cl0 >> 7, o0 = cl0 & 127; src = pn * 256 + 16 + 128 * (o0 >> 6) + 64 * bj + (o0 & 63); }
        else src = n0 + 16;
        d.W = F.w_in; d.ldw = MIX_IN; d.k0 = kb * 64; d.src = src; d.dst = (unsigned char*)(F.win_t + (size_t)n0 * D); d.fp8 = 0; return true;
    }
    r -= TR_I_IN;
    if (r < TR_I_OUT) { const int kb = r / 32, nb = r % 32; d.W = F.w_out; d.ldw = D; d.k0 = kb * 64; d.src = nb * 32; d.dst = (unsigned char*)(F.wout_t + (size_t)nb * 32 * D); d.fp8 = 0; return true; }
    r -= TR_I_OUT;
    if (r < NE * TR_I_GU) {
        const int e = r / TR_I_GU, rr = r % TR_I_GU, kb = rr / 64, nb = rr % 64, n0 = nb * 32, pn = n0 >> 8, cl0 = n0 & 255, bj = cl0 >> 7, o0 = cl0 & 127;
        d.W = F.w_gu + (size_t)e * D * 2048; d.ldw = 2048; d.k0 = kb * 64; d.src = 1024 * bj + 128 * pn + o0; d.fp8 = MOE_FP8;
        d.dst = (unsigned char*)F.wgu_t + ((size_t)e * 2048 + n0) * D * (MOE_FP8 ? 1 : 2); return true;
    }
    r -= NE * TR_I_GU;
    { const int e = r / TR_I_D, rr = r % TR_I_D, kb = rr / 32, nb = rr % 32;
      d.W = F.w_down + (size_t)e * D * D; d.ldw = D; d.k0 = kb * 64; d.src = nb * 32; d.fp8 = MOE_FP8;
      d.dst = (unsigned char*)F.wd_t + ((size_t)e * D + nb * 32) * D * (MOE_FP8 ? 1 : 2); return true; }
}
DI void tr_load(float (&t)[32], const TrDesc& d, int lane) {
    const float* wp = d.W + (size_t)(d.k0 + (lane >> 5)) * d.ldw + d.src + (lane & 31);
#pragma unroll
    for (int i = 0; i < 32; ++i) t[i] = __builtin_nontemporal_load(wp + (size_t)(2 * i) * d.ldw);
}
DI void tr_finish(const float (&t)[32], const TrDesc& d, LAS float* scr, int lane) {
#pragma unroll
    for (int i = 0; i < 32; ++i) scr[(2 * i + (lane >> 5)) * 33 + (lane & 31)] = t[i];
    LDS_WAIT(); asm volatile("" ::: "memory");
    if (d.fp8) {
        const int c = lane & 3;
#pragma unroll
        for (int j = 0; j < 2; ++j) { const int n = (lane >> 2) + 16 * j; const LAS float* s = scr + (16 * c) * 33 + n;
            u32x4 o;
            o.x = pk4_fp8(s[0 * 33] * W8_SCALE, s[1 * 33] * W8_SCALE, s[2 * 33] * W8_SCALE, s[3 * 33] * W8_SCALE);
            o.y = pk4_fp8(s[4 * 33] * W8_SCALE, s[5 * 33] * W8_SCALE, s[6 * 33] * W8_SCALE, s[7 * 33] * W8_SCALE);
            o.z = pk4_fp8(s[8 * 33] * W8_SCALE, s[9 * 33] * W8_SCALE, s[10 * 33] * W8_SCALE, s[11 * 33] * W8_SCALE);
            o.w = pk4_fp8(s[12 * 33] * W8_SCALE, s[13 * 33] * W8_SCALE, s[14 * 33] * W8_SCALE, s[15 * 33] * W8_SCALE);
            *(u32x4*)(d.dst + (size_t)n * D + d.k0 + 16 * c) = o; }
    } else {
        const int c = lane & 7;
#pragma unroll
        for (int j = 0; j < 4; ++j) { const int n = (lane >> 3) + 8 * j; const LAS float* s = scr + (8 * c) * 33 + n;
            u32x4 o; o.x = pk2(s[0 * 33], s[1 * 33]); o.y = pk2(s[2 * 33], s[3 * 33]); o.z = pk2(s[4 * 33], s[5 * 33]); o.w = pk2(s[6 * 33], s[7 * 33]);
            *(u32x4*)((bf16_t*)d.dst + (size_t)n * D + d.k0 + 8 * c) = o; }
    }
    LDS_WAIT(); asm volatile("" ::: "memory");
}

constexpr int TR_SPLIT1 = TR_NITEMS - 9216 - 7168, TR_SPLIT2 = TR_NITEMS - 7168;
DI void tr_range(Frame& F, LAS float* scr, int first, int last, int widx, int nw) {
    int it = first + widx; TrDesc d0, d1; float t0[32], t1[32];
    bool v0 = it < last && tr_decode(F, it, d0);
    if (v0) tr_load(t0, d0, F.lane);
    while (v0) {
        const bool v1 = (it + nw) < last && tr_decode(F, it + nw, d1);
        if (v1) tr_load(t1, d1, F.lane);
        tr_finish(t0, d0, scr, F.lane);
        if (!v1) break;
        it += 2 * nw; v0 = it < last && tr_decode(F, it, d0);
        if (v0) tr_load(t0, d0, F.lane);
        tr_finish(t1, d1, scr, F.lane);
    }
}

DI void p0_prep(Frame& F) {
    { int t_ = threadIdx.x; asm volatile("" : "+v"(t_)); F.tid = t_; F.lane = t_ & 63; }
    LAS float* red = (LAS float*)F.lds;
    LAS float* sc_ = (LAS float*)(F.lds + 4096);
    for (int i = F.tid; i < 2 * D; i += NTHREADS) { const float cv = F.c[i]; sc_[i] = cv * sigmoidf_(cv); }
    __syncthreads();
    for (int it = F.bid * NTHREADS + F.tid; it < 256 * 128; it += F.G * NTHREADS) {
        const int c = it & 255, k8 = it >> 8;
        float w2[16];
#pragma unroll
        for (int j = 0; j < 16; ++j) w2[j] = F.w_gk2[j * 256 + c];
        float o[8];
#pragma unroll
        for (int kk = 0; kk < 8; ++kk) {
            const float* wi = F.w_in + (size_t)(k8 * 8 + kk) * MIX_IN + 1536; float s = 0.f;
#pragma unroll
            for (int j = 0; j < 16; ++j) s += wi[j] * w2[j];
            o[kk] = s;
        }
        u32x4 w; w.x = pk2(o[0], o[1]); w.y = pk2(o[2], o[3]); w.z = pk2(o[4], o[5]); w.w = pk2(o[6], o[7]);
        *(u32x4*)(F.win_t + (size_t)(3584 + c) * D + k8 * 8) = w;
    }
    LAS float* scr = (LAS float*)(F.lds + 16384 + F.wave * 8704);
    const int tr_last = F.G == 256 ? TR_SPLIT1 : TR_NITEMS, tr_nw = F.G * NWAVES;
    int it = F.bid * NWAVES + F.wave; TrDesc d0, d1; float t0[32], t1[32];
    bool v0 = it < tr_last && tr_decode(F, it, d0);
    if (v0) tr_load(t0, d0, F.lane);
    for (int cb = F.bid; cb < 256; cb += F.G) {
        const bool act = F.tid < 504;
        const int col = F.tid % 24, ks = F.tid / 24; float a0 = 0.f, a1 = 0.f;
        const float* wp = F.w_ada + (size_t)ks * 6144 + cb * 24 + col;
#define P0_ISSUE(k0_) _Pragma("unroll") for (int j = 0; j < 7; ++j) { const int k = ks + 21 * ((k0_) + j); w[j] = (act && k < D) ? wp[(size_t)(21 * ((k0_) + j)) * 6144] : 0.f; }
#define P0_USE(k0_) _Pragma("unroll") for (int j = 0; j < 7; ++j) { const int k = ks + 21 * ((k0_) + j); if (act && k < D) { a0 += sc_[k] * w[j]; a1 += sc_[D + k] * w[j]; } }
#pragma unroll 1
        for (int k0 = 0; k0 < 56; k0 += 14) {
            float w[7];
            P0_ISSUE(k0);
            bool v1 = false;
            if (v0) { v1 = (it + tr_nw) < tr_last && tr_decode(F, it + tr_nw, d1); if (v1) tr_load(t1, d1, F.lane); tr_finish(t0, d0, scr, F.lane); }
            P0_USE(k0);
            P0_ISSUE(k0 + 7);
            v0 = false;
            if (v1) { it += 2 * tr_nw; v0 = it < tr_last && tr_decode(F, it, d0); if (v0) tr_load(t0, d0, F.lane); tr_finish(t1, d1, scr, F.lane); }
            P0_USE(k0 + 7);
        }
#undef P0_ISSUE
#undef P0_USE
        if (act) { red[ks * 24 + col] = a0; red[(21 + ks) * 24 + col] = a1; }
        __syncthreads();
        if (F.tid < 48) {
            const int b = F.tid / 24, c2 = F.tid % 24; float s = F.b_ada[cb * 24 + c2];
            for (int q = 0; q < 21; ++q) s += red[(b * 21 + q) * 24 + c2];
            F.mod[b * 6144 + cb * 24 + c2] = s;
        }
        __syncthreads();
    }
    while (v0) {
        const bool v1 = (it + tr_nw) < tr_last && tr_decode(F, it + tr_nw, d1);
        if (v1) tr_load(t1, d1, F.lane);
        tr_finish(t0, d0, scr, F.lane);
        if (!v1) break;
        it += 2 * tr_nw; v0 = it < tr_last && tr_decode(F, it, d0);
        if (v0) tr_load(t0, d0, F.lane);
        tr_finish(t1, d1, scr, F.lane);
    }
}

DI void p1_h1(Frame& F) {
    { int t_ = threadIdx.x; asm volatile("" : "+v"(t_)); F.tid = t_; F.lane = t_ & 63; }
    const int gw = F.bid * NWAVES + F.wave, NGW = F.G * NWAVES;
    f32x4 v[4], vn[4];
    if (gw < M) { const f32x4* xr = (const f32x4*)(F.x + (size_t)gw * D) + F.lane;
#pragma unroll
        for (int j = 0; j < 4; ++j) v[j] = xr[64 * j]; }
    for (int m = gw; m < M; m += NGW) {
        const int b = m >= SEQ;
        if (m + NGW < M) { const f32x4* xn = (const f32x4*)(F.x + (size_t)(m + NGW) * D) + F.lane;
#pragma unroll
            for (int j = 0; j < 4; ++j) vn[j] = xn[64 * j]; }
        const f32x4* nr = (const f32x4*)F.norm1 + F.lane;
        const f32x4* shr = (const f32x4*)(F.mod + b * 6144) + F.lane;
        const f32x4* scr = (const f32x4*)(F.mod + b * 6144 + 1024) + F.lane;
        float s = 0.f;
#pragma unroll
        for (int j = 0; j < 4; ++j) s += (v[j].x * v[j].x + v[j].y * v[j].y) + (v[j].z * v[j].z + v[j].w * v[j].w);
        const float rstd = __builtin_amdgcn_rsqf(wave_sum(s) * (1.0f / D) + EPS);
        u32x2* o8 = (u32x2*)(F.hbuf + (size_t)m * D) + F.lane;
#pragma unroll
        for (int j = 0; j < 4; ++j) {
            const f32x4 w = nr[64 * j], sc = scr[64 * j], sh = shr[64 * j];
            const f32x4 h = v[j] * rstd * w * (sc + 1.0f) + sh;
            u32x2 p; p.x = pk2(h.x, h.y); p.y = pk2(h.z, h.w); o8[64 * j] = p;
        }
#pragma unroll
        for (int j = 0; j < 4; ++j) v[j] = vn[j];
    }
}

template <int DK, bool GLA>
DI void la_naive_stream(Frame& F, int b, int h) {
    LAS float* qs = (LAS float*)F.lds;
    LAS float* ks = qs + 64 * DK;
    LAS float* as = ks + 64 * DK;
    LAS float* vs = (LAS float*)(F.lds + 3 * 64 * 128 * 4);
    const int qcol = GLA ? h * 64 : 1536 + h * 128, kcol = GLA ? 256 + h * 64 : 2048 + h * 128, vcol = GLA ? 512 + h * 128 : 2560 + h * 128, gcol = GLA ? 1024 + h * 128 : 3072 + h * 128;
    const float gamma = 1.0f - exp2f(-5.0f - (float)h);
    float S[DK];
#pragma unroll
    for (int d = 0; d < DK; ++d) S[d] = 0.f;
    for (int tile = 0; tile < SEQ / 64; ++tile) {
        const int row0 = b * SEQ + tile * 64;
        for (int i = F.tid; i < 64 * DK; i += NTHREADS) {
            const int t = i / DK, d = i % DK; const size_t r = (size_t)(row0 + t);
            qs[i] = bf2f(F.proj[r * NPROJ + qcol + d]); ks[i] = bf2f(F.proj[r * NPROJ + kcol + d]);
            if (GLA) { const float bc = F.bcum[r * 256 + h * 64 + d]; const float bp = t > 0 ? F.bcum[(r - 1) * 256 + h * 64 + d] : 0.f; as[i] = expf(bc - bp); }
        }
        for (int i = F.tid; i < 64 * 128; i += NTHREADS) { const int t = i >> 7, e = i & 127; vs[i] = bf2f(F.proj[(size_t)(row0 + t) * NPROJ + vcol + e]); }
        __syncthreads();
        if (F.tid < 128) {
            const int e = F.tid;
            for (int t = 0; t < 64; ++t) {
                const float v = vs[t * 128 + e]; float o = 0.f;
#pragma unroll
                for (int d = 0; d < DK; ++d) {
                    const float a = GLA ? as[t * DK + d] : gamma;
                    S[d] = a * S[d] + ks[t * DK + d] * v; o += qs[t * DK + d] * S[d];
                }
                vs[t * 128 + e] = o;
            }
        }
        __syncthreads();
        for (int tt = 0; tt < 8; ++tt) {
            const int t = F.wave * 8 + tt; const size_t r = (size_t)(row0 + t);
            const float o0 = vs[t * 128 + F.lane], o1 = vs[t * 128 + 64 + F.lane];
            float y0, y1;
            if (GLA) {
                const float rstd = 1.0f / sqrtf(wave_sum(o0 * o0 + o1 * o1) * (1.0f / 128.f) + EPS);
                y0 = o0 * rstd * F.gla_onorm[F.lane]; y1 = o1 * rstd * F.gla_onorm[64 + F.lane];
            } else {
                const float mu = wave_sum(o0 + o1) * (1.0f / 128.f); const float d0 = o0 - mu, d1 = o1 - mu;
                const float rstd = 1.0f / sqrtf(wave_sum(d0 * d0 + d1 * d1) * (1.0f / 128.f) + EPS);
                y0 = d0 * rstd * F.ret_onorm[F.lane]; y1 = d1 * rstd * F.ret_onorm[64 + F.lane];
            }
            y0 *= bf2f(F.proj[r * NPROJ + gcol + F.lane]); y1 *= bf2f(F.proj[r * NPROJ + gcol + 64 + F.lane]);
            const int oc = (GLA ? 0 : 512) + h * 128;
            F.obuf[r * D + oc + F.lane] = (bf16_t)f2bf(y0); F.obuf[r * D + oc + 64 + F.lane] = (bf16_t)f2bf(y1);
        }
        __syncthreads();
    }
}
DI void p3_la_naive(Frame& F) {
    { int t_ = threadIdx.x; asm volatile("" : "+v"(t_)); F.tid = t_; F.lane = t_ & 63; }
    for (int s = F.bid; s < 16; s += F.G) {
        const int type = s >> 3, b = (s >> 2) & 1, h = s & 3;
        if (type == 0) la_naive_stream<64, true>(F, b, h); else la_naive_stream<128, false>(F, b, h);
    }
}


typedef short s16x4 __attribute__((ext_vector_type(4)));
constexpr int LA_C = 128, LA_NC = SEQ / LA_C;
constexpr size_t U_RET_OFF = (size_t)8 * LA_NC * 128 * 64;
DI bf16x8 tr_pair(const LAS unsigned char* p0, const LAS unsigned char* p1) {
    const s16x4 lo = __builtin_amdgcn_ds_read_tr16_b64_v4i16((LAS s16x4*)p0);
    const s16x4 hi = __builtin_amdgcn_ds_read_tr16_b64_v4i16((LAS s16x4*)p1);
    return __builtin_shufflevector(lo, hi, 0, 1, 2, 3, 4, 5, 6, 7);
}
DI int slot_swap23(int t) { return (t & ~12) | ((t >> 1) & 4) | ((t << 1) & 8); }
DI float lg2_gamma(int h) { return log2f(1.0f - exp2f(-5.0f - (float)h)); }
DI bf16x8 scale8(u32x4 w, const float* f) {
    u32x4 o;
    o.x = cvt_pk_bf16(bflo(w.x) * f[0], bfhi(w.x) * f[1]); o.y = cvt_pk_bf16(bflo(w.y) * f[2], bfhi(w.y) * f[3]);
    o.z = cvt_pk_bf16(bflo(w.z) * f[4], bfhi(w.z) * f[5]); o.w = cvt_pk_bf16(bflo(w.w) * f[6], bfhi(w.w) * f[7]);
    return __builtin_bit_cast(bf16x8, o);
}
DI bf16x8 scale1(u32x4 w, float f) {
    u32x4 o;
    o.x = cvt_pk_bf16(bflo(w.x) * f, bfhi(w.x) * f); o.y = cvt_pk_bf16(bflo(w.y) * f, bfhi(w.y) * f);
    o.z = cvt_pk_bf16(bflo(w.z) * f, bfhi(w.z) * f); o.w = cvt_pk_bf16(bflo(w.w) * f, bfhi(w.w) * f);
    return __builtin_bit_cast(bf16x8, o);
}

template <int DK, int EB, bool GLA>
DI void la_pass1_unit(Frame& F, LAS unsigned char* wl, int b, int h, int n, int eh, bf16_t* Ubase) {
    int lane = F.lane; asm volatile("" : "+v"(lane), "+s"(n));
    const int g = lane >> 4, i16 = lane & 15, q = i16 >> 2, p = i16 & 3;
    constexpr int NDB = DK / 16, VCOLS = 16 * EB, VC = VCOLS / 8, KC = DK / 8, VI = 32 * VC / 64, KI = 32 * KC / 64;
    LAS unsigned char* vt = wl; LAS unsigned char* kt = wl + EB * 1024;
    const int r0 = b * SEQ + n * LA_C;
    const int kcol = GLA ? 256 + h * 64 : 2048 + h * 128, vcol = (GLA ? 512 : 2560) + h * 128 + eh * VCOLS, hd = h * 64;
    f32x4 acc[EB][NDB];
#pragma unroll
    for (int e = 0; e < EB; ++e)
#pragma unroll
        for (int d = 0; d < NDB; ++d) acc[e][d] = (f32x4){0.f, 0.f, 0.f, 0.f};
    const int kc = lane % KC, ktok = lane / KC, vch = lane % VC, vtok = lane / VC;
    float bl[8], b63[8]; const float lg2 = lg2_gamma(h);
    if (GLA) {
        const f32x4 a0 = *(const f32x4*)(F.bcum + (size_t)(r0 + 127) * 256 + hd + 8 * kc), a1 = *(const f32x4*)(F.bcum + (size_t)(r0 + 127) * 256 + hd + 8 * kc + 4);
        const f32x4 c0 = *(const f32x4*)(F.bcum + (size_t)(r0 + 63) * 256 + hd + 8 * kc), c1 = *(const f32x4*)(F.bcum + (size_t)(r0 + 63) * 256 + hd + 8 * kc + 4);
#pragma unroll
        for (int j = 0; j < 4; ++j) { bl[j] = a0[j]; bl[4 + j] = a1[j]; b63[j] = c0[j]; b63[4 + j] = c1[j]; }
    }
    if (GLA && eh == 0 && lane < KC) {
        float* dp = (float*)(F.ws + WS_DEC) + ((size_t)((b * 4 + h) * LA_NC + n) * 64) + 8 * kc;
        *(f32x4*)dp = (f32x4){__expf(bl[0] + b63[0]), __expf(bl[1] + b63[1]), __expf(bl[2] + b63[2]), __expf(bl[3] + b63[3])};
        *(f32x4*)(dp + 4) = (f32x4){__expf(bl[4] + b63[4]), __expf(bl[5] + b63[5]), __expf(bl[6] + b63[6]), __expf(bl[7] + b63[7])};
    }
    const int rbase = (((g >> 1) * 16 + (g & 1) * 4 + q) * 32) + 8 * p;
    u32x4 vr[VI], kr[KI]; f32x4 kbv[KI][2];
#define LA1_LOAD(step_) do { const int rs_ = r0 + 32 * (step_); \
        _Pragma("unroll") for (int i = 0; i < VI; ++i) vr[i] = *(const u32x4*)(F.proj + (size_t)(rs_ + vtok + i * (64 / VC)) * NPROJ + vcol + 8 * vch); \
        _Pragma("unroll") for (int i = 0; i < KI; ++i) { const size_t row = (size_t)(rs_ + ktok + i * (64 / KC)); kr[i] = *(const u32x4*)(F.proj + row * NPROJ + kcol + 8 * kc); \
            if (GLA) { kbv[i][0] = *(const f32x4*)(F.bcum + row * 256 + hd + 8 * kc); kbv[i][1] = *(const f32x4*)(F.bcum + row * 256 + hd + 8 * kc + 4); } } } while (0)
    LA1_LOAD(0);
#pragma unroll 1
    for (int step = 0; step < 4; ++step) {
#pragma unroll
        for (int i = 0; i < VI; ++i) { const int tau = vtok + i * (64 / VC); *(LAS u32x4*)(vt + (vch >> 1) * 1024 + slot_swap23(tau) * 32 + (vch & 1) * 16) = vr[i]; }
#pragma unroll
        for (int i = 0; i < KI; ++i) {
            const int tau = ktok + i * (64 / KC), t = 32 * step + tau;
            bf16x8 o;
            if (GLA) {
                float f[8];
#pragma unroll
                for (int j = 0; j < 8; ++j) f[j] = __expf(bl[j] - kbv[i][j >> 2][j & 3] + (t < 64 ? b63[j] : 0.f));
                o = scale8(kr[i], f);
            } else {
                o = scale1(kr[i], exp2f((float)(127 - t) * lg2));
            }
            *(LAS bf16x8*)(kt + (kc >> 1) * 1024 + slot_swap23(tau) * 32 + (kc & 1) * 16) = o;
        }
        if (step < 3) LA1_LOAD(step + 1);
        bf16x8 af[EB], bfr[NDB];
#pragma unroll
        for (int e = 0; e < EB; ++e) af[e] = tr_pair(vt + e * 1024 + rbase, vt + e * 1024 + rbase + 256);
#pragma unroll
        for (int d = 0; d < NDB; ++d) bfr[d] = tr_pair(kt + d * 1024 + rbase, kt + d * 1024 + rbase + 256);
#pragma unroll
        for (int e = 0; e < EB; ++e)
#pragma unroll
            for (int d = 0; d < NDB; ++d) acc[e][d] = __builtin_amdgcn_mfma_f32_16x16x32_bf16(bfr[d], af[e], acc[e][d], 0, 0, 0);
    }
#undef LA1_LOAD
    bf16_t* U = Ubase + (size_t)n * 128 * DK;
#pragma unroll
    for (int e = 0; e < EB; ++e)
#pragma unroll
        for (int d = 0; d < NDB; ++d)
            { u32x2 w; w.x = cvt_pk_bf16(acc[e][d][0], acc[e][d][1]); w.y = cvt_pk_bf16(acc[e][d][2], acc[e][d][3]);
              *(u32x2*)(U + (size_t)(eh * VCOLS + 16 * e + i16) * DK + 16 * d + 4 * g) = w; }
}

DI void p3_la_pass1(Frame& F) {
    { int t_ = threadIdx.x; asm volatile("" : "+v"(t_)); F.tid = t_; F.lane = t_ & 63; }
    LAS unsigned char* wl = F.lds + F.wave * 16384;
    const int gw = F.bid * NWAVES + F.wave, NGW = F.G * NWAVES;
    bf16_t* Ug = (bf16_t*)(F.ws + WS_U); bf16_t* Ur = Ug + U_RET_OFF;
    for (int u = gw; u < 2048 + 4096; u += NGW) {
        if (u < 2048) { const int eh = u & 1, n = (u >> 1) & 127, st = u >> 8; la_pass1_unit<64, 4, true>(F, wl, st >> 2, st & 3, n, eh, Ug + (size_t)st * LA_NC * 128 * 64); }
        else { const int v = u - 2048, eh = v & 3, n = (v >> 2) & 127, st = v >> 9; la_pass1_unit<128, 2, false>(F, wl, st >> 2, st & 3, n, eh, Ur + (size_t)st * LA_NC * 128 * 128); }
    }
}

DI void p4_la_scan(Frame& F) {
    { int t_ = threadIdx.x; asm volatile("" : "+v"(t_)); F.tid = t_; F.lane = t_ & 63; }
    const bf16_t* Ug = (const bf16_t*)(F.ws + WS_U); bf16_t* Sg = (bf16_t*)(F.ws + WS_SP);
    if (F.tid >= 384) { if (F.G == 256) tr_range(F, (LAS float*)(F.lds + 16384 + F.wave * 8704), TR_SPLIT2, TR_NITEMS, F.bid * 2 + (F.wave - 6), F.G * 2); return; }
    for (int it = F.bid * 384 + F.tid; it < 32768 + 65536; it += F.G * 384) {
        const bool gla = it < 32768;
        int st, e, d2, DK; size_t base;
        if (gla) { st = it >> 12; const int idx = it & 4095; e = idx >> 5; d2 = idx & 31; DK = 64; base = (size_t)st * LA_NC * 128 * 64; }
        else { const int v = it - 32768; st = v >> 13; const int idx = v & 8191; e = idx >> 6; d2 = idx & 63; DK = 128; base = U_RET_OFF + (size_t)st * LA_NC * 128 * 128; }
        const int b = st >> 2, h = st & 3;
        const size_t cstride = (size_t)128 * DK;
        const bf16_t* up = Ug + base + (size_t)e * DK + 2 * d2;
        bf16_t* sp = Sg + base + (size_t)e * DK + 2 * d2;
        const float* bc = (const float*)(F.ws + WS_DEC) + (size_t)(st & 7) * LA_NC * 64 + 2 * d2;
        const float dr = exp2f(128.0f * lg2_gamma(h));
        float s0 = 0.f, s1 = 0.f;
        unsigned uv[16], un[16]; f32x2 dv[16], dn[16];
#define LA4_LOAD(U_, D_, n0_) do { _Pragma("unroll") for (int j = 0; j < 16; ++j) { \
            U_[j] = *(const unsigned*)(up + (size_t)((n0_) + j) * cstride); \
            if (gla) D_[j] = *(const f32x2*)(bc + (size_t)((n0_) + j) * 64); } } while (0)
#define LA4_STEP(U_, D_, n0_) do { _Pragma("unroll") for (int j = 0; j < 16; ++j) { \
            *(unsigned*)(sp + (size_t)((n0_) + j) * cstride) = pk2(s0, s1); \
            const float d0 = gla ? D_[j].x : dr, d1 = gla ? D_[j].y : dr; \
            s0 = d0 * s0 + bflo(U_[j]); s1 = d1 * s1 + bfhi(U_[j]); } } while (0)
        LA4_LOAD(uv, dv, 0);
#pragma unroll 1
        for (int n0 = 0; n0 < LA_NC; n0 += 32) {
            LA4_LOAD(un, dn, n0 + 16);
            LA4_STEP(uv, dv, n0);
            if (n0 + 32 < LA_NC) LA4_LOAD(uv, dv, n0 + 32);
            LA4_STEP(un, dn, n0 + 16);
        }
#undef LA4_LOAD
#undef LA4_STEP
    }
}

template <int DK, bool GLA>
DI void la_pass3_unit(Frame& F, LAS unsigned char* wl, int b, int h, int n, int tq, const bf16_t* SpBase) {
    int lane = F.lane; asm volatile("" : "+v"(lane), "+s"(n), "+s"(tq));
    const int g = lane >> 4, i16 = lane & 15, q = i16 >> 2, p = i16 & 3;
    constexpr int NKS = DK / 32;
    const int r0 = b * SEQ + n * LA_C, t0 = 32 * tq, hd = h * 64;
    const int qcol = GLA ? h * 64 : 1536 + h * 128, kcol = GLA ? 256 + h * 64 : 2048 + h * 128, vcol = (GLA ? 512 : 2560) + h * 128, gcol = (GLA ? 1024 : 3072) + h * 128, ocol = (GLA ? 0 : 512) + h * 128;
    const float lg2 = lg2_gamma(h);
    u32x4 qraw[2][NKS]; f32x4 qb[2][NKS][2]; f32x4 c63[NKS][2];
    u32x4 kraw[2][NKS]; f32x4 kb[2][NKS][2]; u32x4 vraw[8];
#pragma unroll
    for (int tb = 0; tb < 2; ++tb)
#pragma unroll
        for (int ks = 0; ks < NKS; ++ks) {
            const size_t row = (size_t)(r0 + t0 + 16 * tb + i16);
            qraw[tb][ks] = *(const u32x4*)(F.proj + row * NPROJ + qcol + 32 * ks + 8 * g);
            if (GLA) { const float* bp = F.bcum + row * 256 + hd + 32 * ks + 8 * g; qb[tb][ks][0] = *(const f32x4*)bp; qb[tb][ks][1] = *(const f32x4*)(bp + 4); }
        }
    if (GLA) {
#pragma unroll
        for (int ks = 0; ks < NKS; ++ks) { const float* cp = F.bcum + (size_t)(r0 + 63) * 256 + hd + 32 * ks + 8 * g; c63[ks][0] = *(const f32x4*)cp; c63[ks][1] = *(const f32x4*)(cp + 4); }
    }
#define LA3_LOAD_KV(sp_) do { const int rs_ = r0 + 32 * (sp_); \
        _Pragma("unroll") for (int sb = 0; sb < 2; ++sb) _Pragma("unroll") for (int ks = 0; ks < NKS; ++ks) { const size_t row = (size_t)(rs_ + 16 * sb + i16); \
            kraw[sb][ks] = *(const u32x4*)(F.proj + row * NPROJ + kcol + 32 * ks + 8 * g); \
            if (GLA) { const float* bp = F.bcum + row * 256 + hd + 32 * ks + 8 * g; kb[sb][ks][0] = *(const f32x4*)bp; kb[sb][ks][1] = *(const f32x4*)(bp + 4); } } \
        _Pragma("unroll") for (int i = 0; i < 8; ++i) vraw[i] = *(const u32x4*)(F.proj + (size_t)(rs_ + (lane >> 4) + 4 * i) * NPROJ + vcol + 8 * (lane & 15)); } while (0)
    LA3_LOAD_KV(0);
    bf16x8 qf[2][NKS];
#pragma unroll
    for (int tb = 0; tb < 2; ++tb)
#pragma unroll
        for (int ks = 0; ks < NKS; ++ks) {
            if (GLA) {
                float f[8];
#pragma unroll
                for (int j = 0; j < 8; ++j) f[j] = __expf(qb[tb][ks][j >> 2][j & 3] + (t0 >= 64 ? c63[ks][j >> 2][j & 3] : 0.f));
                qf[tb][ks] = scale8(qraw[tb][ks], f);
            } else qf[tb][ks] = scale1(qraw[tb][ks], exp2f((float)(t0 + 16 * tb + i16 + 1) * lg2));
        }
    f32x4 o[2][8];
#pragma unroll
    for (int tb = 0; tb < 2; ++tb)
#pragma unroll
        for (int eb = 0; eb < 8; ++eb) o[tb][eb] = (f32x4){0.f, 0.f, 0.f, 0.f};
    const int vbase = (4 * g + q) * 32 + 8 * p;
#pragma unroll 1
    for (int sp = 0; sp <= tq; ++sp) {
#pragma unroll
        for (int i = 0; i < 8; ++i) { const int tau = (lane >> 4) + 4 * i, ch = lane & 15; *(LAS u32x4*)(wl + (ch >> 1) * 1024 + tau * 32 + (ch & 1) * 16) = vraw[i]; }
        bf16x8 kf[2][NKS];
#pragma unroll
        for (int sb = 0; sb < 2; ++sb)
#pragma unroll
            for (int ks = 0; ks < NKS; ++ks) {
                if (GLA) {
                    float f[8];
#pragma unroll
                    for (int j = 0; j < 8; ++j) f[j] = __expf(-(kb[sb][ks][j >> 2][j & 3] + (sp >= 2 ? c63[ks][j >> 2][j & 3] : 0.f)));
                    kf[sb][ks] = scale8(kraw[sb][ks], f);
                } else kf[sb][ks] = scale1(kraw[sb][ks], exp2f(-(float)(32 * sp + 16 * sb + i16 + 1) * lg2));
            }
        if (sp < tq) LA3_LOAD_KV(sp + 1);
        bf16x8 pf[2];
#pragma unroll
        for (int tb = 0; tb < 2; ++tb) {
            const int T = 2 * tq + tb;
            f32x4 s0 = (f32x4){0.f, 0.f, 0.f, 0.f}, s1 = s0;
#pragma unroll
            for (int ks = 0; ks < NKS; ++ks) {
                s0 = __builtin_amdgcn_mfma_f32_16x16x32_bf16(kf[0][ks], qf[tb][ks], s0, 0, 0, 0);
                s1 = __builtin_amdgcn_mfma_f32_16x16x32_bf16(kf[1][ks], qf[tb][ks], s1, 0, 0, 0);
            }
            const int S0 = 2 * sp, S1 = 2 * sp + 1;
#pragma unroll
            for (int r = 0; r < 4; ++r) {
                const bool keep = (4 * g + r) <= i16;
                if (S0 == T && !keep) s0[r] = 0.f;
                if (S1 > T || (S1 == T && !keep)) s1[r] = 0.f;
            }
            u32x4 pw_; pw_.x = cvt_pk_bf16(s0[0], s0[1]); pw_.y = cvt_pk_bf16(s0[2], s0[3]); pw_.z = cvt_pk_bf16(s1[0], s1[1]); pw_.w = cvt_pk_bf16(s1[2], s1[3]);
            pf[tb] = __builtin_bit_cast(bf16x8, pw_);
        }
#pragma unroll
        for (int eb = 0; eb < 8; ++eb) {
            const bf16x8 vf = tr_pair(wl + eb * 1024 + vbase, wl + eb * 1024 + vbase + 512);
            o[0][eb] = __builtin_amdgcn_mfma_f32_16x16x32_bf16(pf[0], vf, o[0][eb], 0, 0, 0);
            o[1][eb] = __builtin_amdgcn_mfma_f32_16x16x32_bf16(pf[1], vf, o[1][eb], 0, 0, 0);
        }
    }
#undef LA3_LOAD_KV
    u32x4 gt[8];
#pragma unroll
    for (int i = 0; i < 8; ++i) gt[i] = *(const u32x4*)(F.proj + (size_t)(r0 + t0 + 4 * i + (lane >> 4)) * NPROJ + gcol + 8 * (lane & 15));
    const bf16_t* Sp = SpBase + (size_t)n * 128 * DK;
#pragma unroll
    for (int eb = 0; eb < 8; ++eb)
#pragma unroll
        for (int ks = 0; ks < NKS; ++ks) {
            const bf16x8 sf = *(const bf16x8*)(Sp + (size_t)(16 * eb + i16) * DK + 32 * ks + 8 * g);
            o[0][eb] = __builtin_amdgcn_mfma_f32_16x16x32_bf16(qf[0][ks], sf, o[0][eb], 0, 0, 0);
            o[1][eb] = __builtin_amdgcn_mfma_f32_16x16x32_bf16(qf[1][ks], sf, o[1][eb], 0, 0, 0);
        }
#pragma unroll
    for (int tb = 0; tb < 2; ++tb)
#pragma unroll
        for (int r = 0; r < 4; ++r) {
            float mu = 0.f;
            if (!GLA) {
                float s = 0.f;
#pragma unroll
                for (int eb = 0; eb < 8; ++eb) s += o[tb][eb][r];
                s = row16_sum(s);
                mu = s * (1.0f / 128.f);
            }
            float ss = 0.f;
#pragma unroll
            for (int eb = 0; eb < 8; ++eb) { const float dlt = o[tb][eb][r] - mu; o[tb][eb][r] = dlt; ss += dlt * dlt; }
            ss = row16_sum(ss);
            const float rstd = __builtin_amdgcn_rsqf(ss * (1.0f / 128.f) + EPS);
#pragma unroll
            for (int eb = 0; eb < 8; ++eb) *(LAS float*)(wl + ((16 * tb + 4 * g + r) * 128 + 16 * eb + i16) * 4) = o[tb][eb][r] * rstd;
        }
    {
        const int ch = lane & 15; const float* onw = (GLA ? F.gla_onorm : F.ret_onorm) + 8 * ch;
        const f32x4 w0 = *(const f32x4*)onw, w1 = *(const f32x4*)(onw + 4);
#pragma unroll
        for (int i = 0; i < 8; ++i) {
            const int t = 4 * i + (lane >> 4); const size_t row = (size_t)(r0 + t0 + t);
            const f32x4 y0 = *(const LAS f32x4*)(wl + (t * 128 + 8 * ch) * 4), y1 = *(const LAS f32x4*)(wl + (t * 128 + 8 * ch + 4) * 4);
            const u32x4 gg = gt[i];
            float ov[8];
            ov[0] = y0[0] * w0[0] * bflo(gg.x); ov[1] = y0[1] * w0[1] * bfhi(gg.x); ov[2] = y0[2] * w0[2] * bflo(gg.y); ov[3] = y0[3] * w0[3] * bfhi(gg.y);
            ov[4] = y1[0] * w1[0] * bflo(gg.z); ov[5] = y1[1] * w1[1] * bfhi(gg.z); ov[6] = y1[2] * w1[2] * bflo(gg.w); ov[7] = y1[3] * w1[3] * bfhi(gg.w);
            store8_bf16(F.obuf + row * D + ocol + 8 * ch, ov);
        }
    }
}

DI void p5_la_pass3(Frame& F) {
    { int t_ = threadIdx.x; asm volatile("" : "+v"(t_)); F.tid = t_; F.lane = t_ & 63; }
    LAS unsigned char* wl = F.lds + F.wave * 16384;
    const int gw = F.bid * NWAVES + F.wave, NGW = F.G * NWAVES;
    const bf16_t* Sg = (const bf16_t*)(F.ws + WS_SP); const bf16_t* Sr = Sg + U_RET_OFF;
    const int ntask_round = NGW >> 2;
#pragma unroll 1
    for (int i = 0; i * ntask_round < 2048; ++i) {
        const int task = i * ntask_round + (gw >> 2); if (task >= 2048) break;
        const int tq = (gw + i) & 3, type = task & 1, idx = task >> 1, st = idx >> 7, n = idx & 127;
        if (type == 0) la_pass3_unit<64, true>(F, wl, st >> 2, st & 3, n, tq, Sg + (size_t)st * LA_NC * 128 * 64);
        else la_pass3_unit<128, false>(F, wl, st >> 2, st & 3, n, tq, Sr + (size_t)st * LA_NC * 128 * 128);
    }
}

#define DPPF(v, ctrl) __builtin_bit_cast(float, __builtin_amdgcn_update_dpp(__builtin_bit_cast(int, v), __builtin_bit_cast(int, v), ctrl, 0xf, 0xf, false))
DI float row16_max(float v) {
    v = fmaxf(v, DPPF(v, 0xB1)); v = fmaxf(v, DPPF(v, 0x4E)); v = fmaxf(v, DPPF(v, 0x141)); v = fmaxf(v, DPPF(v, 0x140)); return v;
}
DI void p7_router(Frame& F) {
    { int t_ = threadIdx.x; asm volatile("" : "+v"(t_)); F.tid = t_; F.lane = t_ & 63; }
    constexpr int RS = 2064;
    LAS unsigned char* hh = F.lds;
    LAS unsigned char* hlo = F.lds + 16 * RS;
    LAS float* part = (LAS float*)(F.lds + 69632);
    LAS int* hist = (LAS int*)(F.lds + 98304);
    LAS int* basearr = hist + 32;
    LAS int* pinfo = hist + 64;
    LAS float* pwl = (LAS float*)(pinfo + 512);
    const int e = F.lane & 31, g = F.lane >> 4, i16 = F.lane & 15;
    for (int rb = F.bid; rb < M / 128; rb += F.G) {
        const int row0 = rb * 128, b = row0 >= SEQ;
        bf16x8 wh[4][2], wl[4][2];
#pragma unroll
        for (int ks = 0; ks < 4; ++ks)
#pragma unroll
            for (int eb = 0; eb < 2; ++eb) {
                const float* wp = F.w_router + (size_t)(128 * F.wave + 32 * ks + 8 * g) * NE + 16 * eb + i16;
                float w[8];
#pragma unroll
                for (int j = 0; j < 8; ++j) w[j] = wp[j * NE];
                u32x4 hi, lo;
                hi.x = pk2(w[0], w[1]); hi.y = pk2(w[2], w[3]); hi.z = pk2(w[4], w[5]); hi.w = pk2(w[6], w[7]);
                lo.x = pk2(w[0] - bflo(hi.x), w[1] - bfhi(hi.x)); lo.y = pk2(w[2] - bflo(hi.y), w[3] - bfhi(hi.y));
                lo.z = pk2(w[4] - bflo(hi.z), w[5] - bfhi(hi.z)); lo.w = pk2(w[6] - bflo(hi.w), w[7] - bfhi(hi.w));
                wh[ks][eb] = __builtin_bit_cast(bf16x8, hi); wl[ks][eb] = __builtin_bit_cast(bf16x8, lo);
            }
        f32x4 cs[4], sh[4];
#pragma unroll
        for (int j = 0; j < 4; ++j) {
            const f32x4 w = ((const f32x4*)F.norm2)[F.lane + 64 * j], sc = ((const f32x4*)(F.mod + b * 6144 + 4096))[F.lane + 64 * j];
            cs[j] = w * (sc + 1.0f); sh[j] = ((const f32x4*)(F.mod + b * 6144 + 3072))[F.lane + 64 * j];
        }
        const float brt = F.b_router[e];
        if (F.tid < 32) hist[F.tid] = 0;
        f32x4 va[4], vb[4];
#if X1_BF16
        { const u32x2* xa = (const u32x2*)((const bf16_t*)F.x1 + (size_t)(row0 + 2 * F.wave) * D) + F.lane;
#pragma unroll
          for (int j = 0; j < 4; ++j) { va[j] = bf4_to_f32(xa[64 * j]); vb[j] = bf4_to_f32(xa[256 + 64 * j]); } }
#else
        { const f32x4* xa = (const f32x4*)(F.x1 + (size_t)(row0 + 2 * F.wave) * D) + F.lane;
#pragma unroll
          for (int j = 0; j < 4; ++j) { va[j] = xa[64 * j]; vb[j] = xa[256 + 64 * j]; } }
#endif
        __syncthreads();
#pragma unroll 1
        for (int batch = 0; batch < 8; ++batch) {
            {
                const int rl0 = 2 * F.wave, rowa = row0 + batch * 16 + rl0;
                float sa = 0.f, sb = 0.f;
#pragma unroll
                for (int j = 0; j < 4; ++j) { sa += (va[j].x * va[j].x + va[j].y * va[j].y) + (va[j].z * va[j].z + va[j].w * va[j].w); sb += (vb[j].x * vb[j].x + vb[j].y * vb[j].y) + (vb[j].z * vb[j].z + vb[j].w * vb[j].w); }
                const float ra = __builtin_amdgcn_rsqf(wave_sum(sa) * (1.0f / D) + EPS), rbb = __builtin_amdgcn_rsqf(wave_sum(sb) * (1.0f / D) + EPS);
#if MOE_FP8
                unsigned* oa = (unsigned*)((unsigned char*)F.hbuf + (size_t)rowa * D) + F.lane;
#else
                u32x2* oa = (u32x2*)(F.hbuf + (size_t)rowa * D) + F.lane;
#endif
#pragma unroll
                for (int j = 0; j < 4; ++j) {
                    const f32x4 ha = va[j] * ra * cs[j] + sh[j], hb = vb[j] * rbb * cs[j] + sh[j];
#if MOE_FP8
                    oa[64 * j] = pk4_fp8(ha.x * H8_SCALE, ha.y * H8_SCALE, ha.z * H8_SCALE, ha.w * H8_SCALE);
                    oa[256 + 64 * j] = pk4_fp8(hb.x * H8_SCALE, hb.y * H8_SCALE, hb.z * H8_SCALE, hb.w * H8_SCALE);
#else
                    u32x2 p; p.x = pk2(ha.x, ha.y); p.y = pk2(ha.z, ha.w); oa[64 * j] = p;
                    p.x = pk2(hb.x, hb.y); p.y = pk2(hb.z, hb.w); oa[256 + 64 * j] = p;
#endif
                    u32x2 h1, l1, h2_, l2_;
                    h1.x = pk2(ha.x, ha.y); h1.y = pk2(ha.z, ha.w); l1.x = pk2(ha.x - bflo(h1.x), ha.y - bfhi(h1.x)); l1.y = pk2(ha.z - bflo(h1.y), ha.w - bfhi(h1.y));
                    h2_.x = pk2(hb.x, hb.y); h2_.y = pk2(hb.z, hb.w); l2_.x = pk2(hb.x - bflo(h2_.x), hb.y - bfhi(h2_.x)); l2_.y = pk2(hb.z - bflo(h2_.y), hb.w - bfhi(h2_.y));
                    const int co = (4 * F.lane + 256 * j) * 2;
                    *(LAS u32x2*)(hh + rl0 * RS + co) = h1; *(LAS u32x2*)(hlo + rl0 * RS + co) = l1;
                    *(LAS u32x2*)(hh + (rl0 + 1) * RS + co) = h2_; *(LAS u32x2*)(hlo + (rl0 + 1) * RS + co) = l2_;
                }
                if (batch < 7) {
#if X1_BF16
                    const u32x2* xn = (const u32x2*)((const bf16_t*)F.x1 + (size_t)(rowa + 16) * D) + F.lane;
#pragma unroll
                    for (int j = 0; j < 4; ++j) { va[j] = bf4_to_f32(xn[64 * j]); vb[j] = bf4_to_f32(xn[256 + 64 * j]); }
#else
                    const f32x4* xn = (const f32x4*)(F.x1 + (size_t)(rowa + 16) * D) + F.lane;
#pragma unroll
                    for (int j = 0; j < 4; ++j) { va[j] = xn[64 * j]; vb[j] = xn[256 + 64 * j]; }
#endif
                }
            }
            __syncthreads();
            {
                f32x4 acc0 = (f32x4){0.f, 0.f, 0.f, 0.f}, acc1 = acc0;
#pragma unroll
                for (int ks = 0; ks < 4; ++ks) {
                    const int off = i16 * RS + (128 * F.wave + 32 * ks + 8 * g) * 2;
                    const bf16x8 ah = *(const LAS bf16x8*)(hh + off), al = *(const LAS bf16x8*)(hlo + off);
                    acc0 = __builtin_amdgcn_mfma_f32_16x16x32_bf16(ah, wh[ks][0], acc0, 0, 0, 0);
                    acc0 = __builtin_amdgcn_mfma_f32_16x16x32_bf16(ah, wl[ks][0], acc0, 0, 0, 0);
                    acc0 = __builtin_amdgcn_mfma_f32_16x16x32_bf16(al, wh[ks][0], acc0, 0, 0, 0);
                    acc1 = __builtin_amdgcn_mfma_f32_16x16x32_bf16(ah, wh[ks][1], acc1, 0, 0, 0);
                    acc1 = __builtin_amdgcn_mfma_f32_16x16x32_bf16(ah, wl[ks][1], acc1, 0, 0, 0);
                    acc1 = __builtin_amdgcn_mfma_f32_16x16x32_bf16(al, wh[ks][1], acc1, 0, 0, 0);
                }
#pragma unroll
                for (int r = 0; r < 4; ++r) { part[((4 * g + r) * 8 + F.wave) * 32 + i16] = acc0[r]; part[((4 * g + r) * 8 + F.wave) * 32 + 16 + i16] = acc1[r]; }
            }
            __syncthreads();
#pragma unroll
            for (int rr = 0; rr < 2; ++rr) {
                const int rl = 2 * F.wave + rr, rloc = batch * 16 + rl;
                float val = brt;
#pragma unroll
                for (int p = 0; p < 8; ++p) val += part[(rl * 8 + p) * 32 + e];
                if (F.lane >= 32) val = -INFINITY;
                int sel[4]; float sv[4];
#pragma unroll
                for (int k = 0; k < 4; ++k) {
                    const float rm = row16_max(val);
                    const float mx = fmaxf(__builtin_bit_cast(float, __builtin_amdgcn_readlane(__builtin_bit_cast(int, rm), 0)), __builtin_bit_cast(float, __builtin_amdgcn_readlane(__builtin_bit_cast(int, rm), 16)));
                    const unsigned long long bal = __ballot(val == mx && F.lane < 32);
                    const int idx = bal ? (int)__builtin_ctzll(bal) : 0;
                    sel[k] = idx; sv[k] = mx;
                    if (F.lane == idx) val = -INFINITY;
                }
                const float e1 = __expf(sv[1] - sv[0]), e2 = __expf(sv[2] - sv[0]), e3 = __expf(sv[3] - sv[0]);
                const float inv = 1.0f / (1.0f + e1 + e2 + e3);
                if (F.lane < 4) {
                    const int k = F.lane;
                    const int se = k == 0 ? sel[0] : k == 1 ? sel[1] : k == 2 ? sel[2] : sel[3];
                    const float wv = (k == 0 ? 1.0f : k == 1 ? e1 : k == 2 ? e2 : e3) * inv;
                    const int lr = __hip_atomic_fetch_add(hist + se, 1, __ATOMIC_RELAXED, __HIP_MEMORY_SCOPE_WORKGROUP);
                    pinfo[rloc * 4 + k] = se | (lr << 8);
                    pwl[rloc * 4 + k] = wv;
                }
            }
            __syncthreads();
        }
        if (F.tid < 32) basearr[F.tid] = (int)atomicAdd(F.ctl + CW_CNT + 64 * F.tid, (unsigned)hist[F.tid]);
        __syncthreads();
        { const int info = pinfo[F.tid], ee = info & 255, lr = info >> 8; u32x2 rec; rec.x = (unsigned)(row0 * 4 + F.tid); rec.y = __builtin_bit_cast(unsigned, pwl[F.tid]); F.perm[(size_t)ee * ECAP + basearr[ee] + lr] = rec; }
        __syncthreads();
    }
}

DI void moe_order(Frame& F, pg8::MoeOrder& S, int NT, const void* Bt, size_t bstride, int ebytes, int sa, int sb) {
    LAS int* mi = (LAS int*)(F.lds + MISC_OFF);
    LAS int* ud = (LAS int*)(F.lds + UD_OFF);
    if (F.tid < 32) mi[F.tid] = (int)F.ctl[CW_CNT + 64 * F.tid];
    __syncthreads();
    if (F.tid == 0) { int o = 0, tp = 0; for (int i = 0; i < NE; ++i) { mi[32 + i] = o; mi[64 + i] = tp; o += mi[i]; tp += (mi[i] + 255) >> 8; } mi[96] = tp; }
    __syncthreads();
    const int x = F.bid & 7, JB = F.G >> 3, j = F.bid >> 3;
    const int ptot = mi[96], lo = ptot * x / 8, hi = ptot * (x + 1) / 8, U = (hi - lo) * NT;
    if (F.tid < 64) {
        const int q = j + F.tid * JB;
        if (q < U) {
            const int pl = q / NT, pn = q % NT, g = lo + pl;
            int e = 0;
            for (int k = 1; k < NE; ++k) e += (mi[64 + k] <= g) ? 1 : 0;
            const int p = g - mi[64 + e], left = mi[e] - p * 256;
            i32x4_ r; r.x = e | (pn << 8) | (((pn + 2 * pl) & 7) << 16); r.y = left < 256 ? left : 256; r.z = mi[32 + e] + p * 256; r.w = e * ECAP + p * 256;
            *(LAS i32x4_*)(ud + 4 * F.tid) = r;
        }
    }
    __syncthreads();
    const int nu = U > j ? (U - j + JB - 1) / JB : 0;
    S.n = __builtin_amdgcn_readfirstlane(nu < 64 ? nu : 64); S.ud = ud; S.Bt = Bt; S.bstride = bstride; S.ebytes = ebytes; S.sa = sa; S.sb = sb;
}
struct MoeBatch {
    pg8::MoeOrder S; int i0, n;
    DI bool next(int i, pg8::Unit& u) const { if (i >= n) return false; return S.next(i0 + i, u); }
    DI const char* bptr(const pg8::Unit& u) const { return S.bptr(u); }
    DI int scale_a() const { return S.sa; }
    DI int scale_b() const { return S.sb; }
};

DI void p8_gu(Frame& F) {
    { int t_ = threadIdx.x; asm volatile("" : "+v"(t_)); F.tid = t_; F.lane = t_ & 63; }
    pg8::MoeOrder S; moe_order(F, S, 8, F.wgu_t, (size_t)2048 * D, MOE_FP8 ? 1 : 2, H8_E8M0, W8_E8M0);
    LAS unsigned* tbl = (LAS unsigned*)(F.lds + TBL_OFF);
    EpiGU E{F.b_gu, F.act};
    for (int i0 = 0;; i0 += TBL_UNITS) {
        pg8::Unit u; if (!S.next(i0, u)) break;
        int n;
        {
            int t_ = threadIdx.x; asm volatile("" : "+v"(t_));
            const int ln = t_ & 63, half = __builtin_amdgcn_readfirstlane(t_ >> 8), idx = t_ & 255;
            pg8::Unit uk; uk.prow0 = 0; uk.rows = 0;
            const bool ok = ln < TBL_UNITS && S.next_lane(i0 + ln, uk);
            n = __builtin_popcountll(__ballot(ok));
            const int pv = ok ? uk.prow0 : 0, rv = ok ? uk.rows : 0;
            unsigned pr[TBL_UNITS / 2];
#pragma unroll
            for (int it = 0; it < TBL_UNITS / 2; ++it) {
                const int k = 2 * it + half; pr[it] = 0u;
                if (k < n) { const int p0 = __builtin_amdgcn_readlane(pv, k), rw = __builtin_amdgcn_readlane(rv, k); pr[it] = F.perm[p0 + (idx < rw ? idx : 0)].x; }
            }
#pragma unroll
            for (int it = 0; it < TBL_UNITS / 2; ++it) { const int k = 2 * it + half; if (k < n) tbl[k * 256 + idx] = (pr[it] >> 2) * (unsigned)(D * (MOE_FP8 ? 1 : 2)); }
        }
        __syncthreads();
        MoeBatch Bt{S, i0, n};
        pg8::gemm_phase<EpiGU, MoeBatch, true, (MOE_FP8 != 0)>(F.lds, F.hbuf, Bt, E, tbl);
        __syncthreads();
    }
}
DI void p9_down(Frame& F) {
    { int t_ = threadIdx.x; asm volatile("" : "+v"(t_)); F.tid = t_; F.lane = t_ & 63; }
    pg8::MoeOrder S; moe_order(F, S, 4, F.wd_t, (size_t)D * D, MOE_FP8 ? 1 : 2, A8_E8M0, W8_E8M0);
    LAS unsigned* tbl = (LAS unsigned*)(F.lds + TBL_OFF);
    EpiDown E{F.b_down, F.perm, F.Y};
    for (int i0 = 0;; i0 += TBL_UNITS) {
        pg8::Unit u; if (!S.next(i0, u)) break;
        int n = 0;
        for (; n < TBL_UNITS; ++n) {
            if (!S.next(i0 + n, u)) break;
            int t_ = threadIdx.x; asm volatile("" : "+v"(t_));
            if (t_ < 256) tbl[n * 256 + t_] = (unsigned)(u.arow0 + t_) * (unsigned)(D * (MOE_FP8 ? 1 : 2));
        }
        __syncthreads();
        MoeBatch Bt{S, i0, n};
        pg8::gemm_phase<EpiDown, MoeBatch, true, (MOE_FP8 != 0), true>(F.lds, F.act, Bt, E, tbl);
        __syncthreads();
    }
}

DI void p10_final(Frame& F) {
    { int t_ = threadIdx.x; asm volatile("" : "+v"(t_)); F.tid = t_; F.lane = t_ & 63; }
    const int gw = F.bid * NWAVES + F.wave, NGW = F.G * NWAVES;
    f32x4 xv[4], xn[4]; int yv[4][4], yn[4][4];
#if X1_BF16
#define P10_XLOAD(xr_, j_) bf4_to_f32(__builtin_nontemporal_load((const u32x2*)((const bf16_t*)(xr_)) + F.lane + 64 * (j_)))
#else
#define P10_XLOAD(xr_, j_) __builtin_nontemporal_load((const f32x4*)(xr_) + F.lane + 64 * (j_))
#endif
#define P10_LOAD(X_, Y_, m_) do { const void* xr_ = X1_BF16 ? (const void*)((const bf16_t*)F.x1 + (size_t)(m_) * D) : (const void*)(F.x1 + (size_t)(m_) * D); \
        _Pragma("unroll") for (int j = 0; j < 4; ++j) { X_[j] = P10_XLOAD(xr_, j); \
            _Pragma("unroll") for (int k = 0; k < 4; ++k) Y_[j][k] = __builtin_nontemporal_load((const int*)((const unsigned char*)F.Y + ((size_t)(m_) * 4 + k) * D * (Y_FP8 ? 1 : 2)) + F.lane + 64 * j); } } while (0)
    static_assert(Y_FP8, "p10_final reads fp8 rows");
    if (gw < M) P10_LOAD(xv, yv, gw);
    for (int m = gw; m < M; m += NGW) {
        const int b = m >= SEQ;
        if (m + NGW < M) P10_LOAD(xn, yn, m + NGW);
        const f32x4* gr = (const f32x4*)(F.mod + b * 6144 + 5120) + F.lane;
        f32x4 v[4]; float s = 0.f;
#pragma unroll
        for (int j = 0; j < 4; ++j) {
            f32x4 y = (f32x4){0.f, 0.f, 0.f, 0.f};
#pragma unroll
            for (int k = 0; k < 4; ++k) {
                const f32x2 lo = __builtin_amdgcn_cvt_pk_f32_fp8(yv[j][k], false), hi = __builtin_amdgcn_cvt_pk_f32_fp8(yv[j][k], true);
                y += (f32x4){lo.x, lo.y, hi.x, hi.y};
            }
            v[j] = xv[j] + gr[64 * j] * (y * Y8_INV);
            s += (v[j].x * v[j].x + v[j].y * v[j].y) + (v[j].z * v[j].z + v[j].w * v[j].w);
        }
        const float rstd = __builtin_amdgcn_rsqf(wave_sum(s) * (1.0f / D) + EPS);
        f32x4* o = (f32x4*)(F.out + (size_t)m * D) + F.lane;
#pragma unroll
        for (int j = 0; j < 4; ++j) __builtin_nontemporal_store(v[j] * rstd * ((const f32x4*)F.norm_f)[F.lane + 64 * j], o + 64 * j);
#pragma unroll
        for (int j = 0; j < 4; ++j) { xv[j] = xn[j];
#pragma unroll
            for (int k = 0; k < 4; ++k) yv[j][k] = yn[j][k]; }
    }
#undef P10_LOAD
}

constexpr int NPH = 11;
template <int LO, int HI>
__global__ void __launch_bounds__(NTHREADS, 2) fwd_kernel(Args args) {
    extern __shared__ __attribute__((aligned(16))) unsigned char lds[];
    Frame F;
    F.lds = (LAS unsigned char*)lds;
    F.tid = threadIdx.x; F.lane = F.tid & 63; F.wave = __builtin_amdgcn_readfirstlane(F.tid >> 6);
    F.G = gridDim.x; F.bid = blockIdx.x;
    F.x = (const float*)args.in[0]; F.c = (const float*)args.in[1]; F.positions = (const int*)args.in[2]; F.w_ada = (const float*)args.in[3]; F.b_ada = (const float*)args.in[4];
    F.norm1 = (const float*)args.in[5]; F.w_in = (const float*)args.in[6]; F.w_gk2 = (const float*)args.in[7]; F.b_gk = (const float*)args.in[8]; F.gla_onorm = (const float*)args.in[9];
    F.ret_onorm = (const float*)args.in[10]; F.w_out = (const float*)args.in[11]; F.norm2 = (const float*)args.in[12]; F.w_router = (const float*)args.in[13]; F.b_router = (const float*)args.in[14];
    F.w_gu = (const float*)args.in[15]; F.b_gu = (const float*)args.in[16]; F.w_down = (const float*)args.in[17]; F.b_down = (const float*)args.in[18]; F.norm_f = (const float*)args.in[19];
    F.out = args.out; F.ws = args.ws;
    unsigned char* ws = args.ws;
    F.ctl = (unsigned*)(ws + WS_CTL); F.mod = (float*)(ws + WS_MOD); F.win_t = (bf16_t*)(ws + WS_WIN); F.wout_t = (bf16_t*)(ws + WS_WOUT); F.wgu_t = (bf16_t*)(ws + WS_WGU); F.wd_t = (bf16_t*)(ws + WS_WD);
    F.hbuf = (bf16_t*)(ws + WS_H); F.obuf = (bf16_t*)(ws + WS_O); F.proj = (bf16_t*)(ws + WS_PROJ); F.act = (bf16_t*)(ws + WS_ACT); F.Y = (bf16_t*)(ws + WS_Y);
    F.x1 = (float*)(ws + WS_X1); F.bcum = (float*)(ws + WS_BCUM); F.pw = (float*)(ws + WS_PW); F.perm = (u32x2*)(ws + WS_PERM);

#define IN(k) (LO <= (k) && (k) < HI)
#if ONE_LAUNCH && USE_CG_SYNC
#define GSYNC(k) do { if (IN(k) && IN((k) + 1)) { cg::this_grid().sync(); } } while (0)
#elif ONE_LAUNCH
    { volatile LAS unsigned* st = (volatile LAS unsigned*)(F.lds + MISC_OFF + 512); if (F.tid < 2) st[F.tid] = 0u; }
    __syncthreads();
    const XcdBarrier bar = xcd_barrier_post(F.ctl + CW_BAR, (volatile LAS unsigned*)(F.lds + MISC_OFF + 512));
#define GSYNC(k) do { if (IN(k) && IN((k) + 1)) { xcd_barrier(bar); } } while (0)
#else
#define GSYNC(k) do { } while (0)
#endif
    if (IN(0)) { p0_prep(F); if (DUP(0)) p0_prep(F); } GSYNC(0);
    if (IN(1)) { p1_h1(F); if (DUP(1)) p1_h1(F); } GSYNC(1);
    if (IN(2)) {
        pg8::DenseOrder S; S.init(M, NIN_T, F.G, F.bid, F.win_t);
        EpiProj E{F.proj, F.bcum, F.positions, F.b_gk};
        pg8::gemm_phase<EpiProj, pg8::DenseOrder, false>(F.lds, F.hbuf, S, E, nullptr);
        if (DUP(2)) pg8::gemm_phase<EpiProj, pg8::DenseOrder, false>(F.lds, F.hbuf, S, E, nullptr);
        { pg8::Unit u8; if (F.G == 256 && !S.next(7, u8)) {
            { int t_ = threadIdx.x; asm volatile("" : "+v"(t_)); F.tid = t_; F.lane = t_ & 63; }
            const int nidle = F.G - (1920 - 7 * F.G), widx = (F.bid - (1920 - 7 * F.G)) * NWAVES + F.wave;
            if (nidle > 0 && widx >= 0) tr_range(F, (LAS float*)(F.lds + 16384 + F.wave * 8704), TR_SPLIT1, TR_SPLIT2, widx, nidle * NWAVES); } }
    } GSYNC(2);
#if NAIVE_LA
    if (IN(3)) { p3_la_naive(F); } GSYNC(3);
    GSYNC(4);
    GSYNC(5);
#else
    if (IN(3)) { p3_la_pass1(F); if (DUP(3)) p3_la_pass1(F); } GSYNC(3);
    if (IN(4)) { p4_la_scan(F); if (DUP(4)) p4_la_scan(F); } GSYNC(4);
    if (IN(5)) { p5_la_pass3(F); if (DUP(5)) p5_la_pass3(F); } GSYNC(5);
#endif
    if (IN(6)) {
        pg8::DenseOrder S; S.init(M, D, F.G, F.bid, F.wout_t);
        EpiRes1 E{F.x, F.mod, F.x1};
        pg8::gemm_phase<EpiRes1, pg8::DenseOrder, false, false, true>(F.lds, F.obuf, S, E, nullptr);
        if (DUP(6)) pg8::gemm_phase<EpiRes1, pg8::DenseOrder, false, false, true>(F.lds, F.obuf, S, E, nullptr);
    } GSYNC(6);
    if (IN(7)) { p7_router(F); } GSYNC(7);
    if (IN(8)) { p8_gu(F); if (DUP(8)) p8_gu(F); } GSYNC(8);
    if (IN(9)) { p9_down(F); if (DUP(9)) p9_down(F); } GSYNC(9);
    if (IN(10)) { p10_final(F); if (DUP(10)) p10_final(F); }
}

extern "C" void kernel_launch(void* const* d_in, const int* in_sizes, int n_in, void* d_out, int out_size, void* d_ws, size_t ws_size, hipStream_t stream) {
    static int grid = 0;
    if (grid == 0) {
        if (n_in != 20 || out_size != M * D || ws_size < WS_END) { fprintf(stderr, "kernel_launch: unexpected shapes (n_in %d out %d ws %zu)\n", n_in, out_size, ws_size); grid = -1; return; }
        int dev = 0, cus = 0, per_cu = 0;
        hipGetDevice(&dev); hipDeviceGetAttribute(&cus, hipDeviceAttributeMultiprocessorCount, dev);
#if ONE_LAUNCH
        hipFuncSetAttribute((const void*)fwd_kernel<0, NPH>, hipFuncAttributeMaxDynamicSharedMemorySize, LDS_BYTES);
        hipOccupancyMaxActiveBlocksPerMultiprocessor(&per_cu, (const void*)fwd_kernel<0, NPH>, NTHREADS, LDS_BYTES);
#else
        per_cu = 1;
#define SETATTR(k) hipFuncSetAttribute((const void*)fwd_kernel<k, k + 1>, hipFuncAttributeMaxDynamicSharedMemorySize, LDS_BYTES)
        SETATTR(0); SETATTR(1); SETATTR(2); SETATTR(3); SETATTR(4); SETATTR(5); SETATTR(6); SETATTR(7); SETATTR(8); SETATTR(9); SETATTR(10);
#endif
        (void)hipGetLastError();
        if (per_cu < 1) { fprintf(stderr, "kernel_launch: occupancy query says %d blocks/CU\n", per_cu); per_cu = 1; }
        grid = cus;
        if (grid != 256) fprintf(stderr, "kernel_launch: %d CUs (expected 256)\n", grid);
    }
    if (grid < 0) return;
    hipMemsetAsync((char*)d_ws + WS_CTL, 0, CTL_ZERO_BYTES, stream);
    Args a{};
    for (int i = 0; i < 20; ++i) a.in[i] = d_in[i];
    a.out = (float*)d_out; a.ws = (unsigned char*)d_ws;
#if ONE_LAUNCH
    a.ph_lo = 0; a.ph_hi = NPH;
#if USE_CG_SYNC
    void* params[] = {&a};
    hipError_t e = hipLaunchCooperativeKernel((const void*)fwd_kernel<0, NPH>, dim3(grid), dim3(NTHREADS), params, LDS_BYTES, stream);
    if (e != hipSuccess) fprintf(stderr, "cooperative launch failed: %s (grid %d)\n", hipGetErrorString(e), grid);
#else
    hipLaunchKernelGGL((fwd_kernel<0, NPH>), dim3(grid), dim3(NTHREADS), LDS_BYTES, stream, a);
#endif
#else
#define LAUNCH(k) hipLaunchKernelGGL((fwd_kernel<k, k + 1>), dim3(grid), dim3(NTHREADS), LDS_BYTES, stream, a)
    LAUNCH(0); LAUNCH(1); LAUNCH(2); LAUNCH(3); LAUNCH(4); LAUNCH(5); LAUNCH(6); LAUNCH(7); LAUNCH(8); LAUNCH(9); LAUNCH(10);
#endif
}
```

```cpp
#include <hip/hip_runtime.h>
#include <hip/hip_cooperative_groups.h>
#include <cstdio>
#include <cstdint>
namespace cg = cooperative_groups;

#ifndef ONE_LAUNCH
#define ONE_LAUNCH 1
#endif
#ifndef USE_CG_SYNC
#define USE_CG_SYNC 0
#endif
#ifndef PROBE_DUP
#define PROBE_DUP -1
#endif
#define DUP(k) (PROBE_DUP == (k))
#ifndef MOE_FP8
#define MOE_FP8 1
#endif
#ifndef Y_FP8
#define Y_FP8 1
#endif
#ifndef X1_BF16
#define X1_BF16 1
#endif
#ifndef O_FP8
#define O_FP8 1
#endif
#ifndef NAIVE_LA
#define NAIVE_LA 0
#endif

#define LAS __attribute__((address_space(3)))
#define DI __device__ __forceinline__
typedef unsigned short bf16_t;
typedef short bf16x8 __attribute__((ext_vector_type(8)));
typedef float f32x4 __attribute__((ext_vector_type(4)));
typedef float f32x2 __attribute__((ext_vector_type(2)));
typedef unsigned u32x4 __attribute__((ext_vector_type(4)));
typedef unsigned u32x2 __attribute__((ext_vector_type(2)));
typedef int i32x4 __attribute__((ext_vector_type(4)));
typedef int i32x8 __attribute__((ext_vector_type(8)));

constexpr int D = 1024, BATCH = 2, SEQ = 16384, M = BATCH * SEQ;
constexpr int NPROJ = 3584;
constexpr int NIN_T = 3840;
constexpr int MIX_IN = 3600;
constexpr int NE = 32, TOPK = 4, NPAIR = M * TOPK;
constexpr int ECAP = 32768;
constexpr float EPS = 1e-6f;
constexpr int NWAVES = 8, NTHREADS = 512;

constexpr size_t MiB = 1u << 20;
constexpr size_t WS_CTL = 0, CTL_ZERO_BYTES = 65536;
constexpr size_t WS_MOD = 1 * MiB;
constexpr size_t WS_DEC = 1 * MiB + 65536;
constexpr size_t WS_WIN = 2 * MiB;
constexpr size_t WS_WOUT = 10 * MiB;
constexpr size_t WS_WGU = 12 * MiB;
constexpr size_t WS_WD = 140 * MiB;
constexpr size_t WS_H = 204 * MiB;
constexpr size_t WS_O = 268 * MiB;
constexpr size_t WS_X1 = 332 * MiB;
constexpr size_t WS_PROJ = 460 * MiB;
constexpr size_t WS_BCUM = 684 * MiB;
constexpr size_t WS_U = 716 * MiB;
constexpr size_t WS_SP = 812 * MiB;
constexpr size_t WS_ACT = 460 * MiB;
constexpr size_t WS_Y = 717 * MiB;
constexpr size_t WS_PERM = 973 * MiB;
constexpr size_t WS_PW = 981 * MiB;
constexpr size_t WS_END = 982 * MiB;
constexpr int CW_CNT = 1024;
constexpr int CW_BAR = 8192;

constexpr int RING_BYTES = 131072;
constexpr int TBL_OFF = RING_BYTES, TBL_UNITS = 22, UD_OFF = TBL_OFF + TBL_UNITS * 1024, TBL_BYTES = 24 * 1024;
constexpr int MISC_OFF = TBL_OFF + TBL_BYTES;
constexpr int EPI_OFF = MISC_OFF + 1024;
constexpr int LDS_BYTES = EPI_OFF + 4096;

DI unsigned f2bf(float f) { unsigned u = __builtin_bit_cast(unsigned, f); return (u + 0x7fffu + ((u >> 16) & 1u)) >> 16; }
DI unsigned pk2(float lo, float hi) { return f2bf(lo) | (f2bf(hi) << 16); }
DI float bf2f(unsigned h) { return __builtin_bit_cast(float, h << 16); }
DI float bflo(unsigned w) { return __builtin_bit_cast(float, w << 16); }
DI float bfhi(unsigned w) { return __builtin_bit_cast(float, w & 0xffff0000u); }
DI f32x4 bf4_to_f32(u32x2 w) { return (f32x4){bflo(w.x), bfhi(w.x), bflo(w.y), bfhi(w.y)}; }
DI unsigned cvt_pk_bf16(float lo, float hi) { unsigned r; asm volatile("v_cvt_pk_bf16_f32 %0, %1, %2" : "=v"(r) : "v"(lo), "v"(hi)); return r; }
#define DPPF_(v, ctrl) __builtin_bit_cast(float, __builtin_amdgcn_update_dpp(__builtin_bit_cast(int, v), __builtin_bit_cast(int, v), ctrl, 0xf, 0xf, false))
DI float row16_sum(float v) {
    v += DPPF_(v, 0xB1); v += DPPF_(v, 0x4E); v += DPPF_(v, 0x141); v += DPPF_(v, 0x140); return v;
}
DI float wave_sum(float v) {
    v = row16_sum(v);
    const int iv = __builtin_bit_cast(int, v);
    const float a = __builtin_bit_cast(float, __builtin_amdgcn_readlane(iv, 0)), b = __builtin_bit_cast(float, __builtin_amdgcn_readlane(iv, 16));
    const float c = __builtin_bit_cast(float, __builtin_amdgcn_readlane(iv, 32)), d = __builtin_bit_cast(float, __builtin_amdgcn_readlane(iv, 48));
    return (a + b) + (c + d);
}
DI float wave_max(float v) {
#pragma unroll
    for (int o = 1; o < 64; o <<= 1) v = fmaxf(v, __shfl_xor(v, o));
    return v;
}
DI float sigmoidf_(float x) { return __builtin_amdgcn_rcpf(1.0f + __builtin_amdgcn_exp2f(-1.4426950408889634f * x)); }
DI float logsigmoidf_(float x) { return fminf(x, 0.f) - 0.6931471805599453f * __builtin_amdgcn_logf(1.0f + __builtin_amdgcn_exp2f(-1.4426950408889634f * fabsf(x))); }
#define LDS_WAIT() asm volatile("s_waitcnt lgkmcnt(0)" ::: "memory")
DI unsigned pk4_fp8(float a, float b, float c, float d) {
    a = __builtin_amdgcn_fmed3f(a, -448.f, 448.f); b = __builtin_amdgcn_fmed3f(b, -448.f, 448.f); c = __builtin_amdgcn_fmed3f(c, -448.f, 448.f); d = __builtin_amdgcn_fmed3f(d, -448.f, 448.f);
    int p = __builtin_amdgcn_cvt_pk_fp8_f32(a, b, 0, false); p = __builtin_amdgcn_cvt_pk_fp8_f32(c, d, p, true); return (unsigned)p;
}
DI unsigned pk4_fp8_nc(float a, float b, float c, float d) { int p = __builtin_amdgcn_cvt_pk_fp8_f32(a, b, 0, false); p = __builtin_amdgcn_cvt_pk_fp8_f32(c, d, p, true); return (unsigned)p; }
constexpr float Y8_SCALE = 32.f, Y8_INV = 1.0f / 32.f;
constexpr float W8_SCALE = 512.f, H8_SCALE = 16.f, A8_SCALE = 4.f;
constexpr float O8_SCALE = 16.f; constexpr int O8_E8M0 = 0x7B7B7B7B;
constexpr int W8_E8M0 = 0x76767676, H8_E8M0 = 0x7B7B7B7B, A8_E8M0 = 0x7D7D7D7D;

typedef int i32x4_ __attribute__((ext_vector_type(4)));
namespace pg8 {
constexpr int BM = 256, BK = 64, HALF = 128, HTB = HALF * BK * 2, STAGE_BYTES = 8 * HTB, NXCD = 8, WGM = 8, K = 1024;
__host__ __device__ __forceinline__ int lds_byte(int r, int c) { const int st = (r >> 4) * 2 + (c >> 5), rr = r & 15, cc = c & 31, ob = rr * 64 + cc * 2; return st * 1024 + (ob ^ (((ob >> 9) & 1) << 5)); }
__host__ __device__ __forceinline__ void stage_rc(int b, int& R, int& C) { const int st = b / 1024, sb = b % 1024, swz = sb ^ (((sb >> 9) & 1) << 5); R = (st >> 1) * 16 + swz / 64; C = (st & 1) * 32 + (swz % 64) / 2; }
__host__ __device__ __forceinline__ int perm32(int rho) { const int n = rho >> 4, i = rho & 15; return 8 * (i >> 2) + 4 * n + (i & 3); }

struct Unit { int arow0, pn, e, rows, prow0, rot; };

struct DenseOrder {
    int nM, nN, nwg, G, c;
    const bf16_t* Bt; int ebytes, sa, sb;
    DI void init(int M_, int N_, int G_, int c_, const bf16_t* Bt_, int ebytes_ = 2, int sa_ = 0x7f7f7f7f, int sb_ = 0x7f7f7f7f) { nM = M_ / BM; nN = N_ / BM; nwg = nM * nN; G = G_; c = c_; Bt = Bt_; ebytes = ebytes_; sa = sa_; sb = sb_; }
    DI bool next(int i, Unit& u) const {
        const long L = (long)i * G + c; if (L >= nwg) return false;
        int wgid = (int)L; { const int q = nwg / NXCD, r = nwg % NXCD, xcd = wgid % NXCD, off = wgid / NXCD; wgid = (xcd < r ? xcd * (q + 1) : r * (q + 1) + (xcd - r) * q) + off; }
        const int nig = WGM * nN, gid = wgid / nig, fm = gid * WGM, gsz = (nM - fm) < WGM ? (nM - fm) : WGM;
        const int pm = fm + ((wgid % nig) % gsz); u.pn = (wgid % nig) / gsz; u.arow0 = pm * BM; u.e = 0; u.rows = BM; u.prow0 = 0; u.rot = (pm + 3 * u.pn) & 15; return true;
    }
    DI const char* bptr(const Unit& u) const { return (const char*)Bt + (size_t)u.pn * BM * K * ebytes; }
    DI int scale_a() const { return sa; }
    DI int scale_b() const { return sb; }
};

struct MoeOrder {
    int n;
    const LAS int* ud;
    const void* Bt; size_t bstride;
    int ebytes, sa, sb;
    DI bool next(int i, Unit& u) const {
        if (i >= n) return false;
        const i32x4_ r = *(const LAS i32x4_*)(ud + 4 * i);
        const int r0 = __builtin_amdgcn_readfirstlane(r.x);
        u.e = r0 & 255; u.pn = (r0 >> 8) & 255; u.rot = r0 >> 16;
        u.rows = __builtin_amdgcn_readfirstlane(r.y); u.arow0 = __builtin_amdgcn_readfirstlane(r.z); u.prow0 = __builtin_amdgcn_readfirstlane(r.w); return true;
    }
    DI bool next_lane(int i, Unit& u) const {
        if (i >= n) return false;
        const i32x4_ r = *(const LAS i32x4_*)(ud + 4 * i);
        u.e = r.x & 255; u.pn = (r.x >> 8) & 255; u.rot = r.x >> 16; u.rows = r.y; u.arow0 = r.z; u.prow0 = r.w; return true;
    }
    DI const char* bptr(const Unit& u) const { return (const char*)Bt + ((size_t)u.e * bstride + (size_t)u.pn * BM * K) * ebytes; }
    DI int scale_a() const { return sa; }
    DI int scale_b() const { return sb; }
};

DI const char* uniform_ptr(const char* p) {
    const unsigned long long v = (unsigned long long)p;
    const unsigned lo = __builtin_amdgcn_readfirstlane((unsigned)v), hi = __builtin_amdgcn_readfirstlane((unsigned)(v >> 32));
    return (const char*)(((unsigned long long)hi << 32) | lo);
}
template <class Epi, class Sched, bool GATHER, bool FP8 = false, bool BMAP16 = false>
DI void gemm_phase(LAS unsigned char* lds, const bf16_t* Abase, const Sched& S, const Epi& E, const LAS unsigned* tbl) {
    int tid = threadIdx.x; asm volatile("" : "+v"(tid));
    const int wid = __builtin_amdgcn_readfirstlane(tid >> 6), lane = tid & 63, wr = wid >> 2, wc = wid & 3, fr = lane & 15, fq = lane >> 4;
    constexpr int KB = FP8 ? K : 2 * K;
    constexpr int nt = KB / 128;
    unsigned voffB[2]; int Rr[2], Cc[2];
#pragma unroll
    for (int i = 0; i < 2; ++i) { int R, C; stage_rc(tid * 16 + i * 8192, R, C);
        const int Rb = BMAP16 ? (64 * (R >> 5) + 16 * ((R & 15) >> 2) + 4 * ((R >> 4) & 1) + (R & 3)) : ((R & ~31) + perm32(R & 31));
        voffB[i] = (unsigned)(Rb * KB + C * 2); Rr[i] = R; Cc[i] = C; }
    const size_t kstep = (size_t)(BK * 2);
    const size_t hstep = BMAP16 ? (size_t)8 * KB : (size_t)HALF * KB;
    const unsigned ldsw = (unsigned)wid * 1024u;
    const int aoff = lds_byte(wr * 64 + fr, fq * 8), boff = lds_byte(wc * 32 + fr, fq * 8);
#define PG8_SA(b, h) (((b) * 2 + (h)) * HTB)
#define PG8_SB(b, h) ((4 + (b) * 2 + (h)) * HTB)
#define PG8_STAGE2(bufoff, gbase, v0, v1) do { \
        __builtin_amdgcn_global_load_lds((const unsigned*)((const char*)(gbase) + (v0)), (LAS unsigned*)(lds + (bufoff) + ldsw), 16, 0, 0); \
        __builtin_amdgcn_global_load_lds((const unsigned*)((const char*)(gbase) + (v1)), (LAS unsigned*)(lds + (bufoff) + ldsw + 8192), 16, 0, 0); } while (0)
#define PG8_STAGEB(bufoff, gbase) PG8_STAGE2(bufoff, gbase, voffB[0], voffB[1])
#define PG8_RD16(off) (*(const LAS i32x4*)(lds + (off)))
#define PG8_LDA(dst, b, h) do { if constexpr (FP8) { _Pragma("unroll") for (int m = 0; m < 4; ++m) dst##8[m] = __builtin_shufflevector(PG8_RD16(PG8_SA(b, h) + aop + m * 2048), PG8_RD16(PG8_SA(b, h) + aop + m * 2048 + 1024), 0, 1, 2, 3, 4, 5, 6, 7); } \
        else { _Pragma("unroll") for (int m = 0; m < 4; ++m) _Pragma("unroll") for (int k = 0; k < 2; ++k) dst[m][k] = *(const LAS bf16x8*)(lds + PG8_SA(b, h) + aoff + m * 2048 + k * 1024); } } while (0)
#define PG8_LDB(dst, b, h) do { if constexpr (FP8) { _Pragma("unroll") for (int n = 0; n < 2; ++n) dst##8[n] = __builtin_shufflevector(PG8_RD16(PG8_SB(b, h) + bop + n * 2048), PG8_RD16(PG8_SB(b, h) + bop + n * 2048 + 1024), 0, 1, 2, 3, 4, 5, 6, 7); } \
        else { _Pragma("unroll") for (int n = 0; n < 2; ++n) _Pragma("unroll") for (int k = 0; k < 2; ++k) dst[n][k] = *(const LAS bf16x8*)(lds + PG8_SB(b, h) + boff + n * 2048 + k * 1024); } } while (0)
#define PG8_MMA(ai, bj, At, Bt) do { __builtin_amdgcn_s_setprio(1); \
        if constexpr (FP8) { _Pragma("unroll") for (int m = 0; m < 4; ++m) _Pragma("unroll") for (int n = 0; n < 2; ++n) \
            acc[ai][bj][m][n] = __builtin_amdgcn_mfma_scale_f32_16x16x128_f8f6f4(Bt##8[n], At##8[m], acc[ai][bj][m][n], 0, 0, 0, sclB, 0, sclA); } \
        else { _Pragma("unroll") for (int m = 0; m < 4; ++m) _Pragma("unroll") for (int n = 0; n < 2; ++n) _Pragma("unroll") for (int k = 0; k < 2; ++k) \
            acc[ai][bj][m][n] = __builtin_amdgcn_mfma_f32_16x16x32_bf16(Bt[n][k], At[m][k], acc[ai][bj][m][n], 0, 0, 0); } \
        __builtin_amdgcn_s_setprio(0); } while (0)
#define PG8_WAIT_V(n) asm volatile("s_waitcnt vmcnt(" #n ")" ::: "memory")
#define PG8_WAIT_L(n) asm volatile("s_waitcnt lgkmcnt(" #n ")" ::: "memory")
#define PG8_BAR __builtin_amdgcn_s_barrier()
#define PG8_SCHED __builtin_amdgcn_sched_barrier(0)
#define PG8_LOADVA(dst00, dst01, dst10, dst11, ui_) do { \
        if constexpr (GATHER) { const LAS unsigned* t_ = tbl + (ui_) * 256; \
            dst00 = t_[Rr[0]] + (unsigned)Cc[0] * 2u; dst01 = t_[Rr[1]] + (unsigned)Cc[1] * 2u; dst10 = t_[128 + Rr[0]] + (unsigned)Cc[0] * 2u; dst11 = t_[128 + Rr[1]] + (unsigned)Cc[1] * 2u; } \
        else { dst00 = (unsigned)(Rr[0] * KB + Cc[0] * 2); dst01 = (unsigned)(Rr[1] * KB + Cc[1] * 2); dst10 = (unsigned)((128 + Rr[0]) * KB + Cc[0] * 2); dst11 = (unsigned)((128 + Rr[1]) * KB + Cc[1] * 2); } } while (0)
    Unit cur, nxt; int ui = 0;
    if (!S.next(0, cur)) return;
    f32x4 acc[2][2][4][2];
    f32x4 bia[2][2];
    E.bias(cur, wc, fq, bia);
    u32x2 pre;
    E.pre_load(cur, tid, pre);
    bf16x8 At[4][2], B0[2][2], B1[2][2];
    i32x8 At8[4], B08[2], B18[2];
    const int sclA = S.scale_a(), sclB = S.scale_b();
    unsigned vA00, vA01, vA10, vA11;
    PG8_LOADVA(vA00, vA01, vA10, vA11, 0);
    const char* cA = GATHER ? (const char*)Abase : (const char*)Abase + (size_t)cur.arow0 * KB;
    const char* cB = S.bptr(cur);
#define PG8_KOFF(rot_, i_) ((size_t)(((i_) + (rot_)) & (nt - 1)) * kstep)
    { const size_t k0_ = PG8_KOFF(cur.rot, 0);
    PG8_STAGEB(PG8_SB(0, 0), cB + k0_); PG8_STAGEB(PG8_SB(0, 1), cB + hstep + k0_); PG8_STAGE2(PG8_SA(0, 0), cA + k0_, vA00, vA01); PG8_STAGE2(PG8_SA(0, 1), cA + k0_, vA10, vA11); }
#define PG8_ACC_INIT() do { _Pragma("unroll") for (int a = 0; a < 2; ++a) _Pragma("unroll") for (int b = 0; b < 2; ++b) _Pragma("unroll") for (int m = 0; m < 4; ++m) _Pragma("unroll") for (int n = 0; n < 2; ++n) acc[a][b][m][n] = bia[b][n]; } while (0)
    PG8_ACC_INIT();
    E.pre_store(pre, tid, lds + EPI_OFF);
    if (wr == 1) PG8_BAR;
    PG8_WAIT_V(2); PG8_BAR;
    { const size_t k1_ = PG8_KOFF(cur.rot, 1);
    PG8_STAGEB(PG8_SB(1, 0), cB + k1_); PG8_STAGE2(PG8_SA(1, 0), cA + k1_, vA00, vA01); PG8_STAGEB(PG8_SB(1, 1), cB + hstep + k1_); }
    PG8_WAIT_V(6); PG8_BAR;
    for (;;) {
        const bool has_next = S.next(ui + 1, nxt);
        const char* nA = cA; const char* nB = cB;
        if (has_next) { nB = S.bptr(nxt); if constexpr (!GATHER) nA = (const char*)Abase + (size_t)nxt.arow0 * KB; }
        const int nrot = has_next ? nxt.rot : cur.rot;
#pragma unroll 1
        for (int t = 0; t < nt; t += 2) {
            const bool last = (t == nt - 2);
            int aop = aoff, bop = boff; asm volatile("" : "+v"(aop), "+v"(bop));
            const size_t o1 = PG8_KOFF(cur.rot, t + 1), o2 = last ? PG8_KOFF(nrot, 0) : PG8_KOFF(cur.rot, t + 2), o3 = last ? PG8_KOFF(nrot, 1) : PG8_KOFF(cur.rot, t + 3);
            const char* a1 = cA + o1; const char* b1x = cB + o1;
            const char* a2 = (last ? nA : cA) + o2; const char* b2 = (last ? nB : cB) + o2;
            const char* a3 = (last ? nA : cA) + o3; const char* b3 = (last ? nB : cB) + o3;
            (void)b1x;
            PG8_LDB(B0, 0, 0); PG8_LDB(B1, 0, 1); PG8_SCHED; PG8_LDA(At, 0, 0); PG8_STAGE2(PG8_SA(1, 1), a1, vA10, vA11);
            if constexpr (GATHER) { if (last && has_next) PG8_LOADVA(vA00, vA01, vA10, vA11, ui + 1); }
            PG8_WAIT_V(8); PG8_WAIT_L(0); PG8_BAR; PG8_MMA(0, 0, At, B0); PG8_MMA(0, 1, At, B1); PG8_BAR; PG8_SCHED;
            PG8_LDA(At, 0, 1); PG8_STAGEB(PG8_SB(0, 0), b2); PG8_STAGEB(PG8_SB(0, 1), b2 + hstep); PG8_STAGE2(PG8_SA(0, 0), a2, vA00, vA01);
            PG8_WAIT_V(8); PG8_WAIT_L(0); PG8_BAR; PG8_MMA(1, 0, At, B0); PG8_MMA(1, 1, At, B1); PG8_BAR; PG8_SCHED;
            PG8_LDB(B0, 1, 0); PG8_LDB(B1, 1, 1); PG8_SCHED; PG8_LDA(At, 1, 0); PG8_STAGE2(PG8_SA(0, 1), a2, vA10, vA11);
            PG8_WAIT_V(8); PG8_WAIT_L(0); PG8_BAR; PG8_MMA(0, 0, At, B0); PG8_MMA(0, 1, At, B1); PG8_BAR; PG8_SCHED;
            PG8_LDA(At, 1, 1); PG8_STAGEB(PG8_SB(1, 0), b3); PG8_STAGEB(PG8_SB(1, 1), b3 + hstep); PG8_STAGE2(PG8_SA(1, 0), a3, vA00, vA01);
            PG8_WAIT_V(8); PG8_WAIT_L(0); PG8_BAR; PG8_MMA(1, 0, At, B0); PG8_MMA(1, 1, At, B1); PG8_BAR; PG8_SCHED;
        }
        if (wr == 0) PG8_BAR;
        if (has_next) { E.bias(nxt, wc, fq, bia); E.pre_load(nxt, tid, pre); }
        E(acc, cur, lds + EPI_OFF + (ui & 1) * 2048, wr, wc, fr, fq);
        if (!has_next) break;
        PG8_ACC_INIT();
        E.pre_store(pre, tid, lds + EPI_OFF + ((ui + 1) & 1) * 2048);
        cur = nxt; cA = nA; cB = nB; ++ui;
        if (wr == 1) PG8_BAR;
    }
    PG8_WAIT_V(0);
    PG8_BAR;
#undef PG8_SA
#undef PG8_SB
#undef PG8_STAGE2
#undef PG8_STAGEB
#undef PG8_LDA
#undef PG8_LDB
#undef PG8_MMA
#undef PG8_RD16
#undef PG8_WAIT_V
#undef PG8_WAIT_L
#undef PG8_BAR
#undef PG8_SCHED
#undef PG8_LOADVA
#undef PG8_KOFF
#undef PG8_ACC_INIT
}
}

typedef f32x4 AccT[2][2][4][2];

DI void store8_bf16(bf16_t* p, const float* v) {
    u32x4 w; w.x = cvt_pk_bf16(v[0], v[1]); w.y = cvt_pk_bf16(v[2], v[3]); w.z = cvt_pk_bf16(v[4], v[5]); w.w = cvt_pk_bf16(v[6], v[7]);
    *(u32x4*)p = w;
}
DI float dpp_shr_f(float x, int ctrl_sel);

struct EpiProj {
    bf16_t* proj; float* bcum; const int* pos; const float* bgk;
    DI void bias(const pg8::Unit& u, int wc, int fq, f32x4 (&bia)[2][2]) const {
        bia[0][0] = bia[0][1] = bia[1][0] = bia[1][1] = (f32x4){0.f, 0.f, 0.f, 0.f};
        if (u.pn == 14) { const float* b = bgk + wc * 32 + 8 * fq; bia[0][0] = *(const f32x4*)b; bia[0][1] = *(const f32x4*)(b + 4); bia[1][0] = *(const f32x4*)(b + 128); bia[1][1] = *(const f32x4*)(b + 132); }
    }
    DI void pre_load(const pg8::Unit& u, int tid, u32x2& pre) const { if (u.pn >= 6 && u.pn <= 9 && tid < 256) pre.x = (unsigned)pos[u.arow0 + tid]; }
    DI void pre_store(const u32x2& pre, int tid, LAS unsigned char* buf) const { if (tid < 256) *(LAS unsigned*)(buf + tid * 4) = pre.x; }
    DI void operator()(const AccT& acc, const pg8::Unit& u, const LAS unsigned char* ebuf, int wr, int wc, int fr, int fq) const {
        const int pn = u.pn, cl = wc * 32 + 8 * fq, row0 = u.arow0 + wr * 64 + fr;
        if (pn == 14) {
            const int lane = threadIdx.x & 63;
#pragma unroll
            for (int ai = 0; ai < 2; ++ai)
#pragma unroll
                for (int bj = 0; bj < 2; ++bj) {
                    float v[4][8];
#pragma unroll
                    for (int q = 0; q < 8; ++q) {
                        float carry = 0.f;
#pragma unroll
                        for (int m = 0; m < 4; ++m) {
                            float x = logsigmoidf_(acc[ai][bj][m][q >> 2][q & 3]) * 0.0625f;
                            x += __builtin_bit_cast(float, __builtin_amdgcn_update_dpp(0, __builtin_bit_cast(int, x), 0x111, 0xf, 0xf, true));
                            x += __builtin_bit_cast(float, __builtin_amdgcn_update_dpp(0, __builtin_bit_cast(int, x), 0x112, 0xf, 0xf, true));
                            x += __builtin_bit_cast(float, __builtin_amdgcn_update_dpp(0, __builtin_bit_cast(int, x), 0x114, 0xf, 0xf, true));
                            x += __builtin_bit_cast(float, __builtin_amdgcn_update_dpp(0, __builtin_bit_cast(int, x), 0x118, 0xf, 0xf, true));
                            x += carry;
                            v[m][q] = x;
                            carry = __shfl(x, lane | 15);
                        }
                    }
#pragma unroll
                    for (int m = 0; m < 4; ++m) {
                        const int row = row0 + ai * 128 + m * 16;
                        float* p = bcum + (size_t)row * 256 + bj * 128 + cl;
                        *(f32x4*)p = (f32x4){v[m][0], v[m][1], v[m][2], v[m][3]};
                        *(f32x4*)(p + 4) = (f32x4){v[m][4], v[m][5], v[m][6], v[m][7]};
                    }
                    asm volatile("" ::: "memory");
                }
        } else if (pn >= 6 && pn <= 9) {
            float inv[8];
#pragma unroll
            for (int q = 0; q < 8; ++q) inv[q] = exp2f(-(float)((cl + q) & 63) * 0.20762050593046014f);
            const int hh = cl >> 6;
            const float sc = (pn >= 8) ? 0.08838834764831845f : 1.0f;
            int pv[8];
#pragma unroll
            for (int i = 0; i < 8; ++i) pv[i] = *(const LAS int*)(ebuf + (wr * 64 + fr + (i >> 2) * 128 + (i & 3) * 16) * 4);
#pragma unroll
            for (int ai = 0; ai < 2; ++ai)
#pragma unroll
                for (int m = 0; m < 4; ++m) {
                    const int row = row0 + ai * 128 + m * 16;
                    const float p = (float)pv[ai * 4 + m];
                    float o1[8], o2[8];
#pragma unroll
                    for (int q = 0; q < 8; ++q) {
                        const float ang = p * inv[q];
                        const float t = rintf(ang * 0.15915493667125702f);
                        const float f = fmaf(ang, 0.15915493667125702f, -t) + ang * 6.4206382432985265e-09f;
                        const float sn = __builtin_amdgcn_sinf(f), cs = __builtin_amdgcn_cosf(f);
                        const float x1 = acc[ai][0][m][q >> 2][q & 3], x2 = acc[ai][1][m][q >> 2][q & 3];
                        o1[q] = (x1 * cs - x2 * sn) * sc; o2[q] = (x1 * sn + x2 * cs) * sc;
                    }
                    bf16_t* dst = proj + (size_t)row * NPROJ + pn * 256 + hh * 128 + (cl & 63);
                    store8_bf16(dst, o1); store8_bf16(dst + 64, o2);
                }
        } else {
            const bool silu = (pn == 4 || pn == 5 || pn == 12 || pn == 13);
#pragma unroll
            for (int ai = 0; ai < 2; ++ai)
#pragma unroll
                for (int m = 0; m < 4; ++m) {
                    const int row = row0 + ai * 128 + m * 16;
#pragma unroll
                    for (int bj = 0; bj < 2; ++bj) {
                        f32x4 v0 = acc[ai][bj][m][0], v1 = acc[ai][bj][m][1];
                        if (silu) {
                            const f32x4 t0 = v0 * (-1.4426950408889634f), t1 = v1 * (-1.4426950408889634f);
                            f32x4 d0, d1;
#pragma unroll
                            for (int i = 0; i < 4; ++i) { d0[i] = __builtin_amdgcn_exp2f(t0[i]); d1[i] = __builtin_amdgcn_exp2f(t1[i]); }
                            d0 = d0 + 1.0f; d1 = d1 + 1.0f;
#pragma unroll
                            for (int i = 0; i < 4; ++i) { d0[i] = __builtin_amdgcn_rcpf(d0[i]); d1[i] = __builtin_amdgcn_rcpf(d1[i]); }
                            v0 = v0 * d0; v1 = v1 * d1;
                        } else if (pn == 0) { v0 = v0 * 0.125f; v1 = v1 * 0.125f; }
                        u32x4 w; w.x = cvt_pk_bf16(v0[0], v0[1]); w.y = cvt_pk_bf16(v0[2], v0[3]); w.z = cvt_pk_bf16(v1[0], v1[1]); w.w = cvt_pk_bf16(v1[2], v1[3]);
                        *(u32x4*)(proj + (size_t)row * NPROJ + pn * 256 + bj * 128 + cl) = w;
                    }
                }
        }
    }
};

struct EpiRes1 {
    const float* x; const float* mod; float* x1;
    DI void bias(const pg8::Unit&, int, int, f32x4 (&bia)[2][2]) const { bia[0][0] = bia[0][1] = bia[1][0] = bia[1][1] = (f32x4){0.f, 0.f, 0.f, 0.f}; }
    DI void pre_load(const pg8::Unit&, int, u32x2&) const {}
    DI void pre_store(const u32x2&, int, LAS unsigned char*) const {}
    DI void operator()(const AccT& acc, const pg8::Unit& u, const LAS unsigned char* ebuf, int wr, int wc, int fr, int fq) const {
        const int cl = wc * 64 + 16 * fq, row0 = u.arow0 + wr * 64 + fr;
        const int b = u.arow0 >= SEQ ? 1 : 0;
        const float* g = mod + b * 6144 + 2048 + u.pn * 256 + cl;
        f32x4 gv[2][2];
#pragma unroll
        for (int bj = 0; bj < 2; ++bj) { gv[bj][0] = *(const f32x4*)(g + 8 * bj); gv[bj][1] = *(const f32x4*)(g + 8 * bj + 4); }
        f32x4 xa[4], xb[4];
        const size_t off0 = (size_t)row0 * D + u.pn * 256 + cl;
#define RES_LOAD(X_, i_) do { const size_t o_ = off0 + (size_t)(((i_) >> 2) * 128 + ((i_) & 3) * 16) * D; \
        X_[0] = *(const f32x4*)(x + o_); X_[1] = *(const f32x4*)(x + o_ + 4); X_[2] = *(const f32x4*)(x + o_ + 8); X_[3] = *(const f32x4*)(x + o_ + 12); } while (0)
#if X1_BF16
#define RES_STORE(X_, i_) do { const size_t o_ = off0 + (size_t)(((i_) >> 2) * 128 + ((i_) & 3) * 16) * D; \
        const f32x4 r0_ = X_[0] + gv[0][0] * acc[(i_) >> 2][0][(i_) & 3][0], r1_ = X_[1] + gv[0][1] * acc[(i_) >> 2][0][(i_) & 3][1]; \
        const f32x4 r2_ = X_[2] + gv[1][0] * acc[(i_) >> 2][1][(i_) & 3][0], r3_ = X_[3] + gv[1][1] * acc[(i_) >> 2][1][(i_) & 3][1]; \
        u32x4 w0_, w1_; w0_.x = cvt_pk_bf16(r0_[0], r0_[1]); w0_.y = cvt_pk_bf16(r0_[2], r0_[3]); w0_.z = cvt_pk_bf16(r1_[0], r1_[1]); w0_.w = cvt_pk_bf16(r1_[2], r1_[3]); \
        w1_.x = cvt_pk_bf16(r2_[0], r2_[1]); w1_.y = cvt_pk_bf16(r2_[2], r2_[3]); w1_.z = cvt_pk_bf16(r3_[0], r3_[1]); w1_.w = cvt_pk_bf16(r3_[2], r3_[3]); \
        bf16_t* xp_ = (bf16_t*)x1 + o_; *(u32x4*)xp_ = w0_; *(u32x4*)(xp_ + 8) = w1_; } while (0)
#else
#define RES_STORE(X_, i_) do { const size_t o_ = off0 + (size_t)(((i_) >> 2) * 128 + ((i_) & 3) * 16) * D; \
        *(f32x4*)(x1 + o_) = X_[0] + gv[0][0] * acc[(i_) >> 2][0][(i_) & 3][0]; *(f32x4*)(x1 + o_ + 4) = X_[1] + gv[0][1] * acc[(i_) >> 2][0][(i_) & 3][1]; \
        *(f32x4*)(x1 + o_ + 8) = X_[2] + gv[1][0] * acc[(i_) >> 2][1][(i_) & 3][0]; *(f32x4*)(x1 + o_ + 12) = X_[3] + gv[1][1] * acc[(i_) >> 2][1][(i_) & 3][1]; } while (0)
#endif
        RES_LOAD(xa, 0);
        RES_LOAD(xb, 1); RES_STORE(xa, 0);
        RES_LOAD(xa, 2); RES_STORE(xb, 1);
        RES_LOAD(xb, 3); RES_STORE(xa, 2);
        RES_LOAD(xa, 4); RES_STORE(xb, 3);
        RES_LOAD(xb, 5); RES_STORE(xa, 4);
        RES_LOAD(xa, 6); RES_STORE(xb, 5);
        RES_LOAD(xb, 7); RES_STORE(xa, 6);
        RES_STORE(xb, 7);
#undef RES_LOAD
#undef RES_STORE
    }
};

struct EpiGU {
    const float* bgu; bf16_t* act;
    DI void pre_load(const pg8::Unit&, int, u32x2&) const {}
    DI void pre_store(const u32x2&, int, LAS unsigned char*) const {}
    DI void bias(const pg8::Unit& u, int wc, int fq, f32x4 (&bia)[2][2]) const {
        const float* bg = bgu + (size_t)u.e * 2048 + u.pn * 128 + wc * 32 + 8 * fq;
        bia[0][0] = *(const f32x4*)bg; bia[0][1] = *(const f32x4*)(bg + 4); bia[1][0] = *(const f32x4*)(bg + 1024); bia[1][1] = *(const f32x4*)(bg + 1028);
    }
    DI void operator()(const AccT& acc, const pg8::Unit& u, const LAS unsigned char* ebuf, int wr, int wc, int fr, int fq) const {
        const int cl = wc * 32 + 8 * fq;
        constexpr float OS = MOE_FP8 ? A8_SCALE : 1.0f;
#pragma unroll
        for (int ai = 0; ai < 2; ++ai)
#pragma unroll
            for (int m = 0; m < 4; ++m) {
                const int r = ai * 128 + wr * 64 + m * 16 + fr;
                if (r < u.rows) {
                    f32x2 o[4];
#pragma unroll
                    for (int q = 0; q < 4; ++q) {
                        const f32x4 ag = acc[ai][0][m][q >> 1], au = acc[ai][1][m][q >> 1];
                        f32x2 gt = (q & 1) ? (f32x2){ag[2], ag[3]} : (f32x2){ag[0], ag[1]};
                        f32x2 up = (q & 1) ? (f32x2){au[2], au[3]} : (f32x2){au[0], au[1]};
                        gt.x = fminf(gt.x, 7.0f); gt.y = fminf(gt.y, 7.0f);
                        up.x = __builtin_amdgcn_fmed3f(up.x, -7.0f, 7.0f); up.y = __builtin_amdgcn_fmed3f(up.y, -7.0f, 7.0f);
                        const f32x2 t = gt * (-2.4554669595930157f);
                        f32x2 d; d.x = __builtin_amdgcn_exp2f(t.x); d.y = __builtin_amdgcn_exp2f(t.y);
                        d = d + 1.0f;
                        f32x2 rc; rc.x = __builtin_amdgcn_rcpf(d.x); rc.y = __builtin_amdgcn_rcpf(d.y);
                        o[q] = (up * OS + OS) * (gt * rc);
                    }
#if MOE_FP8
                    u32x2 w8; w8.x = pk4_fp8_nc(o[0].x, o[0].y, o[1].x, o[1].y); w8.y = pk4_fp8_nc(o[2].x, o[2].y, o[3].x, o[3].y);
                    *(u32x2*)((unsigned char*)act + (size_t)(u.arow0 + r) * D + u.pn * 128 + cl) = w8;
#else
                    const float ov[8] = {o[0].x, o[0].y, o[1].x, o[1].y, o[2].x, o[2].y, o[3].x, o[3].y};
                    store8_bf16(act + (size_t)(u.arow0 + r) * D + u.pn * 128 + cl, ov);
#endif
                }
            }
    }
};

struct EpiDown {
    const float* bd; const u32x2* perm; bf16_t* Y;
    DI void pre_load(const pg8::Unit& u, int tid, u32x2& pre) const { if (tid < 256) pre = perm[u.prow0 + (tid < u.rows ? tid : 0)]; }
    DI void pre_store(const u32x2& pre, int tid, LAS unsigned char* buf) const { if (tid < 256) *(LAS u32x2*)(buf + tid * 8) = pre; }
    DI void bias(const pg8::Unit& u, int wc, int fq, f32x4 (&bia)[2][2]) const {
        const float* b = bd + (size_t)u.e * D + u.pn * 256 + wc * 64 + 16 * fq;
        bia[0][0] = *(const f32x4*)b; bia[0][1] = *(const f32x4*)(b + 4); bia[1][0] = *(const f32x4*)(b + 8); bia[1][1] = *(const f32x4*)(b + 12);
    }
    DI void operator()(const AccT& acc, const pg8::Unit& u, const LAS unsigned char* ebuf, int wr, int wc, int fr, int fq) const {
        asm volatile("" : "+v"(fr), "+v"(fq));
        const int cl = wc * 64 + 16 * fq;
#pragma unroll
        for (int ai = 0; ai < 2; ++ai) {
            u32x2 rec[4];
#pragma unroll
            for (int m = 0; m < 4; ++m) { const int r = ai * 128 + wr * 64 + m * 16 + fr; rec[m] = *(const LAS u32x2*)(ebuf + r * 8); }
#pragma unroll
            for (int m = 0; m < 4; ++m) {
                const int r = ai * 128 + wr * 64 + m * 16 + fr;
                if (r < u.rows) {
                    const unsigned wbits = rec[m].y; const float wgt = __uint_as_float(wbits);
#if Y_FP8
                    const float wg8 = wgt * Y8_SCALE;
                    const f32x4 v00 = acc[ai][0][m][0] * wg8, v01 = acc[ai][0][m][1] * wg8, v10 = acc[ai][1][m][0] * wg8, v11 = acc[ai][1][m][1] * wg8;
                    u32x4 w; w.x = pk4_fp8(v00[0], v00[1], v00[2], v00[3]); w.y = pk4_fp8(v01[0], v01[1], v01[2], v01[3]); w.z = pk4_fp8(v10[0], v10[1], v10[2], v10[3]); w.w = pk4_fp8(v11[0], v11[1], v11[2], v11[3]);
                    *(u32x4*)((unsigned char*)Y + (size_t)rec[m].x * D + u.pn * 256 + cl) = w;
#else
                    const f32x4 v00 = acc[ai][0][m][0] * wgt, v01 = acc[ai][0][m][1] * wgt, v10 = acc[ai][1][m][0] * wgt, v11 = acc[ai][1][m][1] * wgt;
                    u32x4 w0, w1; w0.x = cvt_pk_bf16(v00[0], v00[1]); w0.y = cvt_pk_bf16(v00[2], v00[3]); w0.z = cvt_pk_bf16(v01[0], v01[1]); w0.w = cvt_pk_bf16(v01[2], v01[3]);
                    w1.x = cvt_pk_bf16(v10[0], v10[1]); w1.y = cvt_pk_bf16(v10[2], v10[3]); w1.z = cvt_pk_bf16(v11[0], v11[1]); w1.w = cvt_pk_bf16(v11[2], v11[3]);
                    bf16_t* yp = Y + (size_t)rec[m].x * D + u.pn * 256 + cl; *(u32x4*)yp = w0; *(u32x4*)(yp + 8) = w1;
#endif
                }
            }
            asm volatile("" ::: "memory");
        }
    }
};

#define XB_TMO      128
#define XB_XCNT(j)  (256  + 64 * (j))
#define XB_XSUB(j)  (1280 + 64 * (j))
#define XB_XGEN(j)  (2304 + 64 * (j))
#define XB_TOP      3328
#define XB_TOPGEN   3392
#define XCD_BAR_WORDS 3456
#define XB_SPIN_CAP (1u << 22)
DI unsigned xb_ld(unsigned* p)              { return __hip_atomic_load(p, __ATOMIC_RELAXED, __HIP_MEMORY_SCOPE_AGENT); }
DI unsigned xb_add(unsigned* p, unsigned v) { return __hip_atomic_fetch_add(p, v, __ATOMIC_RELAXED, __HIP_MEMORY_SCOPE_AGENT); }
DI unsigned xb_xcc_id() { return (unsigned)__builtin_amdgcn_s_getreg((3 << 11) | 20) & 0xFu; }
#define XB_SPIN(cond, bar) do { unsigned _sp = 0; while (cond) { __builtin_amdgcn_s_sleep(1); \
    if ((++_sp & 255u) == 0u) { if (xb_ld(&(bar)[XB_TMO])) break; if (_sp > XB_SPIN_CAP) { atomicAdd(&(bar)[XB_TMO], 1u); break; } } } } while (0)
struct XcdBarrier { unsigned* bar; unsigned x; volatile LAS unsigned* st; };
DI XcdBarrier xcd_barrier_post(unsigned* bar, volatile LAS unsigned* st) {
    XcdBarrier b; b.bar = bar; b.x = xb_xcc_id(); b.st = st;
    if (threadIdx.x == 0) (void)xb_add(&bar[XB_XCNT(b.x)], 1u);
    return b;
}
DI void xcd_barrier_complete(unsigned* bar, unsigned x, unsigned& nloc, unsigned& nx) {
    const unsigned G = gridDim.x * gridDim.y * gridDim.z;
    unsigned sum, cnt, mine, sp = 0u;
    for (;;) {
        sum = 0u; cnt = 0u; mine = 0u;
#pragma unroll
        for (unsigned j = 0; j < 16; ++j) { const unsigned c = xb_ld(&bar[XB_XCNT(j)]); sum += c; cnt += (c > 0u) ? 1u : 0u; mine = (j == x) ? c : mine; }
        if (sum == G) break;
        __builtin_amdgcn_s_sleep(1);
        if ((++sp & 255u) == 0u) { if (xb_ld(&bar[XB_TMO])) break; if (sp > XB_SPIN_CAP) { atomicAdd(&bar[XB_TMO], 1u); break; } }
    }
    nloc = mine > 0u ? mine : 1u; nx = cnt > 0u ? cnt : 1u;
}
DI void xcd_barrier(const XcdBarrier& b) {
    asm volatile("s_waitcnt vmcnt(0)" ::: "memory");
    __syncthreads();
    if (threadIdx.x == 0) {
        unsigned* bar = b.bar;
        __builtin_amdgcn_s_waitcnt(0);
        unsigned nloc = b.st[0], nx = b.st[1];
        if (nloc == 0u) { xcd_barrier_complete(bar, b.x, nloc, nx); b.st[0] = nloc; b.st[1] = nx; }
        const unsigned old = xb_add(&bar[XB_XSUB(b.x)], 1u);
        const unsigned gen = old / nloc;
        if (old + 1u == (gen + 1u) * nloc) {
            __builtin_amdgcn_fence(__ATOMIC_RELEASE, "agent");
            asm volatile("s_waitcnt vmcnt(0)" ::: "memory");
            const unsigned og = xb_add(&bar[XB_TOP], 1u);
            const unsigned tg = og / nx;
            if (og + 1u == (tg + 1u) * nx) xb_add(&bar[XB_TOPGEN], 1u);
            else XB_SPIN(xb_ld(&bar[XB_TOPGEN]) == tg, bar);
            __builtin_amdgcn_fence(__ATOMIC_ACQUIRE, "agent");
            xb_add(&bar[XB_XGEN(b.x)], 1u);
            asm volatile("s_waitcnt vmcnt(0)" ::: "memory");
        } else {
            XB_SPIN(xb_ld(&bar[XB_XGEN(b.x)]) == gen, bar);
            __builtin_amdgcn_fence(__ATOMIC_ACQUIRE, "agent");
            asm volatile("s_waitcnt vmcnt(0)" ::: "memory");
        }
    }
    __syncthreads();
}

struct Args { const void* in[20]; float* out; unsigned char* ws; int ph_lo, ph_hi; };

struct Frame {
    LAS unsigned char* lds;
    int tid, lane, wave, G, bid;
    const float *x, *c, *w_ada, *b_ada, *norm1, *w_in, *w_gk2, *b_gk, *gla_onorm, *ret_onorm, *w_out, *norm2, *w_router, *b_router, *w_gu, *b_gu, *w_down, *b_down, *norm_f;
    const int* positions;
    float* out; unsigned char* ws;
    unsigned* ctl; float* mod; bf16_t *win_t, *wout_t, *wgu_t, *wd_t, *hbuf, *obuf, *proj, *act, *Y; float *x1, *bcum, *pw; u32x2* perm;
};

DI void tr_item(const float* W, int ldw, int k0, int src_c0, bf16_t* dst, LAS float* scr, int lane) {
    { float t[32]; const float* wp = W + (size_t)(k0 + (lane >> 5)) * ldw + src_c0 + (lane & 31);
#pragma unroll
      for (int i = 0; i < 32; ++i) t[i] = wp[(size_t)(2 * i) * ldw];
#pragma unroll
      for (int i = 0; i < 32; ++i) scr[(2 * i + (lane >> 5)) * 33 + (lane & 31)] = t[i]; }
    LDS_WAIT(); asm volatile("" ::: "memory");
    const int c = lane & 7;
#pragma unroll
    for (int j = 0; j < 4; ++j) { const int n = (lane >> 3) + 8 * j; const LAS float* s = scr + (8 * c) * 33 + n;
        u32x4 o; o.x = pk2(s[0 * 33], s[1 * 33]); o.y = pk2(s[2 * 33], s[3 * 33]); o.z = pk2(s[4 * 33], s[5 * 33]); o.w = pk2(s[6 * 33], s[7 * 33]);
        *(u32x4*)(dst + (size_t)n * D + k0 + 8 * c) = o; }
    LDS_WAIT(); asm volatile("" ::: "memory");
}

DI void tr_item8(const float* W, int ldw, int k0, int src_c0, unsigned char* dst, LAS float* scr, int lane) {
    { float t[32]; const float* wp = W + (size_t)(k0 + (lane >> 5)) * ldw + src_c0 + (lane & 31);
#pragma unroll
      for (int i = 0; i < 32; ++i) t[i] = wp[(size_t)(2 * i) * ldw];
#pragma unroll
      for (int i = 0; i < 32; ++i) scr[(2 * i + (lane >> 5)) * 33 + (lane & 31)] = t[i]; }
    LDS_WAIT(); asm volatile("" ::: "memory");
    const int c = lane & 3;
#pragma unroll
    for (int j = 0; j < 2; ++j) { const int n = (lane >> 2) + 16 * j; const LAS float* s = scr + (16 * c) * 33 + n;
        u32x4 o;
        o.x = pk4_fp8(s[0 * 33] * W8_SCALE, s[1 * 33] * W8_SCALE, s[2 * 33] * W8_SCALE, s[3 * 33] * W8_SCALE);
        o.y = pk4_fp8(s[4 * 33] * W8_SCALE, s[5 * 33] * W8_SCALE, s[6 * 33] * W8_SCALE, s[7 * 33] * W8_SCALE);
        o.z = pk4_fp8(s[8 * 33] * W8_SCALE, s[9 * 33] * W8_SCALE, s[10 * 33] * W8_SCALE, s[11 * 33] * W8_SCALE);
        o.w = pk4_fp8(s[12 * 33] * W8_SCALE, s[13 * 33] * W8_SCALE, s[14 * 33] * W8_SCALE, s[15 * 33] * W8_SCALE);
        *(u32x4*)(dst + (size_t)n * D + k0 + 16 * c) = o; }
    LDS_WAIT(); asm volatile("" ::: "memory");
}

struct TrDesc { const float* W; int ldw, k0, src; unsigned char* dst; int fp8; };
constexpr int TR_I_IN = 112 * 16, TR_I_OUT = 32 * 16, TR_I_GU = 64 * 16, TR_I_D = 32 * 16, TR_NITEMS = TR_I_IN + TR_I_OUT + NE * TR_I_GU + NE * TR_I_D;
DI bool tr_decode(Frame& F, int it, TrDesc& d) {
    if (it >= TR_NITEMS) return false;
    int r = it;
    if (r < TR_I_IN) {
        const int kb = r / 112, nb = r % 112, n0 = nb * 32, pn = n0 >> 8, cl0 = n0 & 255;
        int src;
        if (pn < 6) src = n0;
        else if (pn <= 9) { const int bj = cl0 >> 7, o0 = cl0 & 127; src = pn * 256 + 16 + 128 * (o0 >> 6) + 64 * bj + (o0 & 63); }
        else src = n0 + 16;
        d.W = F.w_in; d.ldw = MIX_IN; d.k0 = kb * 64; d.src = src; d.dst = (unsigned char*)(F.win_t + (size_t)n0 * D); d.fp8 = 0; return true;
    }
    r -= TR_I_IN;
    if (r < TR_I_OUT) { const int kb = r / 32, nb = r % 32; d.W = F.w_out; d.ldw = D; d.k0 = kb * 64; d.src = nb * 32; d.dst = (unsigned char*)F.wout_t + (size_t)nb * 32 * D * (O_FP8 ? 1 : 2); d.fp8 = O_FP8; return true; }
    r -= TR_I_OUT;
    if (r < NE * TR_I_GU) {
        const int e = r / TR_I_GU, rr = r % TR_I_GU, kb = rr / 64, nb = rr % 64, n0 = nb * 32, pn = n0 >> 8, cl0 = n0 & 255, bj = cl0 >> 7, o0 = cl0 & 127;
        d.W = F.w_gu + (size_t)e * D * 2048; d.ldw = 2048; d.k0 = kb * 64; d.src = 1024 * bj + 128 * pn + o0; d.fp8 = MOE_FP8;
        d.dst = (unsigned char*)F.wgu_t + ((size_t)e * 2048 + n0) * D * (MOE_FP8 ? 1 : 2); return true;
    }
    r -= NE * TR_I_GU;
    { const int e = r / TR_I_D, rr = r % TR_I_D, kb = rr / 32, nb = rr % 32;
      d.W = F.w_down + (size_t)e * D * D; d.ldw = D; d.k0 = kb * 64; d.src = nb * 32; d.fp8 = MOE_FP8;
      d.dst = (unsigned char*)F.wd_t + ((size_t)e * D + nb * 32) * D * (MOE_FP8 ? 1 : 2); return true; }
}
DI void tr_load(float (&t)[32], const TrDesc& d, int lane) {
    const float* wp = d.W + (size_t)(d.k0 + (lane >> 5)) * d.ldw + d.src + (lane & 31);
#pragma unroll
    for (int i = 0; i < 32; ++i) t[i] = __builtin_nontemporal_load(wp + (size_t)(2 * i) * d.ldw);
}
DI void tr_finish(const float (&t)[32], const TrDesc& d, LAS float* scr, int lane) {
#pragma unroll
    for (int i = 0; i < 32; ++i) scr[(2 * i + (lane >> 5)) * 33 + (lane & 31)] = t[i];
    LDS_WAIT(); asm volatile("" ::: "memory");
    if (d.fp8) {
        const int c = lane & 3;
#pragma unroll
        for (int j = 0; j < 2; ++j) { const int n = (lane >> 2) + 16 * j; const LAS float* s = scr + (16 * c) * 33 + n;
            u32x4 o;
            o.x = pk4_fp8(s[0 * 33] * W8_SCALE, s[1 * 33] * W8_SCALE, s[2 * 33] * W8_SCALE, s[3 * 33] * W8_SCALE);
            o.y = pk4_fp8(s[4 * 33] * W8_SCALE, s[5 * 33] * W8_SCALE, s[6 * 33] * W8_SCALE, s[7 * 33] * W8_SCALE);
            o.z = pk4_fp8(s[8 * 33] * W8_SCALE, s[9 * 33] * W8_SCALE, s[10 * 33] * W8_SCALE, s[11 * 33] * W8_SCALE);
            o.w = pk4_fp8(s[12 * 33] * W8_SCALE, s[13 * 33] * W8_SCALE, s[14 * 33] * W8_SCALE, s[15 * 33] * W8_SCALE);
            *(u32x4*)(d.dst + (size_t)n * D + d.k0 + 16 * c) = o; }
    } else {
        const int c = lane & 7;
#pragma unroll
        for (int j = 0; j < 4; ++j) { const int n = (lane >> 3) + 8 * j; const LAS float* s = scr + (8 * c) * 33 + n;
            u32x4 o; o.x = pk2(s[0 * 33], s[1 * 33]); o.y = pk2(s[2 * 33], s[3 * 33]); o.z = pk2(s[4 * 33], s[5 * 33]); o.w = pk2(s[6 * 33], s[7 * 33]);
            *(u32x4*)((bf16_t*)d.dst + (size_t)n * D + d.k0 + 8 * c) = o; }
    }
    LDS_WAIT(); asm volatile("" ::: "memory");
}

constexpr int TR_SPLIT1 = TR_NITEMS - 9216 - 7168, TR_SPLIT2 = TR_NITEMS - 7168;
DI void tr_range(Frame& F, LAS float* scr, int first, int last, int widx, int nw) {
    int it = first + widx; TrDesc d0, d1; float t0[32], t1[32];
    bool v0 = it < last && tr_decode(F, it, d0);
    if (v0) tr_load(t0, d0, F.lane);
    while (v0) {
        const bool v1 = (it + nw) < last && tr_decode(F, it + nw, d1);
        if (v1) tr_load(t1, d1, F.lane);
        tr_finish(t0, d0, scr, F.lane);
        if (!v1) break;
        it += 2 * nw; v0 = it < last && tr_decode(F, it, d0);
        if (v0) tr_load(t0, d0, F.lane);
        tr_finish(t1, d1, scr, F.lane);
    }
}

DI void p0_prep(Frame& F) {
    { int t_ = threadIdx.x; asm volatile("" : "+v"(t_)); F.tid = t_; F.lane = t_ & 63; }
    LAS float* red = (LAS float*)F.lds;
    LAS float* sc_ = (LAS float*)(F.lds + 4096);
    for (int i = F.tid; i < 2 * D; i += NTHREADS) { const float cv = F.c[i]; sc_[i] = cv * sigmoidf_(cv); }
    __syncthreads();
    for (int it = F.bid * NTHREADS + F.tid; it < 256 * 128; it += F.G * NTHREADS) {
        const int c = it & 255, k8 = it >> 8;
        float w2[16];
#pragma unroll
        for (int j = 0; j < 16; ++j) w2[j] = F.w_gk2[j * 256 + c];
        float o[8];
#pragma unroll
        for (int kk = 0; kk < 8; ++kk) {
            const float* wi = F.w_in + (size_t)(k8 * 8 + kk) * MIX_IN + 1536; float s = 0.f;
#pragma unroll
            for (int j = 0; j < 16; ++j) s += wi[j] * w2[j];
            o[kk] = s;
        }
        u32x4 w; w.x = pk2(o[0], o[1]); w.y = pk2(o[2], o[3]); w.z = pk2(o[4], o[5]); w.w = pk2(o[6], o[7]);
        *(u32x4*)(F.win_t + (size_t)(3584 + c) * D + k8 * 8) = w;
    }
    LAS float* scr = (LAS float*)(F.lds + 16384 + F.wave * 8704);
    const int tr_last = F.G == 256 ? TR_SPLIT1 : TR_NITEMS, tr_nw = F.G * NWAVES;
    int it = F.bid * NWAVES + F.wave; TrDesc d0, d1; float t0[32], t1[32];
    bool v0 = it < tr_last && tr_decode(F, it, d0);
    if (v0) tr_load(t0, d0, F.lane);
    for (int cb = F.bid; cb < 256; cb += F.G) {
        const bool act = F.tid < 504;
        const int col = F.tid % 24, ks = F.tid / 24; float a0 = 0.f, a1 = 0.f;
        const float* wp = F.w_ada + (size_t)ks * 6144 + cb * 24 + col;
#define P0_ISSUE(k0_) _Pragma("unroll") for (int j = 0; j < 7; ++j) { const int k = ks + 21 * ((k0_) + j); w[j] = (act && k < D) ? wp[(size_t)(21 * ((k0_) + j)) * 6144] : 0.f; }
#define P0_USE(k0_) _Pragma("unroll") for (int j = 0; j < 7; ++j) { const int k = ks + 21 * ((k0_) + j); if (act && k < D) { a0 += sc_[k] * w[j]; a1 += sc_[D + k] * w[j]; } }
#pragma unroll 1
        for (int k0 = 0; k0 < 56; k0 += 14) {
            float w[7];
            P0_ISSUE(k0);
            bool v1 = false;
            if (v0) { v1 = (it + tr_nw) < tr_last && tr_decode(F, it + tr_nw, d1); if (v1) tr_load(t1, d1, F.lane); tr_finish(t0, d0, scr, F.lane); }
            P0_USE(k0);
            P0_ISSUE(k0 + 7);
            v0 = false;
            if (v1) { it += 2 * tr_nw; v0 = it < tr_last && tr_decode(F, it, d0); if (v0) tr_load(t0, d0, F.lane); tr_finish(t1, d1, scr, F.lane); }
            P0_USE(k0 + 7);
        }
#undef P0_ISSUE
#undef P0_USE
        if (act) { red[ks * 24 + col] = a0; red[(21 + ks) * 24 + col] = a1; }
        __syncthreads();
        if (F.tid < 48) {
            const int b = F.tid / 24, c2 = F.tid % 24; float s = F.b_ada[cb * 24 + c2];
            for (int q = 0; q < 21; ++q) s += red[(b * 21 + q) * 24 + c2];
            F.mod[b * 6144 + cb * 24 + c2] = s;
        }
        __syncthreads();
    }
    while (v0) {
        const bool v1 = (it + tr_nw) < tr_last && tr_decode(F, it + tr_nw, d1);
        if (v1) tr_load(t1, d1, F.lane);
        tr_finish(t0, d0, scr, F.lane);
        if (!v1) break;
        it += 2 * tr_nw; v0 = it < tr_last && tr_decode(F, it, d0);
        if (v0) tr_load(t0, d0, F.lane);
        tr_finish(t1, d1, scr, F.lane);
    }
}

DI void p1_h1(Frame& F) {
    { int t_ = threadIdx.x; asm volatile("" : "+v"(t_)); F.tid = t_; F.lane = t_ & 63; }
    const int gw = F.bid * NWAVES + F.wave, NGW = F.G * NWAVES;
    f32x4 v[4], vn[4];
    if (gw < M) { const f32x4* xr = (const f32x4*)(F.x + (size_t)gw * D) + F.lane;
#pragma unroll
        for (int j = 0; j < 4; ++j) v[j] = xr[64 * j]; }
    for (int m = gw; m < M; m += NGW) {
        const int b = m >= SEQ;
        if (m + NGW < M) { const f32x4* xn = (const f32x4*)(F.x + (size_t)(m + NGW) * D) + F.lane;
#pragma unroll
            for (int j = 0; j < 4; ++j) vn[j] = xn[64 * j]; }
        const f32x4* nr = (const f32x4*)F.norm1 + F.lane;
        const f32x4* shr = (const f32x4*)(F.mod + b * 6144) + F.lane;
        const f32x4* scr = (const f32x4*)(F.mod + b * 6144 + 1024) + F.lane;
        float s = 0.f;
#pragma unroll
        for (int j = 0; j < 4; ++j) s += (v[j].x * v[j].x + v[j].y * v[j].y) + (v[j].z * v[j].z + v[j].w * v[j].w);
        const float rstd = __builtin_amdgcn_rsqf(wave_sum(s) * (1.0f / D) + EPS);
        u32x2* o8 = (u32x2*)(F.hbuf + (size_t)m * D) + F.lane;
#pragma unroll
        for (int j = 0; j < 4; ++j) {
            const f32x4 w = nr[64 * j], sc = scr[64 * j], sh = shr[64 * j];
            const f32x4 h = v[j] * rstd * w * (sc + 1.0f) + sh;
            u32x2 p; p.x = pk2(h.x, h.y); p.y = pk2(h.z, h.w); o8[64 * j] = p;
        }
#pragma unroll
        for (int j = 0; j < 4; ++j) v[j] = vn[j];
    }
}

template <int DK, bool GLA>
DI void la_naive_stream(Frame& F, int b, int h) {
    LAS float* qs = (LAS float*)F.lds;
    LAS float* ks = qs + 64 * DK;
    LAS float* as = ks + 64 * DK;
    LAS float* vs = (LAS float*)(F.lds + 3 * 64 * 128 * 4);
    const int qcol = GLA ? h * 64 : 1536 + h * 128, kcol = GLA ? 256 + h * 64 : 2048 + h * 128, vcol = GLA ? 512 + h * 128 : 2560 + h * 128, gcol = GLA ? 1024 + h * 128 : 3072 + h * 128;
    const float gamma = 1.0f - exp2f(-5.0f - (float)h);
    float S[DK];
#pragma unroll
    for (int d = 0; d < DK; ++d) S[d] = 0.f;
    for (int tile = 0; tile < SEQ / 64; ++tile) {
        const int row0 = b * SEQ + tile * 64;
        for (int i = F.tid; i < 64 * DK; i += NTHREADS) {
            const int t = i / DK, d = i % DK; const size_t r = (size_t)(row0 + t);
            qs[i] = bf2f(F.proj[r * NPROJ + qcol + d]); ks[i] = bf2f(F.proj[r * NPROJ + kcol + d]);
            if (GLA) { const float bc = F.bcum[r * 256 + h * 64 + d]; const float bp = t > 0 ? F.bcum[(r - 1) * 256 + h * 64 + d] : 0.f; as[i] = expf(bc - bp); }
        }
        for (int i = F.tid; i < 64 * 128; i += NTHREADS) { const int t = i >> 7, e = i & 127; vs[i] = bf2f(F.proj[(size_t)(row0 + t) * NPROJ + vcol + e]); }
        __syncthreads();
        if (F.tid < 128) {
            const int e = F.tid;
            for (int t = 0; t < 64; ++t) {
                const float v = vs[t * 128 + e]; float o = 0.f;
#pragma unroll
                for (int d = 0; d < DK; ++d) {
                    const float a = GLA ? as[t * DK + d] : gamma;
                    S[d] = a * S[d] + ks[t * DK + d] * v; o += qs[t * DK + d] * S[d];
                }
                vs[t * 128 + e] = o;
            }
        }
        __syncthreads();
        for (int tt = 0; tt < 8; ++tt) {
            const int t = F.wave * 8 + tt; const size_t r = (size_t)(row0 + t);
            const float o0 = vs[t * 128 + F.lane], o1 = vs[t * 128 + 64 + F.lane];
            float y0, y1;
            if (GLA) {
                const float rstd = 1.0f / sqrtf(wave_sum(o0 * o0 + o1 * o1) * (1.0f / 128.f) + EPS);
                y0 = o0 * rstd * F.gla_onorm[F.lane]; y1 = o1 * rstd * F.gla_onorm[64 + F.lane];
            } else {
                const float mu = wave_sum(o0 + o1) * (1.0f / 128.f); const float d0 = o0 - mu, d1 = o1 - mu;
                const float rstd = 1.0f / sqrtf(wave_sum(d0 * d0 + d1 * d1) * (1.0f / 128.f) + EPS);
                y0 = d0 * rstd * F.ret_onorm[F.lane]; y1 = d1 * rstd * F.ret_onorm[64 + F.lane];
            }
            y0 *= bf2f(F.proj[r * NPROJ + gcol + F.lane]); y1 *= bf2f(F.proj[r * NPROJ + gcol + 64 + F.lane]);
            const int oc = (GLA ? 0 : 512) + h * 128;
            F.obuf[r * D + oc + F.lane] = (bf16_t)f2bf(y0); F.obuf[r * D + oc + 64 + F.lane] = (bf16_t)f2bf(y1);
        }
        __syncthreads();
    }
}
DI void p3_la_naive(Frame& F) {
    { int t_ = threadIdx.x; asm volatile("" : "+v"(t_)); F.tid = t_; F.lane = t_ & 63; }
    for (int s = F.bid; s < 16; s += F.G) {
        const int type = s >> 3, b = (s >> 2) & 1, h = s & 3;
        if (type == 0) la_naive_stream<64, true>(F, b, h); else la_naive_stream<128, false>(F, b, h);
    }
}


typedef short s16x4 __attribute__((ext_vector_type(4)));
constexpr int LA_C = 128, LA_NC = SEQ / LA_C;
constexpr size_t U_RET_OFF = (size_t)8 * LA_NC * 128 * 64;
DI bf16x8 tr_pair(const LAS unsigned char* p0, const LAS unsigned char* p1) {
    const s16x4 lo = __builtin_amdgcn_ds_read_tr16_b64_v4i16((LAS s16x4*)p0);
    const s16x4 hi = __builtin_amdgcn_ds_read_tr16_b64_v4i16((LAS s16x4*)p1);
    return __builtin_shufflevector(lo, hi, 0, 1, 2, 3, 4, 5, 6, 7);
}
DI int slot_swap23(int t) { return (t & ~12) | ((t >> 1) & 4) | ((t << 1) & 8); }
DI float lg2_gamma(int h) { return log2f(1.0f - exp2f(-5.0f - (float)h)); }
DI bf16x8 scale8(u32x4 w, const float* f) {
    u32x4 o;
    o.x = cvt_pk_bf16(bflo(w.x) * f[0], bfhi(w.x) * f[1]); o.y = cvt_pk_bf16(bflo(w.y) * f[2], bfhi(w.y) * f[3]);
    o.z = cvt_pk_bf16(bflo(w.z) * f[4], bfhi(w.z) * f[5]); o.w = cvt_pk_bf16(bflo(w.w) * f[6], bfhi(w.w) * f[7]);
    return __builtin_bit_cast(bf16x8, o);
}
DI bf16x8 scale1(u32x4 w, float f) {
    u32x4 o;
    o.x = cvt_pk_bf16(bflo(w.x) * f, bfhi(w.x) * f); o.y = cvt_pk_bf16(bflo(w.y) * f, bfhi(w.y) * f);
    o.z = cvt_pk_bf16(bflo(w.z) * f, bfhi(w.z) * f); o.w = cvt_pk_bf16(bflo(w.w) * f, bfhi(w.w) * f);
    return __builtin_bit_cast(bf16x8, o);
}

template <int DK, int EB, bool GLA>
DI void la_pass1_unit(Frame& F, LAS unsigned char* wl, int b, int h, int n, int eh, bf16_t* Ubase) {
    int lane = F.lane; asm volatile("" : "+v"(lane), "+s"(n));
    const int g = lane >> 4, i16 = lane & 15, q = i16 >> 2, p = i16 & 3;
    constexpr int NDB = DK / 16, VCOLS = 16 * EB, VC = VCOLS / 8, KC = DK / 8, VI = 32 * VC / 64, KI = 32 * KC / 64;
    LAS unsigned char* vt = wl; LAS unsigned char* kt = wl + EB * 1024;
    const int r0 = b * SEQ + n * LA_C;
    const int kcol = GLA ? 256 + h * 64 : 2048 + h * 128, vcol = (GLA ? 512 : 2560) + h * 128 + eh * VCOLS, hd = h * 64;
    f32x4 acc[EB][NDB];
#pragma unroll
    for (int e = 0; e < EB; ++e)
#pragma unroll
        for (int d = 0; d < NDB; ++d) acc[e][d] = (f32x4){0.f, 0.f, 0.f, 0.f};
    const int kc = lane % KC, ktok = lane / KC, vch = lane % VC, vtok = lane / VC;
    float bl[8], b63[8]; const float lg2 = lg2_gamma(h);
    if (GLA) {
        const f32x4 a0 = *(const f32x4*)(F.bcum + (size_t)(r0 + 127) * 256 + hd + 8 * kc), a1 = *(const f32x4*)(F.bcum + (size_t)(r0 + 127) * 256 + hd + 8 * kc + 4);
        const f32x4 c0 = *(const f32x4*)(F.bcum + (size_t)(r0 + 63) * 256 + hd + 8 * kc), c1 = *(const f32x4*)(F.bcum + (size_t)(r0 + 63) * 256 + hd + 8 * kc + 4);
#pragma unroll
        for (int j = 0; j < 4; ++j) { bl[j] = a0[j]; bl[4 + j] = a1[j]; b63[j] = c0[j]; b63[4 + j] = c1[j]; }
    }
    if (GLA && eh == 0 && lane < KC) {
        float* dp = (float*)(F.ws + WS_DEC) + ((size_t)((b * 4 + h) * LA_NC + n) * 64) + 8 * kc;
        *(f32x4*)dp = (f32x4){__expf(bl[0] + b63[0]), __expf(bl[1] + b63[1]), __expf(bl[2] + b63[2]), __expf(bl[3] + b63[3])};
        *(f32x4*)(dp + 4) = (f32x4){__expf(bl[4] + b63[4]), __expf(bl[5] + b63[5]), __expf(bl[6] + b63[6]), __expf(bl[7] + b63[7])};
    }
    const int rbase = (((g >> 1) * 16 + (g & 1) * 4 + q) * 32) + 8 * p;
    u32x4 vr[VI], kr[KI]; f32x4 kbv[KI][2];
#define LA1_LOAD(step_) do { const int rs_ = r0 + 32 * (step_); \
        _Pragma("unroll") for (int i = 0; i < VI; ++i) vr[i] = *(const u32x4*)(F.proj + (size_t)(rs_ + vtok + i * (64 / VC)) * NPROJ + vcol + 8 * vch); \
        _Pragma("unroll") for (int i = 0; i < KI; ++i) { const size_t row = (size_t)(rs_ + ktok + i * (64 / KC)); kr[i] = *(const u32x4*)(F.proj + row * NPROJ + kcol + 8 * kc); \
            if (GLA) { kbv[i][0] = *(const f32x4*)(F.bcum + row * 256 + hd + 8 * kc); kbv[i][1] = *(const f32x4*)(F.bcum + row * 256 + hd + 8 * kc + 4); } } } while (0)
    LA1_LOAD(0);
#pragma unroll 1
    for (int step = 0; step < 4; ++step) {
#pragma unroll
        for (int i = 0; i < VI; ++i) { const int tau = vtok + i * (64 / VC); *(LAS u32x4*)(vt + (vch >> 1) * 1024 + slot_swap23(tau) * 32 + (vch & 1) * 16) = vr[i]; }
#pragma unroll
        for (int i = 0; i < KI; ++i) {
            const int tau = ktok + i * (64 / KC), t = 32 * step + tau;
            bf16x8 o;
            if (GLA) {
                float f[8];
#pragma unroll
                for (int j = 0; j < 8; ++j) f[j] = __expf(bl[j] - kbv[i][j >> 2][j & 3] + (t < 64 ? b63[j] : 0.f));
                o = scale8(kr[i], f);
            } else {
                o = scale1(kr[i], exp2f((float)(127 - t) * lg2));
            }
            *(LAS bf16x8*)(kt + (kc >> 1) * 1024 + slot_swap23(tau) * 32 + (kc & 1) * 16) = o;
        }
        if (step < 3) LA1_LOAD(step + 1);
        bf16x8 af[EB], bfr[NDB];
#pragma unroll
        for (int e = 0; e < EB; ++e) af[e] = tr_pair(vt + e * 1024 + rbase, vt + e * 1024 + rbase + 256);
#pragma unroll
        for (int d = 0; d < NDB; ++d) bfr[d] = tr_pair(kt + d * 1024 + rbase, kt + d * 1024 + rbase + 256);
#pragma unroll
        for (int e = 0; e < EB; ++e)
#pragma unroll
            for (int d = 0; d < NDB; ++d) acc[e][d] = __builtin_amdgcn_mfma_f32_16x16x32_bf16(bfr[d], af[e], acc[e][d], 0, 0, 0);
    }
#undef LA1_LOAD
    bf16_t* U = Ubase + (size_t)n * 128 * DK;
#pragma unroll
    for (int e = 0; e < EB; ++e)
#pragma unroll
        for (int d = 0; d < NDB; ++d)
            { u32x2 w; w.x = cvt_pk_bf16(acc[e][d][0], acc[e][d][1]); w.y = cvt_pk_bf16(acc[e][d][2], acc[e][d][3]);
              *(u32x2*)(U + (size_t)(eh * VCOLS + 16 * e + i16) * DK + 16 * d + 4 * g) = w; }
}

DI void p3_la_pass1(Frame& F) {
    { int t_ = threadIdx.x; asm volatile("" : "+v"(t_)); F.tid = t_; F.lane = t_ & 63; }
    LAS unsigned char* wl = F.lds + F.wave * 16384;
    const int gw = F.bid * NWAVES + F.wave, NGW = F.G * NWAVES;
    bf16_t* Ug = (bf16_t*)(F.ws + WS_U); bf16_t* Ur = Ug + U_RET_OFF;
    for (int u = gw; u < 2048 + 4096; u += NGW) {
        if (u < 2048) { const int eh = u & 1, n = (u >> 1) & 127, st = u >> 8; la_pass1_unit<64, 4, true>(F, wl, st >> 2, st & 3, n, eh, Ug + (size_t)st * LA_NC * 128 * 64); }
        else { const int v = u - 2048, eh = v & 3, n = (v >> 2) & 127, st = v >> 9; la_pass1_unit<128, 2, false>(F, wl, st >> 2, st & 3, n, eh, Ur + (size_t)st * LA_NC * 128 * 128); }
    }
}

DI void p4_la_scan(Frame& F) {
    { int t_ = threadIdx.x; asm volatile("" : "+v"(t_)); F.tid = t_; F.lane = t_ & 63; }
    const bf16_t* Ug = (const bf16_t*)(F.ws + WS_U); bf16_t* Sg = (bf16_t*)(F.ws + WS_SP);
    if (F.tid >= 384) { if (F.G == 256) tr_range(F, (LAS float*)(F.lds + 16384 + F.wave * 8704), TR_SPLIT2, TR_NITEMS, F.bid * 2 + (F.wave - 6), F.G * 2); return; }
    for (int it = F.bid * 384 + F.tid; it < 32768 + 65536; it += F.G * 384) {
        const bool gla = it < 32768;
        int st, e, d2, DK; size_t base;
        if (gla) { st = it >> 12; const int idx = it & 4095; e = idx >> 5; d2 = idx & 31; DK = 64; base = (size_t)st * LA_NC * 128 * 64; }
        else { const int v = it - 32768; st = v >> 13; const int idx = v & 8191; e = idx >> 6; d2 = idx & 63; DK = 128; base = U_RET_OFF + (size_t)st * LA_NC * 128 * 128; }
        const int b = st >> 2, h = st & 3;
        const size_t cstride = (size_t)128 * DK;
        const bf16_t* up = Ug + base + (size_t)e * DK + 2 * d2;
        bf16_t* sp = Sg + base + (size_t)e * DK + 2 * d2;
        const float* bc = (const float*)(F.ws + WS_DEC) + (size_t)(st & 7) * LA_NC * 64 + 2 * d2;
        const float dr = exp2f(128.0f * lg2_gamma(h));
        float s0 = 0.f, s1 = 0.f;
        unsigned uv[16], un[16]; f32x2 dv[16], dn[16];
#define LA4_LOAD(U_, D_, n0_) do { _Pragma("unroll") for (int j = 0; j < 16; ++j) { \
            U_[j] = *(const unsigned*)(up + (size_t)((n0_) + j) * cstride); \
            if (gla) D_[j] = *(const f32x2*)(bc + (size_t)((n0_) + j) * 64); } } while (0)
#define LA4_STEP(U_, D_, n0_) do { _Pragma("unroll") for (int j = 0; j < 16; ++j) { \
            *(unsigned*)(sp + (size_t)((n0_) + j) * cstride) = pk2(s0, s1); \
            const float d0 = gla ? D_[j].x : dr, d1 = gla ? D_[j].y : dr; \
            s0 = d0 * s0 + bflo(U_[j]); s1 = d1 * s1 + bfhi(U_[j]); } } while (0)
        LA4_LOAD(uv, dv, 0);
#pragma unroll 1
        for (int n0 = 0; n0 < LA_NC; n0 += 32) {
            LA4_LOAD(un, dn, n0 + 16);
            LA4_STEP(uv, dv, n0);
            if (n0 + 32 < LA_NC) LA4_LOAD(uv, dv, n0 + 32);
            LA4_STEP(un, dn, n0 + 16);
        }
#undef LA4_LOAD
#undef LA4_STEP
    }
}

template <int DK, bool GLA>
DI void la_pass3_unit(Frame& F, LAS unsigned char* wl, int b, int h, int n, int tq, const bf16_t* SpBase) {
    int lane = F.lane; asm volatile("" : "+v"(lane), "+s"(n), "+s"(tq));
    const int g = lane >> 4, i16 = lane & 15, q = i16 >> 2, p = i16 & 3;
    constexpr int NKS = DK / 32;
    const int r0 = b * SEQ + n * LA_C, t0 = 32 * tq, hd = h * 64;
    const int qcol = GLA ? h * 64 : 1536 + h * 128, kcol = GLA ? 256 + h * 64 : 2048 + h * 128, vcol = (GLA ? 512 : 2560) + h * 128, gcol = (GLA ? 1024 : 3072) + h * 128, ocol = (GLA ? 0 : 512) + h * 128;
    const float lg2 = lg2_gamma(h);
    u32x4 qraw[2][NKS]; f32x4 qb[2][NKS][2]; f32x4 c63[NKS][2];
    u32x4 kraw[2][NKS]; f32x4 kb[2][NKS][2]; u32x4 vraw[8];
#pragma unroll
    for (int tb = 0; tb < 2; ++tb)
#pragma unroll
        for (int ks = 0; ks < NKS; ++ks) {
            const size_t row = (size_t)(r0 + t0 + 16 * tb + i16);
            qraw[tb][ks] = *(const u32x4*)(F.proj + row * NPROJ + qcol + 32 * ks + 8 * g);
            if (GLA) { const float* bp = F.bcum + row * 256 + hd + 32 * ks + 8 * g; qb[tb][ks][0] = *(const f32x4*)bp; qb[tb][ks][1] = *(const f32x4*)(bp + 4); }
        }
    if (GLA) {
#pragma unroll
        for (int ks = 0; ks < NKS; ++ks) { const float* cp = F.bcum + (size_t)(r0 + 63) * 256 + hd + 32 * ks + 8 * g; c63[ks][0] = *(const f32x4*)cp; c63[ks][1] = *(const f32x4*)(cp + 4); }
    }
#define LA3_LOAD_KV(sp_) do { const int rs_ = r0 + 32 * (sp_); \
        _Pragma("unroll") for (int sb = 0; sb < 2; ++sb) _Pragma("unroll") for (int ks = 0; ks < NKS; ++ks) { const size_t row = (size_t)(rs_ + 16 * sb + i16); \
            kraw[sb][ks] = *(const u32x4*)(F.proj + row * NPROJ + kcol + 32 * ks + 8 * g); \
            if (GLA) { const float* bp = F.bcum + row * 256 + hd + 32 * ks + 8 * g; kb[sb][ks][0] = *(const f32x4*)bp; kb[sb][ks][1] = *(const f32x4*)(bp + 4); } } \
        _Pragma("unroll") for (int i = 0; i < 8; ++i) vraw[i] = *(const u32x4*)(F.proj + (size_t)(rs_ + (lane >> 4) + 4 * i) * NPROJ + vcol + 8 * (lane & 15)); } while (0)
    LA3_LOAD_KV(0);
    bf16x8 qf[2][NKS];
#pragma unroll
    for (int tb = 0; tb < 2; ++tb)
#pragma unroll
        for (int ks = 0; ks < NKS; ++ks) {
            if (GLA) {
                float f[8];
#pragma unroll
                for (int j = 0; j < 8; ++j) f[j] = __expf(qb[tb][ks][j >> 2][j & 3] + (t0 >= 64 ? c63[ks][j >> 2][j & 3] : 0.f));
                qf[tb][ks] = scale8(qraw[tb][ks], f);
            } else qf[tb][ks] = scale1(qraw[tb][ks], exp2f((float)(t0 + 16 * tb + i16 + 1) * lg2));
        }
    f32x4 o[2][8];
#pragma unroll
    for (int tb = 0; tb < 2; ++tb)
#pragma unroll
        for (int eb = 0; eb < 8; ++eb) o[tb][eb] = (f32x4){0.f, 0.f, 0.f, 0.f};
    const int vbase = (4 * g + q) * 32 + 8 * p;
#pragma unroll 1
    for (int sp = 0; sp <= tq; ++sp) {
#pragma unroll
        for (int i = 0; i < 8; ++i) { const int tau = (lane >> 4) + 4 * i, ch = lane & 15; *(LAS u32x4*)(wl + (ch >> 1) * 1024 + tau * 32 + (ch & 1) * 16) = vraw[i]; }
        bf16x8 kf[2][NKS];
#pragma unroll
        for (int sb = 0; sb < 2; ++sb)
#pragma unroll
            for (int ks = 0; ks < NKS; ++ks) {
                if (GLA) {
                    float f[8];
#pragma unroll
                    for (int j = 0; j < 8; ++j) f[j] = __expf(-(kb[sb][ks][j >> 2][j & 3] + (sp >= 2 ? c63[ks][j >> 2][j & 3] : 0.f)));
                    kf[sb][ks] = scale8(kraw[sb][ks], f);
                } else kf[sb][ks] = scale1(kraw[sb][ks], exp2f(-(float)(32 * sp + 16 * sb + i16 + 1) * lg2));
            }
        if (sp < tq) LA3_LOAD_KV(sp + 1);
        bf16x8 pf[2];
#pragma unroll
        for (int tb = 0; tb < 2; ++tb) {
            const int T = 2 * tq + tb;
            f32x4 s0 = (f32x4){0.f, 0.f, 0.f, 0.f}, s1 = s0;
#pragma unroll
            for (int ks = 0; ks < NKS; ++ks) {
                s0 = __builtin_amdgcn_mfma_f32_16x16x32_bf16(kf[0][ks], qf[tb][ks], s0, 0, 0, 0);
                s1 = __builtin_amdgcn_mfma_f32_16x16x32_bf16(kf[1][ks], qf[tb][ks], s1, 0, 0, 0);
            }
            const int S0 = 2 * sp, S1 = 2 * sp + 1;
#pragma unroll
            for (int r = 0; r < 4; ++r) {
                const bool keep = (4 * g + r) <= i16;
                if (S0 == T && !keep) s0[r] = 0.f;
                if (S1 > T || (S1 == T && !keep)) s1[r] = 0.f;
            }
            u32x4 pw_; pw_.x = cvt_pk_bf16(s0[0], s0[1]); pw_.y = cvt_pk_bf16(s0[2], s0[3]); pw_.z = cvt_pk_bf16(s1[0], s1[1]); pw_.w = cvt_pk_bf16(s1[2], s1[3]);
            pf[tb] = __builtin_bit_cast(bf16x8, pw_);
        }
#pragma unroll
        for (int eb = 0; eb < 8; ++eb) {
            const bf16x8 vf = tr_pair(wl + eb * 1024 + vbase, wl + eb * 1024 + vbase + 512);
            o[0][eb] = __builtin_amdgcn_mfma_f32_16x16x32_bf16(pf[0], vf, o[0][eb], 0, 0, 0);
            o[1][eb] = __builtin_amdgcn_mfma_f32_16x16x32_bf16(pf[1], vf, o[1][eb], 0, 0, 0);
        }
    }
#undef LA3_LOAD_KV
    u32x4 gt[8];
#pragma unroll
    for (int i = 0; i < 8; ++i) gt[i] = *(const u32x4*)(F.proj + (size_t)(r0 + t0 + 4 * i + (lane >> 4)) * NPROJ + gcol + 8 * (lane & 15));
    const bf16_t* Sp = SpBase + (size_t)n * 128 * DK;
#pragma unroll
    for (int eb = 0; eb < 8; ++eb)
#pragma unroll
        for (int ks = 0; ks < NKS; ++ks) {
            const bf16x8 sf = *(const bf16x8*)(Sp + (size_t)(16 * eb + i16) * DK + 32 * ks + 8 * g);
            o[0][eb] = __builtin_amdgcn_mfma_f32_16x16x32_bf16(qf[0][ks], sf, o[0][eb], 0, 0, 0);
            o[1][eb] = __builtin_amdgcn_mfma_f32_16x16x32_bf16(qf[1][ks], sf, o[1][eb], 0, 0, 0);
        }
#pragma unroll
    for (int tb = 0; tb < 2; ++tb)
#pragma unroll
        for (int r = 0; r < 4; ++r) {
            float mu = 0.f;
            if (!GLA) {
                float s = 0.f;
#pragma unroll
                for (int eb = 0; eb < 8; ++eb) s += o[tb][eb][r];
                s = row16_sum(s);
                mu = s * (1.0f / 128.f);
            }
            float ss = 0.f;
#pragma unroll
            for (int eb = 0; eb < 8; ++eb) { const float dlt = o[tb][eb][r] - mu; o[tb][eb][r] = dlt; ss += dlt * dlt; }
            ss = row16_sum(ss);
            const float rstd = __builtin_amdgcn_rsqf(ss * (1.0f / 128.f) + EPS);
#pragma unroll
            for (int eb = 0; eb < 8; ++eb) *(LAS float*)(wl + ((16 * tb + 4 * g + r) * 128 + 16 * eb + i16) * 4) = o[tb][eb][r] * rstd;
        }
    {
        const int ch = lane & 15; const float* onw = (GLA ? F.gla_onorm : F.ret_onorm) + 8 * ch;
        const f32x4 w0 = *(const f32x4*)onw, w1 = *(const f32x4*)(onw + 4);
#pragma unroll
        for (int i = 0; i < 8; ++i) {
            const int t = 4 * i + (lane >> 4); const size_t row = (size_t)(r0 + t0 + t);
            const f32x4 y0 = *(const LAS f32x4*)(wl + (t * 128 + 8 * ch) * 4), y1 = *(const LAS f32x4*)(wl + (t * 128 + 8 * ch + 4) * 4);
            const u32x4 gg = gt[i];
            float ov[8];
            ov[0] = y0[0] * w0[0] * bflo(gg.x); ov[1] = y0[1] * w0[1] * bfhi(gg.x); ov[2] = y0[2] * w0[2] * bflo(gg.y); ov[3] = y0[3] * w0[3] * bfhi(gg.y);
            ov[4] = y1[0] * w1[0] * bflo(gg.z); ov[5] = y1[1] * w1[1] * bfhi(gg.z); ov[6] = y1[2] * w1[2] * bflo(gg.w); ov[7] = y1[3] * w1[3] * bfhi(gg.w);
#if O_FP8
            { u32x2 w8; w8.x = pk4_fp8(ov[0] * O8_SCALE, ov[1] * O8_SCALE, ov[2] * O8_SCALE, ov[3] * O8_SCALE); w8.y = pk4_fp8(ov[4] * O8_SCALE, ov[5] * O8_SCALE, ov[6] * O8_SCALE, ov[7] * O8_SCALE);
              *(u32x2*)((unsigned char*)F.obuf + row * D + ocol + 8 * ch) = w8; }
#else
            store8_bf16(F.obuf + row * D + ocol + 8 * ch, ov);
#endif
        }
    }
}

DI void p5_la_pass3(Frame& F) {
    { int t_ = threadIdx.x; asm volatile("" : "+v"(t_)); F.tid = t_; F.lane = t_ & 63; }
    LAS unsigned char* wl = F.lds + F.wave * 16384;
    const int gw = F.bid * NWAVES + F.wave, NGW = F.G * NWAVES;
    const bf16_t* Sg = (const bf16_t*)(F.ws + WS_SP); const bf16_t* Sr = Sg + U_RET_OFF;
    const int ntask_round = NGW >> 2;
#pragma unroll 1
    for (int i = 0; i * ntask_round < 2048; ++i) {
        const int task = i * ntask_round + (gw >> 2); if (task >= 2048) break;
        const int tq = (gw + i) & 3, type = task & 1, idx = task >> 1, st = idx >> 7, n = idx & 127;
        if (type == 0) la_pass3_unit<64, true>(F, wl, st >> 2, st & 3, n, tq, Sg + (size_t)st * LA_NC * 128 * 64);
        else la_pass3_unit<128, false>(F, wl, st >> 2, st & 3, n, tq, Sr + (size_t)st * LA_NC * 128 * 128);
    }
}

#define DPPF(v, ctrl) __builtin_bit_cast(float, __builtin_amdgcn_update_dpp(__builtin_bit_cast(int, v), __builtin_bit_cast(int, v), ctrl, 0xf, 0xf, false))
DI float row16_max(float v) {
    v = fmaxf(v, DPPF(v, 0xB1)); v = fmaxf(v, DPPF(v, 0x4E)); v = fmaxf(v, DPPF(v, 0x141)); v = fmaxf(v, DPPF(v, 0x140)); return v;
}
DI void p7_router(Frame& F) {
    { int t_ = threadIdx.x; asm volatile("" : "+v"(t_)); F.tid = t_; F.lane = t_ & 63; }
    constexpr int RS = 2064;
    LAS unsigned char* hh = F.lds;
    LAS unsigned char* hlo = F.lds + 16 * RS;
    LAS float* part = (LAS float*)(F.lds + 69632);
    LAS int* hist = (LAS int*)(F.lds + 98304);
    LAS int* basearr = hist + 32;
    LAS int* pinfo = hist + 64;
    LAS float* pwl = (LAS float*)(pinfo + 512);
    const int e = F.lane & 31, g = F.lane >> 4, i16 = F.lane & 15;
    for (int rb = F.bid; rb < M / 128; rb += F.G) {
        const int row0 = rb * 128, b = row0 >= SEQ;
        bf16x8 wh[4][2], wl[4][2];
#pragma unroll
        for (int ks = 0; ks < 4; ++ks)
#pragma unroll
            for (int eb = 0; eb < 2; ++eb) {
                const float* wp = F.w_router + (size_t)(128 * F.wave + 32 * ks + 8 * g) * NE + 16 * eb + i16;
                float w[8];
#pragma unroll
                for (int j = 0; j < 8; ++j) w[j] = wp[j * NE];
                u32x4 hi, lo;
                hi.x = pk2(w[0], w[1]); hi.y = pk2(w[2], w[3]); hi.z = pk2(w[4], w[5]); hi.w = pk2(w[6], w[7]);
                lo.x = pk2(w[0] - bflo(hi.x), w[1] - bfhi(hi.x)); lo.y = pk2(w[2] - bflo(hi.y), w[3] - bfhi(hi.y));
                lo.z = pk2(w[4] - bflo(hi.z), w[5] - bfhi(hi.z)); lo.w = pk2(w[6] - bflo(hi.w), w[7] - bfhi(hi.w));
                wh[ks][eb] = __builtin_bit_cast(bf16x8, hi); wl[ks][eb] = __builtin_bit_cast(bf16x8, lo);
            }
        f32x4 cs[4], sh[4];
#pragma unroll
        for (int j = 0; j < 4; ++j) {
            const f32x4 w = ((const f32x4*)F.norm2)[F.lane + 64 * j], sc = ((const f32x4*)(F.mod + b * 6144 + 4096))[F.lane + 64 * j];
            cs[j] = w * (sc + 1.0f); sh[j] = ((const f32x4*)(F.mod + b * 6144 + 3072))[F.lane + 64 * j];
        }
        const float brt = F.b_router[e];
        if (F.tid < 32) hist[F.tid] = 0;
        f32x4 va[4], vb[4];
#if X1_BF16
        { const u32x2* xa = (const u32x2*)((const bf16_t*)F.x1 + (size_t)(row0 + 2 * F.wave) * D) + F.lane;
#pragma unroll
          for (int j = 0; j < 4; ++j) { va[j] = bf4_to_f32(xa[64 * j]); vb[j] = bf4_to_f32(xa[256 + 64 * j]); } }
#else
        { const f32x4* xa = (const f32x4*)(F.x1 + (size_t)(row0 + 2 * F.wave) * D) + F.lane;
#pragma unroll
          for (int j = 0; j < 4; ++j) { va[j] = xa[64 * j]; vb[j] = xa[256 + 64 * j]; } }
#endif
        __syncthreads();
#pragma unroll 1
        for (int batch = 0; batch < 8; ++batch) {
            {
                const int rl0 = 2 * F.wave, rowa = row0 + batch * 16 + rl0;
                float sa = 0.f, sb = 0.f;
#pragma unroll
                for (int j = 0; j < 4; ++j) { sa += (va[j].x * va[j].x + va[j].y * va[j].y) + (va[j].z * va[j].z + va[j].w * va[j].w); sb += (vb[j].x * vb[j].x + vb[j].y * vb[j].y) + (vb[j].z * vb[j].z + vb[j].w * vb[j].w); }
                const float ra = __builtin_amdgcn_rsqf(wave_sum(sa) * (1.0f / D) + EPS), rbb = __builtin_amdgcn_rsqf(wave_sum(sb) * (1.0f / D) + EPS);
#if MOE_FP8
                unsigned* oa = (unsigned*)((unsigned char*)F.hbuf + (size_t)rowa * D) + F.lane;
#else
                u32x2* oa = (u32x2*)(F.hbuf + (size_t)rowa * D) + F.lane;
#endif
#pragma unroll
                for (int j = 0; j < 4; ++j) {
                    const f32x4 ha = va[j] * ra * cs[j] + sh[j], hb = vb[j] * rbb * cs[j] + sh[j];
#if MOE_FP8
                    oa[64 * j] = pk4_fp8(ha.x * H8_SCALE, ha.y * H8_SCALE, ha.z * H8_SCALE, ha.w * H8_SCALE);
                    oa[256 + 64 * j] = pk4_fp8(hb.x * H8_SCALE, hb.y * H8_SCALE, hb.z * H8_SCALE, hb.w * H8_SCALE);
#else
                    u32x2 p; p.x = pk2(ha.x, ha.y); p.y = pk2(ha.z, ha.w); oa[64 * j] = p;
                    p.x = pk2(hb.x, hb.y); p.y = pk2(hb.z, hb.w); oa[256 + 64 * j] = p;
#endif
                    u32x2 h1, l1, h2_, l2_;
                    h1.x = pk2(ha.x, ha.y); h1.y = pk2(ha.z, ha.w); l1.x = pk2(ha.x - bflo(h1.x), ha.y - bfhi(h1.x)); l1.y = pk2(ha.z - bflo(h1.y), ha.w - bfhi(h1.y));
                    h2_.x = pk2(hb.x, hb.y); h2_.y = pk2(hb.z, hb.w); l2_.x = pk2(hb.x - bflo(h2_.x), hb.y - bfhi(h2_.x)); l2_.y = pk2(hb.z - bflo(h2_.y), hb.w - bfhi(h2_.y));
                    const int co = (4 * F.lane + 256 * j) * 2;
                    *(LAS u32x2*)(hh + rl0 * RS + co) = h1; *(LAS u32x2*)(hlo + rl0 * RS + co) = l1;
                    *(LAS u32x2*)(hh + (rl0 + 1) * RS + co) = h2_; *(LAS u32x2*)(hlo + (rl0 + 1) * RS + co) = l2_;
                }
                if (batch < 7) {
#if X1_BF16
                    const u32x2* xn = (const u32x2*)((const bf16_t*)F.x1 + (size_t)(rowa + 16) * D) + F.lane;
#pragma unroll
                    for (int j = 0; j < 4; ++j) { va[j] = bf4_to_f32(xn[64 * j]); vb[j] = bf4_to_f32(xn[256 + 64 * j]); }
#else
                    const f32x4* xn = (const f32x4*)(F.x1 + (size_t)(rowa + 16) * D) + F.lane;
#pragma unroll
                    for (int j = 0; j < 4; ++j) { va[j] = xn[64 * j]; vb[j] = xn[256 + 64 * j]; }
#endif
                }
            }
            __syncthreads();
            {
                f32x4 acc0 = (f32x4){0.f, 0.f, 0.f, 0.f}, acc1 = acc0;
#pragma unroll
                for (int ks = 0; ks < 4; ++ks) {
                    const int off = i16 * RS + (128 * F.wave + 32 * ks + 8 * g) * 2;
                    const bf16x8 ah = *(const LAS bf16x8*)(hh + off), al = *(const LAS bf16x8*)(hlo + off);
                    acc0 = __builtin_amdgcn_mfma_f32_16x16x32_bf16(ah, wh[ks][0], acc0, 0, 0, 0);
                    acc0 = __builtin_amdgcn_mfma_f32_16x16x32_bf16(ah, wl[ks][0], acc0, 0, 0, 0);
                    acc0 = __builtin_amdgcn_mfma_f32_16x16x32_bf16(al, wh[ks][0], acc0, 0, 0, 0);
                    acc1 = __builtin_amdgcn_mfma_f32_16x16x32_bf16(ah, wh[ks][1], acc1, 0, 0, 0);
                    acc1 = __builtin_amdgcn_mfma_f32_16x16x32_bf16(ah, wl[ks][1], acc1, 0, 0, 0);
                    acc1 = __builtin_amdgcn_mfma_f32_16x16x32_bf16(al, wh[ks][1], acc1, 0, 0, 0);
                }
#pragma unroll
                for (int r = 0; r < 4; ++r) { part[((4 * g + r) * 8 + F.wave) * 32 + i16] = acc0[r]; part[((4 * g + r) * 8 + F.wave) * 32 + 16 + i16] = acc1[r]; }
            }
            __syncthreads();
#pragma unroll
            for (int rr = 0; rr < 2; ++rr) {
                const int rl = 2 * F.wave + rr, rloc = batch * 16 + rl;
                float val = brt;
#pragma unroll
                for (int p = 0; p < 8; ++p) val += part[(rl * 8 + p) * 32 + e];
                if (F.lane >= 32) val = -INFINITY;
                int sel[4]; float sv[4];
#pragma unroll
                for (int k = 0; k < 4; ++k) {
                    const float rm = row16_max(val);
                    const float mx = fmaxf(__builtin_bit_cast(float, __builtin_amdgcn_readlane(__builtin_bit_cast(int, rm), 0)), __builtin_bit_cast(float, __builtin_amdgcn_readlane(__builtin_bit_cast(int, rm), 16)));
                    const unsigned long long bal = __ballot(val == mx && F.lane < 32);
                    const int idx = bal ? (int)__builtin_ctzll(bal) : 0;
                    sel[k] = idx; sv[k] = mx;
                    if (F.lane == idx) val = -INFINITY;
                }
                const float e1 = __expf(sv[1] - sv[0]), e2 = __expf(sv[2] - sv[0]), e3 = __expf(sv[3] - sv[0]);
                const float inv = 1.0f / (1.0f + e1 + e2 + e3);
                if (F.lane < 4) {
                    const int k = F.lane;
                    const int se = k == 0 ? sel[0] : k == 1 ? sel[1] : k == 2 ? sel[2] : sel[3];
                    const float wv = (k == 0 ? 1.0f : k == 1 ? e1 : k == 2 ? e2 : e3) * inv;
                    const int lr = __hip_atomic_fetch_add(hist + se, 1, __ATOMIC_RELAXED, __HIP_MEMORY_SCOPE_WORKGROUP);
                    pinfo[rloc * 4 + k] = se | (lr << 8);
                    pwl[rloc * 4 + k] = wv;
                }
            }
            __syncthreads();
        }
        if (F.tid < 32) basearr[F.tid] = (int)atomicAdd(F.ctl + CW_CNT + 64 * F.tid, (unsigned)hist[F.tid]);
        __syncthreads();
        { const int info = pinfo[F.tid], ee = info & 255, lr = info >> 8; u32x2 rec; rec.x = (unsigned)(row0 * 4 + F.tid); rec.y = __builtin_bit_cast(unsigned, pwl[F.tid]); F.perm[(size_t)ee * ECAP + basearr[ee] + lr] = rec; }
        __syncthreads();
    }
}

DI void moe_order(Frame& F, pg8::MoeOrder& S, int NT, const void* Bt, size_t bstride, int ebytes, int sa, int sb) {
    LAS int* mi = (LAS int*)(F.lds + MISC_OFF);
    LAS int* ud = (LAS int*)(F.lds + UD_OFF);
    if (F.tid < 32) mi[F.tid] = (int)F.ctl[CW_CNT + 64 * F.tid];
    __syncthreads();
    if (F.tid == 0) { int o = 0, tp = 0; for (int i = 0; i < NE; ++i) { mi[32 + i] = o; mi[64 + i] = tp; o += mi[i]; tp += (mi[i] + 255) >> 8; } mi[96] = tp; }
    __syncthreads();
    const int x = F.bid & 7, JB = F.G >> 3, j = F.bid >> 3;
    const int ptot = mi[96], lo = ptot * x / 8, hi = ptot * (x + 1) / 8, U = (hi - lo) * NT;
    if (F.tid < 64) {
        const int q = j + F.tid * JB;
        if (q < U) {
            const int pl = q / NT, pn = q % NT, g = lo + pl;
            int e = 0;
            for (int k = 1; k < NE; ++k) e += (mi[64 + k] <= g) ? 1 : 0;
            const int p = g - mi[64 + e], left = mi[e] - p * 256;
            i32x4_ r; r.x = e | (pn << 8) | (((pn + 2 * pl) & 7) << 16); r.y = left < 256 ? left : 256; r.z = mi[32 + e] + p * 256; r.w = e * ECAP + p * 256;
            *(LAS i32x4_*)(ud + 4 * F.tid) = r;
        }
    }
    __syncthreads();
    const int nu = U > j ? (U - j + JB - 1) / JB : 0;
    S.n = __builtin_amdgcn_readfirstlane(nu < 64 ? nu : 64); S.ud = ud; S.Bt = Bt; S.bstride = bstride; S.ebytes = ebytes; S.sa = sa; S.sb = sb;
}
struct MoeBatch {
    pg8::MoeOrder S; int i0, n;
    DI bool next(int i, pg8::Unit& u) const { if (i >= n) return false; return S.next(i0 + i, u); }
    DI const char* bptr(const pg8::Unit& u) const { return S.bptr(u); }
    DI int scale_a() const { return S.sa; }
    DI int scale_b() const { return S.sb; }
};

DI void p8_gu(Frame& F) {
    { int t_ = threadIdx.x; asm volatile("" : "+v"(t_)); F.tid = t_; F.lane = t_ & 63; }
    pg8::MoeOrder S; moe_order(F, S, 8, F.wgu_t, (size_t)2048 * D, MOE_FP8 ? 1 : 2, H8_E8M0, W8_E8M0);
    LAS unsigned* tbl = (LAS unsigned*)(F.lds + TBL_OFF);
    EpiGU E{F.b_gu, F.act};
    for (int i0 = 0;; i0 += TBL_UNITS) {
        pg8::Unit u; if (!S.next(i0, u)) break;
        int n;
        {
            int t_ = threadIdx.x; asm volatile("" : "+v"(t_));
            const int ln = t_ & 63, half = __builtin_amdgcn_readfirstlane(t_ >> 8), idx = t_ & 255;
            pg8::Unit uk; uk.prow0 = 0; uk.rows = 0;
            const bool ok = ln < TBL_UNITS && S.next_lane(i0 + ln, uk);
            n = __builtin_popcountll(__ballot(ok));
            const int pv = ok ? uk.prow0 : 0, rv = ok ? uk.rows : 0;
            unsigned pr[TBL_UNITS / 2];
#pragma unroll
            for (int it = 0; it < TBL_UNITS / 2; ++it) {
                const int k = 2 * it + half; pr[it] = 0u;
                if (k < n) { const int p0 = __builtin_amdgcn_readlane(pv, k), rw = __builtin_amdgcn_readlane(rv, k); pr[it] = F.perm[p0 + (idx < rw ? idx : 0)].x; }
            }
#pragma unroll
            for (int it = 0; it < TBL_UNITS / 2; ++it) { const int k = 2 * it + half; if (k < n) tbl[k * 256 + idx] = (pr[it] >> 2) * (unsigned)(D * (MOE_FP8 ? 1 : 2)); }
        }
        __syncthreads();
        MoeBatch Bt{S, i0, n};
        pg8::gemm_phase<EpiGU, MoeBatch, true, (MOE_FP8 != 0)>(F.lds, F.hbuf, Bt, E, tbl);
        __syncthreads();
    }
}
DI void p9_down(Frame& F) {
    { int t_ = threadIdx.x; asm volatile("" : "+v"(t_)); F.tid = t_; F.lane = t_ & 63; }
    pg8::MoeOrder S; moe_order(F, S, 4, F.wd_t, (size_t)D * D, MOE_FP8 ? 1 : 2, A8_E8M0, W8_E8M0);
    LAS unsigned* tbl = (LAS unsigned*)(F.lds + TBL_OFF);
    EpiDown E{F.b_down, F.perm, F.Y};
    for (int i0 = 0;; i0 += TBL_UNITS) {
        pg8::Unit u; if (!S.next(i0, u)) break;
        int n = 0;
        for (; n < TBL_UNITS; ++n) {
            if (!S.next(i0 + n, u)) break;
            int t_ = threadIdx.x; asm volatile("" : "+v"(t_));
            if (t_ < 256) tbl[n * 256 + t_] = (unsigned)(u.arow0 + t_) * (unsigned)(D * (MOE_FP8 ? 1 : 2));
        }
        __syncthreads();
        MoeBatch Bt{S, i0, n};
        pg8::gemm_phase<EpiDown, MoeBatch, true, (MOE_FP8 != 0), true>(F.lds, F.act, Bt, E, tbl);
        __syncthreads();
    }
}

DI void p10_final(Frame& F) {
    { int t_ = threadIdx.x; asm volatile("" : "+v"(t_)); F.tid = t_; F.lane = t_ & 63; }
    const int gw = F.bid * NWAVES + F.wave, NGW = F.G * NWAVES;
    f32x4 xv[4], xn[4]; int yv[4][4], yn[4][4];
#if X1_BF16
#define P10_XLOAD(xr_, j_) bf4_to_f32(__builtin_nontemporal_load((const u32x2*)((const bf16_t*)(xr_)) + F.lane + 64 * (j_)))
#else
#define P10_XLOAD(xr_, j_) __builtin_nontemporal_load((const f32x4*)(xr_) + F.lane + 64 * (j_))
#endif
#define P10_LOAD(X_, Y_, m_) do { const void* xr_ = X1_BF16 ? (const void*)((const bf16_t*)F.x1 + (size_t)(m_) * D) : (const void*)(F.x1 + (size_t)(m_) * D); \
        _Pragma("unroll") for (int j = 0; j < 4; ++j) { X_[j] = P10_XLOAD(xr_, j); \
            _Pragma("unroll") for (int k = 0; k < 4; ++k) Y_[j][k] = __builtin_nontemporal_load((const int*)((const unsigned char*)F.Y + ((size_t)(m_) * 4 + k) * D * (Y_FP8 ? 1 : 2)) + F.lane + 64 * j); } } while (0)
    static_assert(Y_FP8, "p10_final reads fp8 rows");
    if (gw < M) P10_LOAD(xv, yv, gw);
    for (int m = gw; m < M; m += NGW) {
        const int b = m >= SEQ;
        if (m + NGW < M) P10_LOAD(xn, yn, m + NGW);
        const f32x4* gr = (const f32x4*)(F.mod + b * 6144 + 5120) + F.lane;
        f32x4 v[4]; float s = 0.f;
#pragma unroll
        for (int j = 0; j < 4; ++j) {
            f32x4 y = (f32x4){0.f, 0.f, 0.f, 0.f};
#pragma unroll
            for (int k = 0; k < 4; ++k) {
                const f32x2 lo = __builtin_amdgcn_cvt_pk_f32_fp8(yv[j][k], false), hi = __builtin_amdgcn_cvt_pk_f32_fp8(yv[j][k], true);
                y += (f32x4){lo.x, lo.y, hi.x, hi.y};
            }
            v[j] = xv[j] + gr[64 * j] * (y * Y8_INV);
            s += (v[j].x * v[j].x + v[j].y * v[j].y) + (v[j].z * v[j].z + v[j].w * v[j].w);
        }
        const float rstd = __builtin_amdgcn_rsqf(wave_sum(s) * (1.0f / D) + EPS);
        f32x4* o = (f32x4*)(F.out + (size_t)m * D) + F.lane;
#pragma unroll
        for (int j = 0; j < 4; ++j) __builtin_nontemporal_store(v[j] * rstd * ((const f32x4*)F.norm_f)[F.lane + 64 * j], o + 64 * j);
#pragma unroll
        for (int j = 0; j < 4; ++j) { xv[j] = xn[j];
#pragma unroll
            for (int k = 0; k < 4; ++k) yv[j][k] = yn[j][k]; }
    }
#undef P10_LOAD
}

constexpr int NPH = 11;
template <int LO, int HI>
__global__ void __launch_bounds__(NTHREADS, 2) fwd_kernel(Args args) {
    extern __shared__ __attribute__((aligned(16))) unsigned char lds[];
    Frame F;
    F.lds = (LAS unsigned char*)lds;
    F.tid = threadIdx.x; F.lane = F.tid & 63; F.wave = __builtin_amdgcn_readfirstlane(F.tid >> 6);
    F.G = gridDim.x; F.bid = blockIdx.x;
    F.x = (const float*)args.in[0]; F.c = (const float*)args.in[1]; F.positions = (const int*)args.in[2]; F.w_ada = (const float*)args.in[3]; F.b_ada = (const float*)args.in[4];
    F.norm1 = (const float*)args.in[5]; F.w_in = (const float*)args.in[6]; F.w_gk2 = (const float*)args.in[7]; F.b_gk = (const float*)args.in[8]; F.gla_onorm = (const float*)args.in[9];
    F.ret_onorm = (const float*)args.in[10]; F.w_out = (const float*)args.in[11]; F.norm2 = (const float*)args.in[12]; F.w_router = (const float*)args.in[13]; F.b_router = (const float*)args.in[14];
    F.w_gu = (const float*)args.in[15]; F.b_gu = (const float*)args.in[16]; F.w_down = (const float*)args.in[17]; F.b_down = (const float*)args.in[18]; F.norm_f = (const float*)args.in[19];
    F.out = args.out; F.ws = args.ws;
    unsigned char* ws = args.ws;
    F.ctl = (unsigned*)(ws + WS_CTL); F.mod = (float*)(ws + WS_MOD); F.win_t = (bf16_t*)(ws + WS_WIN); F.wout_t = (bf16_t*)(ws + WS_WOUT); F.wgu_t = (bf16_t*)(ws + WS_WGU); F.wd_t = (bf16_t*)(ws + WS_WD);
    F.hbuf = (bf16_t*)(ws + WS_H); F.obuf = (bf16_t*)(ws + WS_O); F.proj = (bf16_t*)(ws + WS_PROJ); F.act = (bf16_t*)(ws + WS_ACT); F.Y = (bf16_t*)(ws + WS_Y);
    F.x1 = (float*)(ws + WS_X1); F.bcum = (float*)(ws + WS_BCUM); F.pw = (float*)(ws + WS_PW); F.perm = (u32x2*)(ws + WS_PERM);

#define IN(k) (LO <= (k) && (k) < HI)
#if ONE_LAUNCH && USE_CG_SYNC
#define GSYNC(k) do { if (IN(k) && IN((k) + 1)) { cg::this_grid().sync(); } } while (0)
#elif ONE_LAUNCH
    { volatile LAS unsigned* st = (volatile LAS unsigned*)(F.lds + MISC_OFF + 512); if (F.tid < 2) st[F.tid] = 0u; }
    __syncthreads();
    const XcdBarrier bar = xcd_barrier_post(F.ctl + CW_BAR, (volatile LAS unsigned*)(F.lds + MISC_OFF + 512));
#define GSYNC(k) do { if (IN(k) && IN((k) + 1)) { xcd_barrier(bar); } } while (0)
#else
#define GSYNC(k) do { } while (0)
#endif
    if (IN(0)) { p0_prep(F); if (DUP(0)) p0_prep(F); } GSYNC(0);
    if (IN(1)) { p1_h1(F); if (DUP(1)) p1_h1(F); } GSYNC(1);
    if (IN(2)) {
        pg8::DenseOrder S; S.init(M, NIN_T, F.G, F.bid, F.win_t);
        EpiProj E{F.proj, F.bcum, F.positions, F.b_gk};
        pg8::gemm_phase<EpiProj, pg8::DenseOrder, false>(F.lds, F.hbuf, S, E, nullptr);
        if (DUP(2)) pg8::gemm_phase<EpiProj, pg8::DenseOrder, false>(F.lds, F.hbuf, S, E, nullptr);
        { pg8::Unit u8; if (F.G == 256 && !S.next(7, u8)) {
            { int t_ = threadIdx.x; asm volatile("" : "+v"(t_)); F.tid = t_; F.lane = t_ & 63; }
            const int nidle = F.G - (1920 - 7 * F.G), widx = (F.bid - (1920 - 7 * F.G)) * NWAVES + F.wave;
            if (nidle > 0 && widx >= 0) tr_range(F, (LAS float*)(F.lds + 16384 + F.wave * 8704), TR_SPLIT1, TR_SPLIT2, widx, nidle * NWAVES); } }
    } GSYNC(2);
#if NAIVE_LA
    if (IN(3)) { p3_la_naive(F); } GSYNC(3);
    GSYNC(4);
    GSYNC(5);
#else
    if (IN(3)) { p3_la_pass1(F); if (DUP(3)) p3_la_pass1(F); } GSYNC(3);
    if (IN(4)) { p4_la_scan(F); if (DUP(4)) p4_la_scan(F); } GSYNC(4);
    if (IN(5)) { p5_la_pass3(F); if (DUP(5)) p5_la_pass3(F); } GSYNC(5);
#endif
    if (IN(6)) {
        EpiRes1 E{F.x, F.mod, F.x1};
#if O_FP8
        pg8::DenseOrder S; S.init(M, D, F.G, F.bid, F.wout_t, 1, O8_E8M0, W8_E8M0);
        LAS unsigned* tbl = (LAS unsigned*)(F.lds + TBL_OFF);
        { pg8::Unit u; int n = 0;
          for (; n < TBL_UNITS; ++n) { if (!S.next(n, u)) break; int t_ = threadIdx.x; asm volatile("" : "+v"(t_)); if (t_ < 256) tbl[n * 256 + t_] = (unsigned)(u.arow0 + t_) * (unsigned)D; } }
        __syncthreads();
        pg8::gemm_phase<EpiRes1, pg8::DenseOrder, true, true, true>(F.lds, F.obuf, S, E, tbl);
#else
        pg8::DenseOrder S; S.init(M, D, F.G, F.bid, F.wout_t);
        pg8::gemm_phase<EpiRes1, pg8::DenseOrder, false, false, true>(F.lds, F.obuf, S, E, nullptr);
        if (DUP(6)) pg8::gemm_phase<EpiRes1, pg8::DenseOrder, false, false, true>(F.lds, F.obuf, S, E, nullptr);
#endif
    } GSYNC(6);
    if (IN(7)) { p7_router(F); } GSYNC(7);
    if (IN(8)) { p8_gu(F); if (DUP(8)) p8_gu(F); } GSYNC(8);
    if (IN(9)) { p9_down(F); if (DUP(9)) p9_down(F); } GSYNC(9);
    if (IN(10)) { p10_final(F); if (DUP(10)) p10_final(F); }
}

extern "C" void kernel_launch(void* const* d_in, const int* in_sizes, int n_in, void* d_out, int out_size, void* d_ws, size_t ws_size, hipStream_t stream) {
    static int grid = 0;
    if (grid == 0) {
        if (n_in != 20 || out_size != M * D || ws_size < WS_END) { fprintf(stderr, "kernel_launch: unexpected shapes (n_in %d out %d ws %zu)\n", n_in, out_size, ws_size); grid = -1; return; }
        int dev = 0, cus = 0, per_cu = 0;
        hipGetDevice(&dev); hipDeviceGetAttribute(&cus, hipDeviceAttributeMultiprocessorCount, dev);
#if ONE_LAUNCH
        hipFuncSetAttribute((const void*)fwd_kernel<0, NPH>, hipFuncAttributeMaxDynamicSharedMemorySize, LDS_BYTES);
        hipOccupancyMaxActiveBlocksPerMultiprocessor(&per_cu, (const void*)fwd_kernel<0, NPH>, NTHREADS, LDS_BYTES);
#else
        per_cu = 1;
#define SETATTR(k) hipFuncSetAttribute((const void*)fwd_kernel<k, k + 1>, hipFuncAttributeMaxDynamicSharedMemorySize, LDS_BYTES)
        SETATTR(0); SETATTR(1); SETATTR(2); SETATTR(3); SETATTR(4); SETATTR(5); SETATTR(6); SETATTR(7); SETATTR(8); SETATTR(9); SETATTR(10);
#endif
        (void)hipGetLastError();
        if (per_cu < 1) { fprintf(stderr, "kernel_launch: occupancy query says %d blocks/CU\n", per_cu); per_cu = 1; }
        grid = cus;
        if (grid != 256) fprintf(stderr, "kernel_launch: %d CUs (expected 256)\n", grid);
    }
    if (grid < 0) return;
    hipMemsetAsync((char*)d_ws + WS_CTL, 0, CTL_ZERO_BYTES, stream);
    Args a{};
    for (int i = 0; i < 20; ++i) a.in[i] = d_in[i];
    a.out = (float*)d_out; a.ws = (unsigned char*)d_ws;
#if ONE_LAUNCH
    a.ph_lo = 0; a.ph_hi = NPH;
#if USE_CG_SYNC
    void* params[] = {&a};
    hipError_t e = hipLaunchCooperativeKernel((const void*)fwd_kernel<0, NPH>, dim3(grid), dim3(NTHREADS), params, LDS_BYTES, stream);
    if (e != hipSuccess) fprintf(stderr, "cooperative launch failed: %s (grid %d)\n", hipGetErrorString(e), grid);
#else
    hipLaunchKernelGGL((fwd_kernel<0, NPH>), dim3(grid), dim3(NTHREADS), LDS_BYTES, stream, a);
#endif
#else
#define LAUNCH(k) hipLaunchKernelGGL((fwd_kernel<k, k + 1>), dim3(grid), dim3(NTHREADS), LDS_BYTES, stream, a)
    LAUNCH(0); LAUNCH(1); LAUNCH(2); LAUNCH(3); LAUNCH(4); LAUNCH(5); LAUNCH(6); LAUNCH(7); LAUNCH(8); LAUNCH(9); LAUNCH(10);
#endif
}
```

```cpp
#include <hip/hip_runtime.h>
#include <hip/hip_cooperative_groups.h>
#include <cstdio>
#include <cstdint>
namespace cg = cooperative_groups;

#ifndef ONE_LAUNCH
#define ONE_LAUNCH 1
#endif
#ifndef USE_CG_SYNC
#define USE_CG_SYNC 0
#endif
#ifndef PROBE_DUP
#define PROBE_DUP -1
#endif
#define DUP(k) (PROBE_DUP == (k))
#ifndef MOE_FP8
#define MOE_FP8 1
#endif
#ifndef Y_FP8
#define Y_FP8 1
#endif
#ifndef X1_BF16
#define X1_BF16 1
#endif
#ifndef O_FP8
#define O_FP8 1
#endif
#ifndef NAIVE_LA
#define NAIVE_LA 0
#endif

#define LAS __attribute__((address_space(3)))
#define DI __device__ __forceinline__
typedef unsigned short bf16_t;
typedef short bf16x8 __attribute__((ext_vector_type(8)));
typedef float f32x4 __attribute__((ext_vector_type(4)));
typedef float f32x2 __attribute__((ext_vector_type(2)));
typedef unsigned u32x4 __attribute__((ext_vector_type(4)));
typedef unsigned u32x2 __attribute__((ext_vector_type(2)));
typedef int i32x4 __attribute__((ext_vector_type(4)));
typedef int i32x8 __attribute__((ext_vector_type(8)));

constexpr int D = 1024, BATCH = 2, SEQ = 16384, M = BATCH * SEQ;
constexpr int NPROJ = 3584;
constexpr int NIN_T = 3840;
constexpr int MIX_IN = 3600;
constexpr int NE = 32, TOPK = 4, NPAIR = M * TOPK;
constexpr int ECAP = 32768;
constexpr float EPS = 1e-6f;
constexpr int NWAVES = 8, NTHREADS = 512;

constexpr size_t MiB = 1u << 20;
constexpr size_t WS_CTL = 0, CTL_ZERO_BYTES = 65536;
constexpr size_t WS_MOD = 1 * MiB;
constexpr size_t WS_DEC = 1 * MiB + 65536;
constexpr size_t WS_WIN = 2 * MiB;
constexpr size_t WS_WOUT = 10 * MiB;
constexpr size_t WS_WGU = 12 * MiB;
constexpr size_t WS_WD = 140 * MiB;
constexpr size_t WS_H = 204 * MiB;
constexpr size_t WS_O = 268 * MiB;
constexpr size_t WS_X1 = 332 * MiB;
constexpr size_t WS_PROJ = 460 * MiB;
constexpr size_t WS_BCUM = 684 * MiB;
constexpr size_t WS_U = 716 * MiB;
constexpr size_t WS_SP = 812 * MiB;
constexpr size_t WS_ACT = 460 * MiB;
constexpr size_t WS_Y = 717 * MiB;
constexpr size_t WS_PERM = 973 * MiB;
constexpr size_t WS_PW = 981 * MiB;
constexpr size_t WS_END = 982 * MiB;
constexpr int CW_CNT = 1024;
constexpr int CW_BAR = 8192;

constexpr int RING_BYTES = 131072;
constexpr int TBL_OFF = RING_BYTES, TBL_UNITS = 22, UD_OFF = TBL_OFF + TBL_UNITS * 1024, TBL_BYTES = 24 * 1024;
constexpr int MISC_OFF = TBL_OFF + TBL_BYTES;
constexpr int EPI_OFF = MISC_OFF + 1024;
constexpr int LDS_BYTES = EPI_OFF + 4096;

DI unsigned f2bf(float f) { unsigned u = __builtin_bit_cast(unsigned, f); return (u + 0x7fffu + ((u >> 16) & 1u)) >> 16; }
DI unsigned pk2(float lo, float hi) { return f2bf(lo) | (f2bf(hi) << 16); }
DI float bf2f(unsigned h) { return __builtin_bit_cast(float, h << 16); }
DI float bflo(unsigned w) { return __builtin_bit_cast(float, w << 16); }
DI float bfhi(unsigned w) { return __builtin_bit_cast(float, w & 0xffff0000u); }
DI f32x4 bf4_to_f32(u32x2 w) { return (f32x4){bflo(w.x), bfhi(w.x), bflo(w.y), bfhi(w.y)}; }
DI unsigned cvt_pk_bf16(float lo, float hi) { unsigned r; asm volatile("v_cvt_pk_bf16_f32 %0, %1, %2" : "=v"(r) : "v"(lo), "v"(hi)); return r; }
#define DPPF_(v, ctrl) __builtin_bit_cast(float, __builtin_amdgcn_update_dpp(__builtin_bit_cast(int, v), __builtin_bit_cast(int, v), ctrl, 0xf, 0xf, false))
DI float row16_sum(float v) {
    v += DPPF_(v, 0xB1); v += DPPF_(v, 0x4E); v += DPPF_(v, 0x141); v += DPPF_(v, 0x140); return v;
}
DI float wave_sum(float v) {
    v = row16_sum(v);
    const int iv = __builtin_bit_cast(int, v);
    const float a = __builtin_bit_cast(float, __builtin_amdgcn_readlane(iv, 0)), b = __builtin_bit_cast(float, __builtin_amdgcn_readlane(iv, 16));
    const float c = __builtin_bit_cast(float, __builtin_amdgcn_readlane(iv, 32)), d = __builtin_bit_cast(float, __builtin_amdgcn_readlane(iv, 48));
    return (a + b) + (c + d);
}
DI float wave_max(float v) {
#pragma unroll
    for (int o = 1; o < 64; o <<= 1) v = fmaxf(v, __shfl_xor(v, o));
    return v;
}
DI float sigmoidf_(float x) { return __builtin_amdgcn_rcpf(1.0f + __builtin_amdgcn_exp2f(-1.4426950408889634f * x)); }
DI float logsigmoidf_(float x) { return fminf(x, 0.f) - 0.6931471805599453f * __builtin_amdgcn_logf(1.0f + __builtin_amdgcn_exp2f(-1.4426950408889634f * fabsf(x))); }
#define LDS_WAIT() asm volatile("s_waitcnt lgkmcnt(0)" ::: "memory")
DI unsigned pk4_fp8(float a, float b, float c, float d) {
    a = __builtin_amdgcn_fmed3f(a, -448.f, 448.f); b = __builtin_amdgcn_fmed3f(b, -448.f, 448.f); c = __builtin_amdgcn_fmed3f(c, -448.f, 448.f); d = __builtin_amdgcn_fmed3f(d, -448.f, 448.f);
    int p = __builtin_amdgcn_cvt_pk_fp8_f32(a, b, 0, false); p = __builtin_amdgcn_cvt_pk_fp8_f32(c, d, p, true); return (unsigned)p;
}
DI unsigned pk4_fp8_nc(float a, float b, float c, float d) { int p = __builtin_amdgcn_cvt_pk_fp8_f32(a, b, 0, false); p = __builtin_amdgcn_cvt_pk_fp8_f32(c, d, p, true); return (unsigned)p; }
constexpr float Y8_SCALE = 32.f, Y8_INV = 1.0f / 32.f;
constexpr float W8_SCALE = 512.f, H8_SCALE = 16.f, A8_SCALE = 4.f;
constexpr float O8_SCALE = 16.f; constexpr int O8_E8M0 = 0x7B7B7B7B;
constexpr int W8_E8M0 = 0x76767676, H8_E8M0 = 0x7B7B7B7B, A8_E8M0 = 0x7D7D7D7D;

typedef int i32x4_ __attribute__((ext_vector_type(4)));
namespace pg8 {
constexpr int BM = 256, BK = 64, HALF = 128, HTB = HALF * BK * 2, STAGE_BYTES = 8 * HTB, NXCD = 8, WGM = 8, K = 1024;
__host__ __device__ __forceinline__ int lds_byte(int r, int c) { const int st = (r >> 4) * 2 + (c >> 5), rr = r & 15, cc = c & 31, ob = rr * 64 + cc * 2; return st * 1024 + (ob ^ (((ob >> 9) & 1) << 5)); }
__host__ __device__ __forceinline__ void stage_rc(int b, int& R, int& C) { const int st = b / 1024, sb = b % 1024, swz = sb ^ (((sb >> 9) & 1) << 5); R = (st >> 1) * 16 + swz / 64; C = (st & 1) * 32 + (swz % 64) / 2; }
__host__ __device__ __forceinline__ int perm32(int rho) { const int n = rho >> 4, i = rho & 15; return 8 * (i >> 2) + 4 * n + (i & 3); }

struct Unit { int arow0, pn, e, rows, prow0, rot; };

struct DenseOrder {
    int nM, nN, nwg, G, c;
    const bf16_t* Bt; int ebytes, sa, sb;
    DI void init(int M_, int N_, int G_, int c_, const bf16_t* Bt_, int ebytes_ = 2, int sa_ = 0x7f7f7f7f, int sb_ = 0x7f7f7f7f) { nM = M_ / BM; nN = N_ / BM; nwg = nM * nN; G = G_; c = c_; Bt = Bt_; ebytes = ebytes_; sa = sa_; sb = sb_; }
    DI bool next(int i, Unit& u) const {
        const long L = (long)i * G + c; if (L >= nwg) return false;
        int wgid = (int)L; { const int q = nwg / NXCD, r = nwg % NXCD, xcd = wgid % NXCD, off = wgid / NXCD; wgid = (xcd < r ? xcd * (q + 1) : r * (q + 1) + (xcd - r) * q) + off; }
        const int nig = WGM * nN, gid = wgid / nig, fm = gid * WGM, gsz = (nM - fm) < WGM ? (nM - fm) : WGM;
        const int pm = fm + ((wgid % nig) % gsz); u.pn = (wgid % nig) / gsz; u.arow0 = pm * BM; u.e = 0; u.rows = BM; u.prow0 = 0; u.rot = (pm + 3 * u.pn) & 15; return true;
    }
    DI const char* bptr(const Unit& u) const { return (const char*)Bt + (size_t)u.pn * BM * K * ebytes; }
    DI int scale_a() const { return sa; }
    DI int scale_b() const { return sb; }
};

struct MoeOrder {
    int n;
    const LAS int* ud;
    const void* Bt; size_t bstride;
    int ebytes, sa, sb;
    DI bool next(int i, Unit& u) const {
        if (i >= n) return false;
        const i32x4_ r = *(const LAS i32x4_*)(ud + 4 * i);
        const int r0 = __builtin_amdgcn_readfirstlane(r.x);
        u.e = r0 & 255; u.pn = (r0 >> 8) & 255; u.rot = r0 >> 16;
        u.rows = __builtin_amdgcn_readfirstlane(r.y); u.arow0 = __builtin_amdgcn_readfirstlane(r.z); u.prow0 = __builtin_amdgcn_readfirstlane(r.w); return true;
    }
    DI bool next_lane(int i, Unit& u) const {
        if (i >= n) return false;
        const i32x4_ r = *(const LAS i32x4_*)(ud + 4 * i);
        u.e = r.x & 255; u.pn = (r.x >> 8) & 255; u.rot = r.x >> 16; u.rows = r.y; u.arow0 = r.z; u.prow0 = r.w; return true;
    }
    DI const char* bptr(const Unit& u) const { return (const char*)Bt + ((size_t)u.e * bstride + (size_t)u.pn * BM * K) * ebytes; }
    DI int scale_a() const { return sa; }
    DI int scale_b() const { return sb; }
};

DI const char* uniform_ptr(const char* p) {
    const unsigned long long v = (unsigned long long)p;
    const unsigned lo = __builtin_amdgcn_readfirstlane((unsigned)v), hi = __builtin_amdgcn_readfirstlane((unsigned)(v >> 32));
    return (const char*)(((unsigned long long)hi << 32) | lo);
}
template <class Epi, class Sched, bool GATHER, bool FP8 = false, bool BMAP16 = false>
DI void gemm_phase(LAS unsigned char* lds, const bf16_t* Abase, const Sched& S, const Epi& E, const LAS unsigned* tbl) {
    int tid = threadIdx.x; asm volatile("" : "+v"(tid));
    const int wid = __builtin_amdgcn_readfirstlane(tid >> 6), lane = tid & 63, wr = wid >> 2, wc = wid & 3, fr = lane & 15, fq = lane >> 4;
    constexpr int KB = FP8 ? K : 2 * K;
    constexpr int nt = KB / 128;
    unsigned voffB[2]; int Rr[2], Cc[2];
#pragma unroll
    for (int i = 0; i < 2; ++i) { int R, C; stage_rc(tid * 16 + i * 8192, R, C);
        const int Rb = BMAP16 ? (64 * (R >> 5) + 16 * ((R & 15) >> 2) + 4 * ((R >> 4) & 1) + (R & 3)) : ((R & ~31) + perm32(R & 31));
        voffB[i] = (unsigned)(Rb * KB + C * 2); Rr[i] = R; Cc[i] = C; }
    const size_t kstep = (size_t)(BK * 2);
    const size_t hstep = BMAP16 ? (size_t)8 * KB : (size_t)HALF * KB;
    const unsigned ldsw = (unsigned)wid * 1024u;
    const int aoff = lds_byte(wr * 64 + fr, fq * 8), boff = lds_byte(wc * 32 + fr, fq * 8);
#define PG8_SA(b, h) (((b) * 2 + (h)) * HTB)
#define PG8_SB(b, h) ((4 + (b) * 2 + (h)) * HTB)
#define PG8_STAGE2(bufoff, gbase, v0, v1) do { \
        __builtin_amdgcn_global_load_lds((const unsigned*)((const char*)(gbase) + (v0)), (LAS unsigned*)(lds + (bufoff) + ldsw), 16, 0, 0); \
        __builtin_amdgcn_global_load_lds((const unsigned*)((const char*)(gbase) + (v1)), (LAS unsigned*)(lds + (bufoff) + ldsw + 8192), 16, 0, 0); } while (0)
#define PG8_STAGEB(bufoff, gbase) PG8_STAGE2(bufoff, gbase, voffB[0], voffB[1])
#define PG8_RD16(off) (*(const LAS i32x4*)(lds + (off)))
#define PG8_LDA(dst, b, h) do { if constexpr (FP8) { _Pragma("unroll") for (int m = 0; m < 4; ++m) dst##8[m] = __builtin_shufflevector(PG8_RD16(PG8_SA(b, h) + aop + m * 2048), PG8_RD16(PG8_SA(b, h) + aop + m * 2048 + 1024), 0, 1, 2, 3, 4, 5, 6, 7); } \
        else { _Pragma("unroll") for (int m = 0; m < 4; ++m) _Pragma("unroll") for (int k = 0; k < 2; ++k) dst[m][k] = *(const LAS bf16x8*)(lds + PG8_SA(b, h) + aoff + m * 2048 + k * 1024); } } while (0)
#define PG8_LDB(dst, b, h) do { if constexpr (FP8) { _Pragma("unroll") for (int n = 0; n < 2; ++n) dst##8[n] = __builtin_shufflevector(PG8_RD16(PG8_SB(b, h) + bop + n * 2048), PG8_RD16(PG8_SB(b, h) + bop + n * 2048 + 1024), 0, 1, 2, 3, 4, 5, 6, 7); } \
        else { _Pragma("unroll") for (int n = 0; n < 2; ++n) _Pragma("unroll") for (int k = 0; k < 2; ++k) dst[n][k] = *(const LAS bf16x8*)(lds + PG8_SB(b, h) + boff + n * 2048 + k * 1024); } } while (0)
#define PG8_MMA(ai, bj, At, Bt) do { __builtin_amdgcn_s_setprio(1); \
        if constexpr (FP8) { _Pragma("unroll") for (int m = 0; m < 4; ++m) _Pragma("unroll") for (int n = 0; n < 2; ++n) \
            acc[ai][bj][m][n] = __builtin_amdgcn_mfma_scale_f32_16x16x128_f8f6f4(Bt##8[n], At##8[m], acc[ai][bj][m][n], 0, 0, 0, sclB, 0, sclA); } \
        else { _Pragma("unroll") for (int m = 0; m < 4; ++m) _Pragma("unroll") for (int n = 0; n < 2; ++n) _Pragma("unroll") for (int k = 0; k < 2; ++k) \
            acc[ai][bj][m][n] = __builtin_amdgcn_mfma_f32_16x16x32_bf16(Bt[n][k], At[m][k], acc[ai][bj][m][n], 0, 0, 0); } \
        __builtin_amdgcn_s_setprio(0); } while (0)
#define PG8_WAIT_V(n) asm volatile("s_waitcnt vmcnt(" #n ")" ::: "memory")
#define PG8_WAIT_L(n) asm volatile("s_waitcnt lgkmcnt(" #n ")" ::: "memory")
#define PG8_BAR __builtin_amdgcn_s_barrier()
#define PG8_SCHED __builtin_amdgcn_sched_barrier(0)
#define PG8_LOADVA(dst00, dst01, dst10, dst11, ui_) do { \
        if constexpr (GATHER) { const LAS unsigned* t_ = tbl + (ui_) * 256; \
            dst00 = t_[Rr[0]] + (unsigned)Cc[0] * 2u; dst01 = t_[Rr[1]] + (unsigned)Cc[1] * 2u; dst10 = t_[128 + Rr[0]] + (unsigned)Cc[0] * 2u; dst11 = t_[128 + Rr[1]] + (unsigned)Cc[1] * 2u; } \
        else { dst00 = (unsigned)(Rr[0] * KB + Cc[0] * 2); dst01 = (unsigned)(Rr[1] * KB + Cc[1] * 2); dst10 = (unsigned)((128 + Rr[0]) * KB + Cc[0] * 2); dst11 = (unsigned)((128 + Rr[1]) * KB + Cc[1] * 2); } } while (0)
    Unit cur, nxt; int ui = 0;
    if (!S.next(0, cur)) return;
    f32x4 acc[2][2][4][2];
    f32x4 bia[2][2];
    E.bias(cur, wc, fq, bia);
    u32x2 pre;
    E.pre_load(cur, tid, pre);
    bf16x8 At[4][2], B0[2][2], B1[2][2];
    i32x8 At8[4], B08[2], B18[2];
    const int sclA = S.scale_a(), sclB = S.scale_b();
    unsigned vA00, vA01, vA10, vA11;
    PG8_LOADVA(vA00, vA01, vA10, vA11, 0);
    const char* cA = GATHER ? (const char*)Abase : (const char*)Abase + (size_t)cur.arow0 * KB;
    const char* cB = S.bptr(cur);
#define PG8_KOFF(rot_, i_) ((size_t)(((i_) + (rot_)) & (nt - 1)) * kstep)
    { const size_t k0_ = PG8_KOFF(cur.rot, 0);
    PG8_STAGEB(PG8_SB(0, 0), cB + k0_); PG8_STAGEB(PG8_SB(0, 1), cB + hstep + k0_); PG8_STAGE2(PG8_SA(0, 0), cA + k0_, vA00, vA01); PG8_STAGE2(PG8_SA(0, 1), cA + k0_, vA10, vA11); }
#define PG8_ACC_INIT() do { _Pragma("unroll") for (int a = 0; a < 2; ++a) _Pragma("unroll") for (int b = 0; b < 2; ++b) _Pragma("unroll") for (int m = 0; m < 4; ++m) _Pragma("unroll") for (int n = 0; n < 2; ++n) acc[a][b][m][n] = bia[b][n]; } while (0)
    PG8_ACC_INIT();
    E.pre_store(pre, tid, lds + EPI_OFF);
    if (wr == 1) PG8_BAR;
    PG8_WAIT_V(2); PG8_BAR;
    { const size_t k1_ = PG8_KOFF(cur.rot, 1);
    PG8_STAGEB(PG8_SB(1, 0), cB + k1_); PG8_STAGE2(PG8_SA(1, 0), cA + k1_, vA00, vA01); PG8_STAGEB(PG8_SB(1, 1), cB + hstep + k1_); }
    PG8_WAIT_V(6); PG8_BAR;
    for (;;) {
        const bool has_next = S.next(ui + 1, nxt);
        const char* nA = cA; const char* nB = cB;
        if (has_next) { nB = S.bptr(nxt); if constexpr (!GATHER) nA = (const char*)Abase + (size_t)nxt.arow0 * KB; }
        const int nrot = has_next ? nxt.rot : cur.rot;
#pragma unroll 1
        for (int t = 0; t < nt; t += 2) {
            const bool last = (t == nt - 2);
            int aop = aoff, bop = boff; asm volatile("" : "+v"(aop), "+v"(bop));
            const size_t o1 = PG8_KOFF(cur.rot, t + 1), o2 = last ? PG8_KOFF(nrot, 0) : PG8_KOFF(cur.rot, t + 2), o3 = last ? PG8_KOFF(nrot, 1) : PG8_KOFF(cur.rot, t + 3);
            const char* a1 = cA + o1; const char* b1x = cB + o1;
            const char* a2 = (last ? nA : cA) + o2; const char* b2 = (last ? nB : cB) + o2;
            const char* a3 = (last ? nA : cA) + o3; const char* b3 = (last ? nB : cB) + o3;
            (void)b1x;
            PG8_LDB(B0, 0, 0); PG8_LDB(B1, 0, 1); PG8_SCHED; PG8_LDA(At, 0, 0); PG8_STAGE2(PG8_SA(1, 1), a1, vA10, vA11);
            if constexpr (GATHER) { if (last && has_next) PG8_LOADVA(vA00, vA01, vA10, vA11, ui + 1); }
            PG8_WAIT_V(8); PG8_WAIT_L(0); PG8_BAR; PG8_MMA(0, 0, At, B0); PG8_MMA(0, 1, At, B1); PG8_BAR; PG8_SCHED;
            PG8_LDA(At, 0, 1); PG8_STAGEB(PG8_SB(0, 0), b2); PG8_STAGEB(PG8_SB(0, 1), b2 + hstep); PG8_STAGE2(PG8_SA(0, 0), a2, vA00, vA01);
            PG8_WAIT_V(8); PG8_WAIT_L(0); PG8_BAR; PG8_MMA(1, 0, At, B0); PG8_MMA(1, 1, At, B1); PG8_BAR; PG8_SCHED;
            PG8_LDB(B0, 1, 0); PG8_LDB(B1, 1, 1); PG8_SCHED; PG8_LDA(At, 1, 0); PG8_STAGE2(PG8_SA(0, 1), a2, vA10, vA11);
            PG8_WAIT_V(8); PG8_WAIT_L(0); PG8_BAR; PG8_MMA(0, 0, At, B0); PG8_MMA(0, 1, At, B1); PG8_BAR; PG8_SCHED;
            PG8_LDA(At, 1, 1); PG8_STAGEB(PG8_SB(1, 0), b3); PG8_STAGEB(PG8_SB(1, 1), b3 + hstep); PG8_STAGE2(PG8_SA(1, 0), a3, vA00, vA01);
            PG8_WAIT_V(8); PG8_WAIT_L(0); PG8_BAR; PG8_MMA(1, 0, At, B0); PG8_MMA(1, 1, At, B1); PG8_BAR; PG8_SCHED;
        }
        if (wr == 0) PG8_BAR;
        if (has_next) { E.bias(nxt, wc, fq, bia); E.pre_load(nxt, tid, pre); }
        E(acc, cur, lds + EPI_OFF + (ui & 1) * 2048, wr, wc, fr, fq);
        if (!has_next) break;
        PG8_ACC_INIT();
        E.pre_store(pre, tid, lds + EPI_OFF + ((ui + 1) & 1) * 2048);
        cur = nxt; cA = nA; cB = nB; ++ui;
        if (wr == 1) PG8_BAR;
    }
    PG8_WAIT_V(0);
    PG8_BAR;
#undef PG8_SA
#undef PG8_SB
#undef PG8_STAGE2
#undef PG8_STAGEB
#undef PG8_LDA
#undef PG8_LDB
#undef PG8_MMA
#undef PG8_RD16
#undef PG8_WAIT_V
#undef PG8_WAIT_L
#undef PG8_BAR
#undef PG8_SCHED
#undef PG8_LOADVA
#undef PG8_KOFF
#undef PG8_ACC_INIT
}
}

typedef f32x4 AccT[2][2][4][2];

DI void store8_bf16(bf16_t* p, const float* v) {
    u32x4 w; w.x = cvt_pk_bf16(v[0], v[1]); w.y = cvt_pk_bf16(v[2], v[3]); w.z = cvt_pk_bf16(v[4], v[5]); w.w = cvt_pk_bf16(v[6], v[7]);
    *(u32x4*)p = w;
}
DI float dpp_shr_f(float x, int ctrl_sel);

struct EpiProj {
    bf16_t* proj; float* bcum; const int* pos; const float* bgk;
    DI void bias(const pg8::Unit& u, int wc, int fq, f32x4 (&bia)[2][2]) const {
        bia[0][0] = bia[0][1] = bia[1][0] = bia[1][1] = (f32x4){0.f, 0.f, 0.f, 0.f};
        if (u.pn == 14) { const float* b = bgk + wc * 32 + 8 * fq; bia[0][0] = *(const f32x4*)b; bia[0][1] = *(const f32x4*)(b + 4); bia[1][0] = *(const f32x4*)(b + 128); bia[1][1] = *(const f32x4*)(b + 132); }
    }
    DI void pre_load(const pg8::Unit& u, int tid, u32x2& pre) const { if (u.pn >= 6 && u.pn <= 9 && tid < 256) pre.x = (unsigned)pos[u.arow0 + tid]; }
    DI void pre_store(const u32x2& pre, int tid, LAS unsigned char* buf) const { if (tid < 256) *(LAS unsigned*)(buf + tid * 4) = pre.x; }
    DI void operator()(const AccT& acc, const pg8::Unit& u, const LAS unsigned char* ebuf, int wr, int wc, int fr, int fq) const {
        const int pn = u.pn, cl = wc * 32 + 8 * fq, row0 = u.arow0 + wr * 64 + fr;
        if (pn == 14) {
            const int lane = threadIdx.x & 63;
#pragma unroll
            for (int ai = 0; ai < 2; ++ai)
#pragma unroll
                for (int bj = 0; bj < 2; ++bj) {
                    float v[4][8];
#pragma unroll
                    for (int q = 0; q < 8; ++q) {
                        float carry = 0.f;
#pragma unroll
                        for (int m = 0; m < 4; ++m) {
                            float x = logsigmoidf_(acc[ai][bj][m][q >> 2][q & 3]) * 0.0625f;
                            x += __builtin_bit_cast(float, __builtin_amdgcn_update_dpp(0, __builtin_bit_cast(int, x), 0x111, 0xf, 0xf, true));
                            x += __builtin_bit_cast(float, __builtin_amdgcn_update_dpp(0, __builtin_bit_cast(int, x), 0x112, 0xf, 0xf, true));
                            x += __builtin_bit_cast(float, __builtin_amdgcn_update_dpp(0, __builtin_bit_cast(int, x), 0x114, 0xf, 0xf, true));
                            x += __builtin_bit_cast(float, __builtin_amdgcn_update_dpp(0, __builtin_bit_cast(int, x), 0x118, 0xf, 0xf, true));
                            x += carry;
                            v[m][q] = x;
                            carry = __shfl(x, lane | 15);
                        }
                    }
#pragma unroll
                    for (int m = 0; m < 4; ++m) {
                        const int row = row0 + ai * 128 + m * 16;
                        float* p = bcum + (size_t)row * 256 + bj * 128 + cl;
                        *(f32x4*)p = (f32x4){v[m][0], v[m][1], v[m][2], v[m][3]};
                        *(f32x4*)(p + 4) = (f32x4){v[m][4], v[m][5], v[m][6], v[m][7]};
                    }
                    asm volatile("" ::: "memory");
                }
        } else if (pn >= 6 && pn <= 9) {
            float inv[8];
#pragma unroll
            for (int q = 0; q < 8; ++q) inv[q] = exp2f(-(float)((cl + q) & 63) * 0.20762050593046014f);
            const int hh = cl >> 6;
            const float sc = (pn >= 8) ? 0.08838834764831845f : 1.0f;
            int pv[8];
#pragma unroll
            for (int i = 0; i < 8; ++i) pv[i] = *(const LAS int*)(ebuf + (wr * 64 + fr + (i >> 2) * 128 + (i & 3) * 16) * 4);
#pragma unroll
            for (int ai = 0; ai < 2; ++ai)
#pragma unroll
                for (int m = 0; m < 4; ++m) {
                    const int row = row0 + ai * 128 + m * 16;
                    const float p = (float)pv[ai * 4 + m];
                    float o1[8], o2[8];
#pragma unroll
                    for (int q = 0; q < 8; ++q) {
                        const float ang = p * inv[q];
                        const float t = rintf(ang * 0.15915493667125702f);
                        const float f = fmaf(ang, 0.15915493667125702f, -t) + ang * 6.4206382432985265e-09f;
                        const float sn = __builtin_amdgcn_sinf(f), cs = __builtin_amdgcn_cosf(f);
                        const float x1 = acc[ai][0][m][q >> 2][q & 3], x2 = acc[ai][1][m][q >> 2][q & 3];
                        o1[q] = (x1 * cs - x2 * sn) * sc; o2[q] = (x1 * sn + x2 * cs) * sc;
                    }
                    bf16_t* dst = proj + (size_t)row * NPROJ + pn * 256 + hh * 128 + (cl & 63);
                    store8_bf16(dst, o1); store8_bf16(dst + 64, o2);
                }
        } else {
            const bool silu = (pn == 4 || pn == 5 || pn == 12 || pn == 13);
#pragma unroll
            for (int ai = 0; ai < 2; ++ai)
#pragma unroll
                for (int m = 0; m < 4; ++m) {
                    const int row = row0 + ai * 128 + m * 16;
#pragma unroll
                    for (int bj = 0; bj < 2; ++bj) {
                        f32x4 v0 = acc[ai][bj][m][0], v1 = acc[ai][bj][m][1];
                        if (silu) {
                            const f32x4 t0 = v0 * (-1.4426950408889634f), t1 = v1 * (-1.4426950408889634f);
                            f32x4 d0, d1;
#pragma unroll
                            for (int i = 0; i < 4; ++i) { d0[i] = __builtin_amdgcn_exp2f(t0[i]); d1[i] = __builtin_amdgcn_exp2f(t1[i]); }
                            d0 = d0 + 1.0f; d1 = d1 + 1.0f;
#pragma unroll
                            for (int i = 0; i < 4; ++i) { d0[i] = __builtin_amdgcn_rcpf(d0[i]); d1[i] = __builtin_amdgcn_rcpf(d1[i]); }
                            v0 = v0 * d0; v1 = v1 * d1;
                        } else if (pn == 0) { v0 = v0 * 0.125f; v1 = v1 * 0.125f; }
                        u32x4 w; w.x = cvt_pk_bf16(v0[0], v0[1]); w.y = cvt_pk_bf16(v0[2], v0[3]); w.z = cvt_pk_bf16(v1[0], v1[1]); w.w = cvt_pk_bf16(v1[2], v1[3]);
                        *(u32x4*)(proj + (size_t)row * NPROJ + pn * 256 + bj * 128 + cl) = w;
                    }
                }
        }
    }
};

struct EpiRes1 {
    const float* x; const float* mod; float* x1;
    DI void bias(const pg8::Unit&, int, int, f32x4 (&bia)[2][2]) const { bia[0][0] = bia[0][1] = bia[1][0] = bia[1][1] = (f32x4){0.f, 0.f, 0.f, 0.f}; }
    DI void pre_load(const pg8::Unit&, int, u32x2&) const {}
    DI void pre_store(const u32x2&, int, LAS unsigned char*) const {}
    DI void operator()(const AccT& acc, const pg8::Unit& u, const LAS unsigned char* ebuf, int wr, int wc, int fr, int fq) const {
        const int cl = wc * 64 + 16 * fq, row0 = u.arow0 + wr * 64 + fr;
        const int b = u.arow0 >= SEQ ? 1 : 0;
        const float* g = mod + b * 6144 + 2048 + u.pn * 256 + cl;
        f32x4 gv[2][2];
#pragma unroll
        for (int bj = 0; bj < 2; ++bj) { gv[bj][0] = *(const f32x4*)(g + 8 * bj); gv[bj][1] = *(const f32x4*)(g + 8 * bj + 4); }
        f32x4 xa[4], xb[4];
        const size_t off0 = (size_t)row0 * D + u.pn * 256 + cl;
#define RES_LOAD(X_, i_) do { const size_t o_ = off0 + (size_t)(((i_) >> 2) * 128 + ((i_) & 3) * 16) * D; \
        X_[0] = *(const f32x4*)(x + o_); X_[1] = *(const f32x4*)(x + o_ + 4); X_[2] = *(const f32x4*)(x + o_ + 8); X_[3] = *(const f32x4*)(x + o_ + 12); } while (0)
#if X1_BF16
#define RES_STORE(X_, i_) do { const size_t o_ = off0 + (size_t)(((i_) >> 2) * 128 + ((i_) & 3) * 16) * D; \
        const f32x4 r0_ = X_[0] + gv[0][0] * acc[(i_) >> 2][0][(i_) & 3][0], r1_ = X_[1] + gv[0][1] * acc[(i_) >> 2][0][(i_) & 3][1]; \
        const f32x4 r2_ = X_[2] + gv[1][0] * acc[(i_) >> 2][1][(i_) & 3][0], r3_ = X_[3] + gv[1][1] * acc[(i_) >> 2][1][(i_) & 3][1]; \
        u32x4 w0_, w1_; w0_.x = cvt_pk_bf16(r0_[0], r0_[1]); w0_.y = cvt_pk_bf16(r0_[2], r0_[3]); w0_.z = cvt_pk_bf16(r1_[0], r1_[1]); w0_.w = cvt_pk_bf16(r1_[2], r1_[3]); \
        w1_.x = cvt_pk_bf16(r2_[0], r2_[1]); w1_.y = cvt_pk_bf16(r2_[2], r2_[3]); w1_.z = cvt_pk_bf16(r3_[0], r3_[1]); w1_.w = cvt_pk_bf16(r3_[2], r3_[3]); \
        bf16_t* xp_ = (bf16_t*)x1 + o_; *(u32x4*)xp_ = w0_; *(u32x4*)(xp_ + 8) = w1_; } while (0)
#else
#define RES_STORE(X_, i_) do { const size_t o_ = off0 + (size_t)(((i_) >> 2) * 128 + ((i_) & 3) * 16) * D; \
        *(f32x4*)(x1 + o_) = X_[0] + gv[0][0] * acc[(i_) >> 2][0][(i_) & 3][0]; *(f32x4*)(x1 + o_ + 4) = X_[1] + gv[0][1] * acc[(i_) >> 2][0][(i_) & 3][1]; \
        *(f32x4*)(x1 + o_ + 8) = X_[2] + gv[1][0] * acc[(i_) >> 2][1][(i_) & 3][0]; *(f32x4*)(x1 + o_ + 12) = X_[3] + gv[1][1] * acc[(i_) >> 2][1][(i_) & 3][1]; } while (0)
#endif
        RES_LOAD(xa, 0);
        RES_LOAD(xb, 1); RES_STORE(xa, 0);
        RES_LOAD(xa, 2); RES_STORE(xb, 1);
        RES_LOAD(xb, 3); RES_STORE(xa, 2);
        RES_LOAD(xa, 4); RES_STORE(xb, 3);
        RES_LOAD(xb, 5); RES_STORE(xa, 4);
        RES_LOAD(xa, 6); RES_STORE(xb, 5);
        RES_LOAD(xb, 7); RES_STORE(xa, 6);
        RES_STORE(xb, 7);
#undef RES_LOAD
#undef RES_STORE
    }
};

struct EpiGU {
    const float* bgu; bf16_t* act;
    DI void pre_load(const pg8::Unit&, int, u32x2&) const {}
    DI void pre_store(const u32x2&, int, LAS unsigned char*) const {}
    DI void bias(const pg8::Unit& u, int wc, int fq, f32x4 (&bia)[2][2]) const {
        const float* bg = bgu + (size_t)u.e * 2048 + u.pn * 128 + wc * 32 + 8 * fq;
        bia[0][0] = *(const f32x4*)bg; bia[0][1] = *(const f32x4*)(bg + 4); bia[1][0] = *(const f32x4*)(bg + 1024); bia[1][1] = *(const f32x4*)(bg + 1028);
    }
    DI void operator()(const AccT& acc, const pg8::Unit& u, const LAS unsigned char* ebuf, int wr, int wc, int fr, int fq) const {
        const int cl = wc * 32 + 8 * fq;
        constexpr float OS = MOE_FP8 ? A8_SCALE : 1.0f;
#pragma unroll
        for (int ai = 0; ai < 2; ++ai)
#pragma unroll
            for (int m = 0; m < 4; ++m) {
                const int r = ai * 128 + wr * 64 + m * 16 + fr;
                if (r < u.rows) {
                    f32x2 o[4];
#pragma unroll
                    for (int q = 0; q < 4; ++q) {
                        const f32x4 ag = acc[ai][0][m][q >> 1], au = acc[ai][1][m][q >> 1];
                        f32x2 gt = (q & 1) ? (f32x2){ag[2], ag[3]} : (f32x2){ag[0], ag[1]};
                        f32x2 up = (q & 1) ? (f32x2){au[2], au[3]} : (f32x2){au[0], au[1]};
                        gt.x = fminf(gt.x, 7.0f); gt.y = fminf(gt.y, 7.0f);
                        up.x = __builtin_amdgcn_fmed3f(up.x, -7.0f, 7.0f); up.y = __builtin_amdgcn_fmed3f(up.y, -7.0f, 7.0f);
                        const f32x2 t = gt * (-2.4554669595930157f);
                        f32x2 d; d.x = __builtin_amdgcn_exp2f(t.x); d.y = __builtin_amdgcn_exp2f(t.y);
                        d = d + 1.0f;
                        f32x2 rc; rc.x = __builtin_amdgcn_rcpf(d.x); rc.y = __builtin_amdgcn_rcpf(d.y);
                        o[q] = (up * OS + OS) * (gt * rc);
                    }
#if MOE_FP8
                    u32x2 w8; w8.x = pk4_fp8_nc(o[0].x, o[0].y, o[1].x, o[1].y); w8.y = pk4_fp8_nc(o[2].x, o[2].y, o[3].x, o[3].y);
                    *(u32x2*)((unsigned char*)act + (size_t)(u.arow0 + r) * D + u.pn * 128 + cl) = w8;
#else
                    const float ov[8] = {o[0].x, o[0].y, o[1].x, o[1].y, o[2].x, o[2].y, o[3].x, o[3].y};
                    store8_bf16(act + (size_t)(u.arow0 + r) * D + u.pn * 128 + cl, ov);
#endif
                }
            }
    }
};

struct EpiDown {
    const float* bd; const u32x2* perm; bf16_t* Y;
    DI void pre_load(const pg8::Unit& u, int tid, u32x2& pre) const { if (tid < 256) pre = perm[u.prow0 + (tid < u.rows ? tid : 0)]; }
    DI void pre_store(const u32x2& pre, int tid, LAS unsigned char* buf) const { if (tid < 256) *(LAS u32x2*)(buf + tid * 8) = pre; }
    DI void bias(const pg8::Unit& u, int wc, int fq, f32x4 (&bia)[2][2]) const {
        const float* b = bd + (size_t)u.e * D + u.pn * 256 + wc * 64 + 16 * fq;
        bia[0][0] = *(const f32x4*)b; bia[0][1] = *(const f32x4*)(b + 4); bia[1][0] = *(const f32x4*)(b + 8); bia[1][1] = *(const f32x4*)(b + 12);
    }
    DI void operator()(const AccT& acc, const pg8::Unit& u, const LAS unsigned char* ebuf, int wr, int wc, int fr, int fq) const {
        asm volatile("" : "+v"(fr), "+v"(fq));
        const int cl = wc * 64 + 16 * fq;
#pragma unroll
        for (int ai = 0; ai < 2; ++ai) {
            u32x2 rec[4];
#pragma unroll
            for (int m = 0; m < 4; ++m) { const int r = ai * 128 + wr * 64 + m * 16 + fr; rec[m] = *(const LAS u32x2*)(ebuf + r * 8); }
#pragma unroll
            for (int m = 0; m < 4; ++m) {
                const int r = ai * 128 + wr * 64 + m * 16 + fr;
                if (r < u.rows) {
                    const unsigned wbits = rec[m].y; const float wgt = __uint_as_float(wbits);
#if Y_FP8
                    const float wg8 = wgt * Y8_SCALE;
                    const f32x4 v00 = acc[ai][0][m][0] * wg8, v01 = acc[ai][0][m][1] * wg8, v10 = acc[ai][1][m][0] * wg8, v11 = acc[ai][1][m][1] * wg8;
                    u32x4 w; w.x = pk4_fp8(v00[0], v00[1], v00[2], v00[3]); w.y = pk4_fp8(v01[0], v01[1], v01[2], v01[3]); w.z = pk4_fp8(v10[0], v10[1], v10[2], v10[3]); w.w = pk4_fp8(v11[0], v11[1], v11[2], v11[3]);
                    *(u32x4*)((unsigned char*)Y + (size_t)rec[m].x * D + u.pn * 256 + cl) = w;
#else
                    const f32x4 v00 = acc[ai][0][m][0] * wgt, v01 = acc[ai][0][m][1] * wgt, v10 = acc[ai][1][m][0] * wgt, v11 = acc[ai][1][m][1] * wgt;
                    u32x4 w0, w1; w0.x = cvt_pk_bf16(v00[0], v00[1]); w0.y = cvt_pk_bf16(v00[2], v00[3]); w0.z = cvt_pk_bf16(v01[0], v01[1]); w0.w = cvt_pk_bf16(v01[2], v01[3]);
                    w1.x = cvt_pk_bf16(v10[0], v10[1]); w1.y = cvt_pk_bf16(v10[2], v10[3]); w1.z = cvt_pk_bf16(v11[0], v11[1]); w1.w = cvt_pk_bf16(v11[2], v11[3]);
                    bf16_t* yp = Y + (size_t)rec[m].x * D + u.pn * 256 + cl; *(u32x4*)yp = w0; *(u32x4*)(yp + 8) = w1;
#endif
                }
            }
            asm volatile("" ::: "memory");
        }
    }
};

#define XB_TMO      128
#define XB_XCNT(j)  (256  + 64 * (j))
#define XB_XSUB(j)  (1280 + 64 * (j))
#define XB_XGEN(j)  (2304 + 64 * (j))
#define XB_TOP      3328
#define XB_TOPGEN   3392
#define XCD_BAR_WORDS 3456
#define XB_SPIN_CAP (1u << 22)
DI unsigned xb_ld(unsigned* p)              { return __hip_atomic_load(p, __ATOMIC_RELAXED, __HIP_MEMORY_SCOPE_AGENT); }
DI unsigned xb_add(unsigned* p, unsigned v) { return __hip_atomic_fetch_add(p, v, __ATOMIC_RELAXED, __HIP_MEMORY_SCOPE_AGENT); }
DI unsigned xb_xcc_id() { return (unsigned)__builtin_amdgcn_s_getreg((3 << 11) | 20) & 0xFu; }
#define XB_SPIN(cond, bar) do { unsigned _sp = 0; while (cond) { __builtin_amdgcn_s_sleep(1); \
    if ((++_sp & 255u) == 0u) { if (xb_ld(&(bar)[XB_TMO])) break; if (_sp > XB_SPIN_CAP) { atomicAdd(&(bar)[XB_TMO], 1u); break; } } } } while (0)
struct XcdBarrier { unsigned* bar; unsigned x; volatile LAS unsigned* st; };
DI XcdBarrier xcd_barrier_post(unsigned* bar, volatile LAS unsigned* st) {
    XcdBarrier b; b.bar = bar; b.x = xb_xcc_id(); b.st = st;
    if (threadIdx.x == 0) (void)xb_add(&bar[XB_XCNT(b.x)], 1u);
    return b;
}
DI void xcd_barrier_complete(unsigned* bar, unsigned x, unsigned& nloc, unsigned& nx) {
    const unsigned G = gridDim.x * gridDim.y * gridDim.z;
    unsigned sum, cnt, mine, sp = 0u;
    for (;;) {
        sum = 0u; cnt = 0u; mine = 0u;
#pragma unroll
        for (unsigned j = 0; j < 16; ++j) { const unsigned c = xb_ld(&bar[XB_XCNT(j)]); sum += c; cnt += (c > 0u) ? 1u : 0u; mine = (j == x) ? c : mine; }
        if (sum == G) break;
        __builtin_amdgcn_s_sleep(1);
        if ((++sp & 255u) == 0u) { if (xb_ld(&bar[XB_TMO])) break; if (sp > XB_SPIN_CAP) { atomicAdd(&bar[XB_TMO], 1u); break; } }
    }
    nloc = mine > 0u ? mine : 1u; nx = cnt > 0u ? cnt : 1u;
}
DI void xcd_barrier(const XcdBarrier& b) {
    asm volatile("s_waitcnt vmcnt(0)" ::: "memory");
    __syncthreads();
    if (threadIdx.x == 0) {
        unsigned* bar = b.bar;
        __builtin_amdgcn_s_waitcnt(0);
        unsigned nloc = b.st[0], nx = b.st[1];
        if (nloc == 0u) { xcd_barrier_complete(bar, b.x, nloc, nx); b.st[0] = nloc; b.st[1] = nx; }
        const unsigned old = xb_add(&bar[XB_XSUB(b.x)], 1u);
        const unsigned gen = old / nloc;
        if (old + 1u == (gen + 1u) * nloc) {
            __builtin_amdgcn_fence(__ATOMIC_RELEASE, "agent");
            asm volatile("s_waitcnt vmcnt(0)" ::: "memory");
            const unsigned og = xb_add(&bar[XB_TOP], 1u);
            const unsigned tg = og / nx;
            if (og + 1u == (tg + 1u) * nx) xb_add(&bar[XB_TOPGEN], 1u);
            else XB_SPIN(xb_ld(&bar[XB_TOPGEN]) == tg, bar);
            xb_add(&bar[XB_XGEN(b.x)], 1u);
            __builtin_amdgcn_fence(__ATOMIC_ACQUIRE, "agent");
            asm volatile("s_waitcnt vmcnt(0)" ::: "memory");
        } else {
            XB_SPIN(xb_ld(&bar[XB_XGEN(b.x)]) == gen, bar);
            __builtin_amdgcn_fence(__ATOMIC_ACQUIRE, "agent");
            asm volatile("s_waitcnt vmcnt(0)" ::: "memory");
        }
    }
    __syncthreads();
}

struct Args { const void* in[20]; float* out; unsigned char* ws; int ph_lo, ph_hi; };

struct Frame {
    LAS unsigned char* lds;
    int tid, lane, wave, G, bid;
    const float *x, *c, *w_ada, *b_ada, *norm1, *w_in, *w_gk2, *b_gk, *gla_onorm, *ret_onorm, *w_out, *norm2, *w_router, *b_router, *w_gu, *b_gu, *w_down, *b_down, *norm_f;
    const int* positions;
    float* out; unsigned char* ws;
    unsigned* ctl; float* mod; bf16_t *win_t, *wout_t, *wgu_t, *wd_t, *hbuf, *obuf, *proj, *act, *Y; float *x1, *bcum, *pw; u32x2* perm;
};

DI void tr_item(const float* W, int ldw, int k0, int src_c0, bf16_t* dst, LAS float* scr, int lane) {
    { float t[32]; const float* wp = W + (size_t)(k0 + (lane >> 5)) * ldw + src_c0 + (lane & 31);
#pragma unroll
      for (int i = 0; i < 32; ++i) t[i] = wp[(size_t)(2 * i) * ldw];
#pragma unroll
      for (int i = 0; i < 32; ++i) scr[(2 * i + (lane >> 5)) * 33 + (lane & 31)] = t[i]; }
    LDS_WAIT(); asm volatile("" ::: "memory");
    const int c = lane & 7;
#pragma unroll
    for (int j = 0; j < 4; ++j) { const int n = (lane >> 3) + 8 * j; const LAS float* s = scr + (8 * c) * 33 + n;
        u32x4 o; o.x = pk2(s[0 * 33], s[1 * 33]); o.y = pk2(s[2 * 33], s[3 * 33]); o.z = pk2(s[4 * 33], s[5 * 33]); o.w = pk2(s[6 * 33], s[7 * 33]);
        *(u32x4*)(dst + (size_t)n * D + k0 + 8 * c) = o; }
    LDS_WAIT(); asm volatile("" ::: "memory");
}

DI void tr_item8(const float* W, int ldw, int k0, int src_c0, unsigned char* dst, LAS float* scr, int lane) {
    { float t[32]; const float* wp = W + (size_t)(k0 + (lane >> 5)) * ldw + src_c0 + (lane & 31);
#pragma unroll
      for (int i = 0; i < 32; ++i) t[i] = wp[(size_t)(2 * i) * ldw];
#pragma unroll
      for (int i = 0; i < 32; ++i) scr[(2 * i + (lane >> 5)) * 33 + (lane & 31)] = t[i]; }
    LDS_WAIT(); asm volatile("" ::: "memory");
    const int c = lane & 3;
#pragma unroll
    for (int j = 0; j < 2; ++j) { const int n = (lane >> 2) + 16 * j; const LAS float* s = scr + (16 * c) * 33 + n;
        u32x4 o;
        o.x = pk4_fp8(s[0 * 33] * W8_SCALE, s[1 * 33] * W8_SCALE, s[2 * 33] * W8_SCALE, s[3 * 33] * W8_SCALE);
        o.y = pk4_fp8(s[4 * 33] * W8_SCALE, s[5 * 33] * W8_SCALE, s[6 * 33] * W8_SCALE, s[7 * 33] * W8_SCALE);
        o.z = pk4_fp8(s[8 * 33] * W8_SCALE, s[9 * 33] * W8_SCALE, s[10 * 33] * W8_SCALE, s[11 * 33] * W8_SCALE);
        o.w = pk4_fp8(s[12 * 33] * W8_SCALE, s[13 * 33] * W8_SCALE, s[14 * 33] * W8_SCALE, s[15 * 33] * W8_SCALE);
        *(u32x4*)(dst + (size_t)n * D + k0 + 16 * c) = o; }
    LDS_WAIT(); asm volatile("" ::: "memory");
}

struct TrDesc { const float* W; int ldw, k0, src; unsigned char* dst; int fp8; };
constexpr int TR_I_IN = 112 * 16, TR_I_OUT = 32 * 16, TR_I_GU = 64 * 16, TR_I_D = 32 * 16, TR_NITEMS = TR_I_IN + TR_I_OUT + NE * TR_I_GU + NE * TR_I_D;
DI bool tr_decode(Frame& F, int it, TrDesc& d) {
    if (it >= TR_NITEMS) return false;
    int r = it;
    if (r < TR_I_IN) {
        const int kb = r / 112, nb = r % 112, n0 = nb * 32, pn = n0 >> 8, cl0 = n0 & 255;
        int src;
        if (pn < 6) src = n0;
        else if (pn <= 9) { const int bj = cl0 >> 7, o0 = cl0 & 127; src = pn * 256 + 16 + 128 * (o0 >> 6) + 64 * bj + (o0 & 63); }
        else src = n0 + 16;
        d.W = F.w_in; d.ldw = MIX_IN; d.k0 = kb * 64; d.src = src; d.dst = (unsigned char*)(F.win_t + (size_t)n0 * D); d.fp8 = 0; return true;
    }
    r -= TR_I_IN;
    if (r < TR_I_OUT) { const int kb = r / 32, nb = r % 32; d.W = F.w_out; d.ldw = D; d.k0 = kb * 64; d.src = nb * 32; d.dst = (unsigned char*)F.wout_t + (size_t)nb * 32 * D * (O_FP8 ? 1 : 2); d.fp8 = O_FP8; return true; }
    r -= TR_I_OUT;
    if (r < NE * TR_I_GU) {
        const int e = r / TR_I_GU, rr = r % TR_I_GU, kb = rr / 64, nb = rr % 64, n0 = nb * 32, pn = n0 >> 8, cl0 = n0 & 255, bj = cl0 >> 7, o0 = cl0 & 127;
        d.W = F.w_gu + (size_t)e * D * 2048; d.ldw = 2048; d.k0 = kb * 64; d.src = 1024 * bj + 128 * pn + o0; d.fp8 = MOE_FP8;
        d.dst = (unsigned char*)F.wgu_t + ((size_t)e * 2048 + n0) * D * (MOE_FP8 ? 1 : 2); return true;
    }
    r -= NE * TR_I_GU;
    { const int e = r / TR_I_D, rr = r % TR_I_D, kb = rr / 32, nb = rr % 32;
      d.W = F.w_down + (size_t)e * D * D; d.ldw = D; d.k0 = kb * 64; d.src = nb * 32; d.fp8 = MOE_FP8;
      d.dst = (unsigned char*)F.wd_t + ((size_t)e * D + nb * 32) * D * (MOE_FP8 ? 1 : 2); return true; }
}
DI void tr_load(float (&t)[32], const TrDesc& d, int lane) {
    const float* wp = d.W + (size_t)(d.k0 + (lane >> 5)) * d.ldw + d.src + (lane & 31);
#pragma unroll
    for (int i = 0; i < 32; ++i) t[i] = __builtin_nontemporal_load(wp + (size_t)(2 * i) * d.ldw);
}
DI void tr_finish(const float (&t)[32], const TrDesc& d, LAS float* scr, int lane) {
#pragma unroll
    for (int i = 0; i < 32; ++i) scr[(2 * i + (lane >> 5)) * 33 + (lane & 31)] = t[i];
    LDS_WAIT(); asm volatile("" ::: "memory");
    if (d.fp8) {
        const int c = lane & 3;
#pragma unroll
        for (int j = 0; j < 2; ++j) { const int n = (lane >> 2) + 16 * j; const LAS float* s = scr + (16 * c) * 33 + n;
            u32x4 o;
            o.x = pk4_fp8(s[0 * 33] * W8_SCALE, s[1 * 33] * W8_SCALE, s[2 * 33] * W8_SCALE, s[3 * 33] * W8_SCALE);
            o.y = pk4_fp8(s[4 * 33] * W8_SCALE, s[5 * 33] * W8_SCALE, s[6 * 33] * W8_SCALE, s[7 * 33] * W8_SCALE);
            o.z = pk4_fp8(s[8 * 33] * W8_SCALE, s[9 * 33] * W8_SCALE, s[10 * 33] * W8_SCALE, s[11 * 33] * W8_SCALE);
            o.w = pk4_fp8(s[12 * 33] * W8_SCALE, s[13 * 33] * W8_SCALE, s[14 * 33] * W8_SCALE, s[15 * 33] * W8_SCALE);
            *(u32x4*)(d.dst + (size_t)n * D + d.k0 + 16 * c) = o; }
    } else {
        const int c = lane & 7;
#pragma unroll
        for (int j = 0; j < 4; ++j) { const int n = (lane >> 3) + 8 * j; const LAS float* s = scr + (8 * c) * 33 + n;
            u32x4 o; o.x = pk2(s[0 * 33], s[1 * 33]); o.y = pk2(s[2 * 33], s[3 * 33]); o.z = pk2(s[4 * 33], s[5 * 33]); o.w = pk2(s[6 * 33], s[7 * 33]);
            *(u32x4*)((bf16_t*)d.dst + (size_t)n * D + d.k0 + 8 * c) = o; }
    }
    LDS_WAIT(); asm volatile("" ::: "memory");
}

constexpr int TR_SPLIT1 = TR_NITEMS - 9216 - 7168, TR_SPLIT2 = TR_NITEMS - 7168;
DI void tr_range(Frame& F, LAS float* scr, int first, int last, int widx, int nw) {
    int it = first + widx; TrDesc d0, d1; float t0[32], t1[32];
    bool v0 = it < last && tr_decode(F, it, d0);
    if (v0) tr_load(t0, d0, F.lane);
    while (v0) {
        const bool v1 = (it + nw) < last && tr_decode(F, it + nw, d1);
        if (v1) tr_load(t1, d1, F.lane);
        tr_finish(t0, d0, scr, F.lane);
        if (!v1) break;
        it += 2 * nw; v0 = it < last && tr_decode(F, it, d0);
        if (v0) tr_load(t0, d0, F.lane);
        tr_finish(t1, d1, scr, F.lane);
    }
}

DI void p0_prep(Frame& F) {
    { int t_ = threadIdx.x; asm volatile("" : "+v"(t_)); F.tid = t_; F.lane = t_ & 63; }
    LAS float* red = (LAS float*)F.lds;
    LAS float* sc_ = (LAS float*)(F.lds + 4096);
    for (int i = F.tid; i < 2 * D; i += NTHREADS) { const float cv = F.c[i]; sc_[i] = cv * sigmoidf_(cv); }
    __syncthreads();
    for (int it = F.bid * NTHREADS + F.tid; it < 256 * 128; it += F.G * NTHREADS) {
        const int c = it & 255, k8 = it >> 8;
        float w2[16];
#pragma unroll
        for (int j = 0; j < 16; ++j) w2[j] = F.w_gk2[j * 256 + c];
        float o[8];
#pragma unroll
        for (int kk = 0; kk < 8; ++kk) {
            const float* wi = F.w_in + (size_t)(k8 * 8 + kk) * MIX_IN + 1536; float s = 0.f;
#pragma unroll
            for (int j = 0; j < 16; ++j) s += wi[j] * w2[j];
            o[kk] = s;
        }
        u32x4 w; w.x = pk2(o[0], o[1]); w.y = pk2(o[2], o[3]); w.z = pk2(o[4], o[5]); w.w = pk2(o[6], o[7]);
        *(u32x4*)(F.win_t + (size_t)(3584 + c) * D + k8 * 8) = w;
    }
    LAS float* scr = (LAS float*)(F.lds + 16384 + F.wave * 8704);
    const int tr_last = F.G == 256 ? TR_SPLIT1 : TR_NITEMS, tr_nw = F.G * NWAVES;
    int it = F.bid * NWAVES + F.wave; TrDesc d0, d1; float t0[32], t1[32];
    bool v0 = it < tr_last && tr_decode(F, it, d0);
    if (v0) tr_load(t0, d0, F.lane);
    for (int cb = F.bid; cb < 256; cb += F.G) {
        const bool act = F.tid < 504;
        const int col = F.tid % 24, ks = F.tid / 24; float a0 = 0.f, a1 = 0.f;
        const float* wp = F.w_ada + (size_t)ks * 6144 + cb * 24 + col;
#define P0_ISSUE(k0_) _Pragma("unroll") for (int j = 0; j < 7; ++j) { const int k = ks + 21 * ((k0_) + j); w[j] = (act && k < D) ? wp[(size_t)(21 * ((k0_) + j)) * 6144] : 0.f; }
#define P0_USE(k0_) _Pragma("unroll") for (int j = 0; j < 7; ++j) { const int k = ks + 21 * ((k0_) + j); if (act && k < D) { a0 += sc_[k] * w[j]; a1 += sc_[D + k] * w[j]; } }
#pragma unroll 1
        for (int k0 = 0; k0 < 56; k0 += 14) {
            float w[7];
            P0_ISSUE(k0);
            bool v1 = false;
            if (v0) { v1 = (it + tr_nw) < tr_last && tr_decode(F, it + tr_nw, d1); if (v1) tr_load(t1, d1, F.lane); tr_finish(t0, d0, scr, F.lane); }
            P0_USE(k0);
            P0_ISSUE(k0 + 7);
            v0 = false;
            if (v1) { it += 2 * tr_nw; v0 = it < tr_last && tr_decode(F, it, d0); if (v0) tr_load(t0, d0, F.lane); tr_finish(t1, d1, scr, F.lane); }
            P0_USE(k0 + 7);
        }
#undef P0_ISSUE
#undef P0_USE
        if (act) { red[ks * 24 + col] = a0; red[(21 + ks) * 24 + col] = a1; }
        __syncthreads();
        if (F.tid < 48) {
            const int b = F.tid / 24, c2 = F.tid % 24; float s = F.b_ada[cb * 24 + c2];
            for (int q = 0; q < 21; ++q) s += red[(b * 21 + q) * 24 + c2];
            F.mod[b * 6144 + cb * 24 + c2] = s;
        }
        __syncthreads();
    }
    while (v0) {
        const bool v1 = (it + tr_nw) < tr_last && tr_decode(F, it + tr_nw, d1);
        if (v1) tr_load(t1, d1, F.lane);
        tr_finish(t0, d0, scr, F.lane);
        if (!v1) break;
        it += 2 * tr_nw; v0 = it < tr_last && tr_decode(F, it, d0);
        if (v0) tr_load(t0, d0, F.lane);
        tr_finish(t1, d1, scr, F.lane);
    }
}

DI void p1_h1(Frame& F) {
    { int t_ = threadIdx.x; asm volatile("" : "+v"(t_)); F.tid = t_; F.lane = t_ & 63; }
    const int gw = F.bid * NWAVES + F.wave, NGW = F.G * NWAVES;
    f32x4 v[4], vn[4];
    if (gw < M) { const f32x4* xr = (const f32x4*)(F.x + (size_t)gw * D) + F.lane;
#pragma unroll
        for (int j = 0; j < 4; ++j) v[j] = xr[64 * j]; }
    for (int m = gw; m < M; m += NGW) {
        const int b = m >= SEQ;
        if (m + NGW < M) { const f32x4* xn = (const f32x4*)(F.x + (size_t)(m + NGW) * D) + F.lane;
#pragma unroll
            for (int j = 0; j < 4; ++j) vn[j] = xn[64 * j]; }
        const f32x4* nr = (const f32x4*)F.norm1 + F.lane;
        const f32x4* shr = (const f32x4*)(F.mod + b * 6144) + F.lane;
        const f32x4* scr = (const f32x4*)(F.mod + b * 6144 + 1024) + F.lane;
        float s = 0.f;
#pragma unroll
        for (int j = 0; j < 4; ++j) s += (v[j].x * v[j].x + v[j].y * v[j].y) + (v[j].z * v[j].z + v[j].w * v[j].w);
        const float rstd = __builtin_amdgcn_rsqf(wave_sum(s) * (1.0f / D) + EPS);
        u32x2* o8 = (u32x2*)(F.hbuf + (size_t)m * D) + F.lane;
#pragma unroll
        for (int j = 0; j < 4; ++j) {
            const f32x4 w = nr[64 * j], sc = scr[64 * j], sh = shr[64 * j];
            const f32x4 h = v[j] * rstd * w * (sc + 1.0f) + sh;
            u32x2 p; p.x = pk2(h.x, h.y); p.y = pk2(h.z, h.w); o8[64 * j] = p;
        }
#pragma unroll
        for (int j = 0; j < 4; ++j) v[j] = vn[j];
    }
}

template <int DK, bool GLA>
DI void la_naive_stream(Frame& F, int b, int h) {
    LAS float* qs = (LAS float*)F.lds;
    LAS float* ks = qs + 64 * DK;
    LAS float* as = ks + 64 * DK;
    LAS float* vs = (LAS float*)(F.lds + 3 * 64 * 128 * 4);
    const int qcol = GLA ? h * 64 : 1536 + h * 128, kcol = GLA ? 256 + h * 64 : 2048 + h * 128, vcol = GLA ? 512 + h * 128 : 2560 + h * 128, gcol = GLA ? 1024 + h * 128 : 3072 + h * 128;
    const float gamma = 1.0f - exp2f(-5.0f - (float)h);
    float S[DK];
#pragma unroll
    for (int d = 0; d < DK; ++d) S[d] = 0.f;
    for (int tile = 0; tile < SEQ / 64; ++tile) {
        const int row0 = b * SEQ + tile * 64;
        for (int i = F.tid; i < 64 * DK; i += NTHREADS) {
            const int t = i / DK, d = i % DK; const size_t r = (size_t)(row0 + t);
            qs[i] = bf2f(F.proj[r * NPROJ + qcol + d]); ks[i] = bf2f(F.proj[r * NPROJ + kcol + d]);
            if (GLA) { const float bc = F.bcum[r * 256 + h * 64 + d]; const float bp = t > 0 ? F.bcum[(r - 1) * 256 + h * 64 + d] : 0.f; as[i] = expf(bc - bp); }
        }
        for (int i = F.tid; i < 64 * 128; i += NTHREADS) { const int t = i >> 7, e = i & 127; vs[i] = bf2f(F.proj[(size_t)(row0 + t) * NPROJ + vcol + e]); }
        __syncthreads();
        if (F.tid < 128) {
            const int e = F.tid;
            for (int t = 0; t < 64; ++t) {
                const float v = vs[t * 128 + e]; float o = 0.f;
#pragma unroll
                for (int d = 0; d < DK; ++d) {
                    const float a = GLA ? as[t * DK + d] : gamma;
                    S[d] = a * S[d] + ks[t * DK + d] * v; o += qs[t * DK + d] * S[d];
                }
                vs[t * 128 + e] = o;
            }
        }
        __syncthreads();
        for (int tt = 0; tt < 8; ++tt) {
            const int t = F.wave * 8 + tt; const size_t r = (size_t)(row0 + t);
            const float o0 = vs[t * 128 + F.lane], o1 = vs[t * 128 + 64 + F.lane];
            float y0, y1;
            if (GLA) {
                const float rstd = 1.0f / sqrtf(wave_sum(o0 * o0 + o1 * o1) * (1.0f / 128.f) + EPS);
                y0 = o0 * rstd * F.gla_onorm[F.lane]; y1 = o1 * rstd * F.gla_onorm[64 + F.lane];
            } else {
                const float mu = wave_sum(o0 + o1) * (1.0f / 128.f); const float d0 = o0 - mu, d1 = o1 - mu;
                const float rstd = 1.0f / sqrtf(wave_sum(d0 * d0 + d1 * d1) * (1.0f / 128.f) + EPS);
                y0 = d0 * rstd * F.ret_onorm[F.lane]; y1 = d1 * rstd * F.ret_onorm[64 + F.lane];
            }
            y0 *= bf2f(F.proj[r * NPROJ + gcol + F.lane]); y1 *= bf2f(F.proj[r * NPROJ + gcol + 64 + F.lane]);
            const int oc = (GLA ? 0 : 512) + h * 128;
            F.obuf[r * D + oc + F.lane] = (bf16_t)f2bf(y0); F.obuf[r * D + oc + 64 + F.lane] = (bf16_t)f2bf(y1);
        }
        __syncthreads();
    }
}
DI void p3_la_naive(Frame& F) {
    { int t_ = threadIdx.x; asm volatile("" : "+v"(t_)); F.tid = t_; F.lane = t_ & 63; }
    for (int s = F.bid; s < 16; s += F.G) {
        const int type = s >> 3, b = (s >> 2) & 1, h = s & 3;
        if (type == 0) la_naive_stream<64, true>(F, b, h); else la_naive_stream<128, false>(F, b, h);
    }
}


typedef short s16x4 __attribute__((ext_vector_type(4)));
constexpr int LA_C = 128, LA_NC = SEQ / LA_C;
constexpr size_t U_RET_OFF = (size_t)8 * LA_NC * 128 * 64;
DI bf16x8 tr_pair(const LAS unsigned char* p0, const LAS unsigned char* p1) {
    const s16x4 lo = __builtin_amdgcn_ds_read_tr16_b64_v4i16((LAS s16x4*)p0);
    const s16x4 hi = __builtin_amdgcn_ds_read_tr16_b64_v4i16((LAS s16x4*)p1);
    return __builtin_shufflevector(lo, hi, 0, 1, 2, 3, 4, 5, 6, 7);
}
DI int slot_swap23(int t) { return (t & ~12) | ((t >> 1) & 4) | ((t << 1) & 8); }
DI float lg2_gamma(int h) { return log2f(1.0f - exp2f(-5.0f - (float)h)); }
DI bf16x8 scale8(u32x4 w, const float* f) {
    u32x4 o;
    o.x = cvt_pk_bf16(bflo(w.x) * f[0], bfhi(w.x) * f[1]); o.y = cvt_pk_bf16(bflo(w.y) * f[2], bfhi(w.y) * f[3]);
    o.z = cvt_pk_bf16(bflo(w.z) * f[4], bfhi(w.z) * f[5]); o.w = cvt_pk_bf16(bflo(w.w) * f[6], bfhi(w.w) * f[7]);
    return __builtin_bit_cast(bf16x8, o);
}
DI bf16x8 scale1(u32x4 w, float f) {
    u32x4 o;
    o.x = cvt_pk_bf16(bflo(w.x) * f, bfhi(w.x) * f); o.y = cvt_pk_bf16(bflo(w.y) * f, bfhi(w.y) * f);
    o.z = cvt_pk_bf16(bflo(w.z) * f, bfhi(w.z) * f); o.w = cvt_pk_bf16(bflo(w.w) * f, bfhi(w.w) * f);
    return __builtin_bit_cast(bf16x8, o);
}

template <int DK, int EB, bool GLA>
DI void la_pass1_unit(Frame& F, LAS unsigned char* wl, int b, int h, int n, int eh, bf16_t* Ubase) {
    int lane = F.lane; asm volatile("" : "+v"(lane), "+s"(n));
    const int g = lane >> 4, i16 = lane & 15, q = i16 >> 2, p = i16 & 3;
    constexpr int NDB = DK / 16, VCOLS = 16 * EB, VC = VCOLS / 8, KC = DK / 8, VI = 32 * VC / 64, KI = 32 * KC / 64;
    LAS unsigned char* vt = wl; LAS unsigned char* kt = wl + EB * 1024;
    const int r0 = b * SEQ + n * LA_C;
    const int kcol = GLA ? 256 + h * 64 : 2048 + h * 128, vcol = (GLA ? 512 : 2560) + h * 128 + eh * VCOLS, hd = h * 64;
    f32x4 acc[EB][NDB];
#pragma unroll
    for (int e = 0; e < EB; ++e)
#pragma unroll
        for (int d = 0; d < NDB; ++d) acc[e][d] = (f32x4){0.f, 0.f, 0.f, 0.f};
    const int kc = lane % KC, ktok = lane / KC, vch = lane % VC, vtok = lane / VC;
    float bl[8], b63[8]; const float lg2 = lg2_gamma(h);
    if (GLA) {
        const f32x4 a0 = *(const f32x4*)(F.bcum + (size_t)(r0 + 127) * 256 + hd + 8 * kc), a1 = *(const f32x4*)(F.bcum + (size_t)(r0 + 127) * 256 + hd + 8 * kc + 4);
        const f32x4 c0 = *(const f32x4*)(F.bcum + (size_t)(r0 + 63) * 256 + hd + 8 * kc), c1 = *(const f32x4*)(F.bcum + (size_t)(r0 + 63) * 256 + hd + 8 * kc + 4);
#pragma unroll
        for (int j = 0; j < 4; ++j) { bl[j] = a0[j]; bl[4 + j] = a1[j]; b63[j] = c0[j]; b63[4 + j] = c1[j]; }
    }
    if (GLA && eh == 0 && lane < KC) {
        float* dp = (float*)(F.ws + WS_DEC) + ((size_t)((b * 4 + h) * LA_NC + n) * 64) + 8 * kc;
        *(f32x4*)dp = (f32x4){__expf(bl[0] + b63[0]), __expf(bl[1] + b63[1]), __expf(bl[2] + b63[2]), __expf(bl[3] + b63[3])};
        *(f32x4*)(dp + 4) = (f32x4){__expf(bl[4] + b63[4]), __expf(bl[5] + b63[5]), __expf(bl[6] + b63[6]), __expf(bl[7] + b63[7])};
    }
    const int rbase = (((g >> 1) * 16 + (g & 1) * 4 + q) * 32) + 8 * p;
    u32x4 vr[VI], kr[KI]; f32x4 kbv[KI][2];
#define LA1_LOAD(step_) do { const int rs_ = r0 + 32 * (step_); \
        _Pragma("unroll") for (int i = 0; i < VI; ++i) vr[i] = *(const u32x4*)(F.proj + (size_t)(rs_ + vtok + i * (64 / VC)) * NPROJ + vcol + 8 * vch); \
        _Pragma("unroll") for (int i = 0; i < KI; ++i) { const size_t row = (size_t)(rs_ + ktok + i * (64 / KC)); kr[i] = *(const u32x4*)(F.proj + row * NPROJ + kcol + 8 * kc); \
            if (GLA) { kbv[i][0] = *(const f32x4*)(F.bcum + row * 256 + hd + 8 * kc); kbv[i][1] = *(const f32x4*)(F.bcum + row * 256 + hd + 8 * kc + 4); } } } while (0)
    LA1_LOAD(0);
#pragma unroll 1
    for (int step = 0; step < 4; ++step) {
#pragma unroll
        for (int i = 0; i < VI; ++i) { const int tau = vtok + i * (64 / VC); *(LAS u32x4*)(vt + (vch >> 1) * 1024 + slot_swap23(tau) * 32 + (vch & 1) * 16) = vr[i]; }
#pragma unroll
        for (int i = 0; i < KI; ++i) {
            const int tau = ktok + i * (64 / KC), t = 32 * step + tau;
            bf16x8 o;
            if (GLA) {
                float f[8];
#pragma unroll
                for (int j = 0; j < 8; ++j) f[j] = __expf(bl[j] - kbv[i][j >> 2][j & 3] + (t < 64 ? b63[j] : 0.f));
                o = scale8(kr[i], f);
            } else {
                o = scale1(kr[i], exp2f((float)(127 - t) * lg2));
            }
            *(LAS bf16x8*)(kt + (kc >> 1) * 1024 + slot_swap23(tau) * 32 + (kc & 1) * 16) = o;
        }
        if (step < 3) LA1_LOAD(step + 1);
        bf16x8 af[EB], bfr[NDB];
#pragma unroll
        for (int e = 0; e < EB; ++e) af[e] = tr_pair(vt + e * 1024 + rbase, vt + e * 1024 + rbase + 256);
#pragma unroll
        for (int d = 0; d < NDB; ++d) bfr[d] = tr_pair(kt + d * 1024 + rbase, kt + d * 1024 + rbase + 256);
#pragma unroll
        for (int e = 0; e < EB; ++e)
#pragma unroll
            for (int d = 0; d < NDB; ++d) acc[e][d] = __builtin_amdgcn_mfma_f32_16x16x32_bf16(bfr[d], af[e], acc[e][d], 0, 0, 0);
    }
#undef LA1_LOAD
    bf16_t* U = Ubase + (size_t)n * 128 * DK;
#pragma unroll
    for (int e = 0; e < EB; ++e)
#pragma unroll
        for (int d = 0; d < NDB; ++d)
            { u32x2 w; w.x = cvt_pk_bf16(acc[e][d][0], acc[e][d][1]); w.y = cvt_pk_bf16(acc[e][d][2], acc[e][d][3]);
              *(u32x2*)(U + (size_t)(eh * VCOLS + 16 * e + i16) * DK + 16 * d + 4 * g) = w; }
}

DI void p3_la_pass1(Frame& F) {
    { int t_ = threadIdx.x; asm volatile("" : "+v"(t_)); F.tid = t_; F.lane = t_ & 63; }
    LAS unsigned char* wl = F.lds + F.wave * 16384;
    const int gw = F.bid * NWAVES + F.wave, NGW = F.G * NWAVES;
    bf16_t* Ug = (bf16_t*)(F.ws + WS_U); bf16_t* Ur = Ug + U_RET_OFF;
    for (int u = gw; u < 2048 + 4096; u += NGW) {
        if (u < 2048) { const int eh = u & 1, n = (u >> 1) & 127, st = u >> 8; la_pass1_unit<64, 4, true>(F, wl, st >> 2, st & 3, n, eh, Ug + (size_t)st * LA_NC * 128 * 64); }
        else { const int v = u - 2048, eh = v & 3, n = (v >> 2) & 127, st = v >> 9; la_pass1_unit<128, 2, false>(F, wl, st >> 2, st & 3, n, eh, Ur + (size_t)st * LA_NC * 128 * 128); }
    }
}

DI void p4_la_scan(Frame& F) {
    { int t_ = threadIdx.x; asm volatile("" : "+v"(t_)); F.tid = t_; F.lane = t_ & 63; }
    const bf16_t* Ug = (const bf16_t*)(F.ws + WS_U); bf16_t* Sg = (bf16_t*)(F.ws + WS_SP);
    if (F.tid >= 384) { if (F.G == 256) tr_range(F, (LAS float*)(F.lds + 16384 + F.wave * 8704), TR_SPLIT2, TR_NITEMS, F.bid * 2 + (F.wave - 6), F.G * 2); return; }
    for (int it = F.bid * 384 + F.tid; it < 32768 + 65536; it += F.G * 384) {
        const bool gla = it < 32768;
        int st, e, d2, DK; size_t base;
        if (gla) { st = it >> 12; const int idx = it & 4095; e = idx >> 5; d2 = idx & 31; DK = 64; base = (size_t)st * LA_NC * 128 * 64; }
        else { const int v = it - 32768; st = v >> 13; const int idx = v & 8191; e = idx >> 6; d2 = idx & 63; DK = 128; base = U_RET_OFF + (size_t)st * LA_NC * 128 * 128; }
        const int b = st >> 2, h = st & 3;
        const size_t cstride = (size_t)128 * DK;
        const bf16_t* up = Ug + base + (size_t)e * DK + 2 * d2;
        bf16_t* sp = Sg + base + (size_t)e * DK + 2 * d2;
        const float* bc = (const float*)(F.ws + WS_DEC) + (size_t)(st & 7) * LA_NC * 64 + 2 * d2;
        const float dr = exp2f(128.0f * lg2_gamma(h));
        float s0 = 0.f, s1 = 0.f;
        unsigned uv[16], un[16]; f32x2 dv[16], dn[16];
#define LA4_LOAD(U_, D_, n0_) do { _Pragma("unroll") for (int j = 0; j < 16; ++j) { \
            U_[j] = *(const unsigned*)(up + (size_t)((n0_) + j) * cstride); \
            if (gla) D_[j] = *(const f32x2*)(bc + (size_t)((n0_) + j) * 64); } } while (0)
#define LA4_STEP(U_, D_, n0_) do { _Pragma("unroll") for (int j = 0; j < 16; ++j) { \
            *(unsigned*)(sp + (size_t)((n0_) + j) * cstride) = pk2(s0, s1); \
            const float d0 = gla ? D_[j].x : dr, d1 = gla ? D_[j].y : dr; \
            s0 = d0 * s0 + bflo(U_[j]); s1 = d1 * s1 + bfhi(U_[j]); } } while (0)
        LA4_LOAD(uv, dv, 0);
#pragma unroll 1
        for (int n0 = 0; n0 < LA_NC; n0 += 32) {
            LA4_LOAD(un, dn, n0 + 16);
            LA4_STEP(uv, dv, n0);
            if (n0 + 32 < LA_NC) LA4_LOAD(uv, dv, n0 + 32);
            LA4_STEP(un, dn, n0 + 16);
        }
#undef LA4_LOAD
#undef LA4_STEP
    }
}

template <int DK, bool GLA>
DI void la_pass3_unit(Frame& F, LAS unsigned char* wl, int b, int h, int n, int tq, const bf16_t* SpBase) {
    int lane = F.lane; asm volatile("" : "+v"(lane), "+s"(n), "+s"(tq));
    const int g = lane >> 4, i16 = lane & 15, q = i16 >> 2, p = i16 & 3;
    constexpr int NKS = DK / 32;
    const int r0 = b * SEQ + n * LA_C, t0 = 32 * tq, hd = h * 64;
    const int qcol = GLA ? h * 64 : 1536 + h * 128, kcol = GLA ? 256 + h * 64 : 2048 + h * 128, vcol = (GLA ? 512 : 2560) + h * 128, gcol = (GLA ? 1024 : 3072) + h * 128, ocol = (GLA ? 0 : 512) + h * 128;
    const float lg2 = lg2_gamma(h);
    u32x4 qraw[2][NKS]; f32x4 qb[2][NKS][2]; f32x4 c63[NKS][2];
    u32x4 kraw[2][NKS]; f32x4 kb[2][NKS][2]; u32x4 vraw[8];
#pragma unroll
    for (int tb = 0; tb < 2; ++tb)
#pragma unroll
        for (int ks = 0; ks < NKS; ++ks) {
            const size_t row = (size_t)(r0 + t0 + 16 * tb + i16);
            qraw[tb][ks] = *(const u32x4*)(F.proj + row * NPROJ + qcol + 32 * ks + 8 * g);
            if (GLA) { const float* bp = F.bcum + row * 256 + hd + 32 * ks + 8 * g; qb[tb][ks][0] = *(const f32x4*)bp; qb[tb][ks][1] = *(const f32x4*)(bp + 4); }
        }
    if (GLA) {
#pragma unroll
        for (int ks = 0; ks < NKS; ++ks) { const float* cp = F.bcum + (size_t)(r0 + 63) * 256 + hd + 32 * ks + 8 * g; c63[ks][0] = *(const f32x4*)cp; c63[ks][1] = *(const f32x4*)(cp + 4); }
    }
#define LA3_LOAD_KV(sp_) do { const int rs_ = r0 + 32 * (sp_); \
        _Pragma("unroll") for (int sb = 0; sb < 2; ++sb) _Pragma("unroll") for (int ks = 0; ks < NKS; ++ks) { const size_t row = (size_t)(rs_ + 16 * sb + i16); \
            kraw[sb][ks] = *(const u32x4*)(F.proj + row * NPROJ + kcol + 32 * ks + 8 * g); \
            if (GLA) { const float* bp = F.bcum + row * 256 + hd + 32 * ks + 8 * g; kb[sb][ks][0] = *(const f32x4*)bp; kb[sb][ks][1] = *(const f32x4*)(bp + 4); } } \
        _Pragma("unroll") for (int i = 0; i < 8; ++i) vraw[i] = *(const u32x4*)(F.proj + (size_t)(rs_ + (lane >> 4) + 4 * i) * NPROJ + vcol + 8 * (lane & 15)); } while (0)
    LA3_LOAD_KV(0);
    bf16x8 qf[2][NKS];
#pragma unroll
    for (int tb = 0; tb < 2; ++tb)
#pragma unroll
        for (int ks = 0; ks < NKS; ++ks) {
            if (GLA) {
                float f[8];
#pragma unroll
                for (int j = 0; j < 8; ++j) f[j] = __expf(qb[tb][ks][j >> 2][j & 3] + (t0 >= 64 ? c63[ks][j >> 2][j & 3] : 0.f));
                qf[tb][ks] = scale8(qraw[tb][ks], f);
            } else qf[tb][ks] = scale1(qraw[tb][ks], exp2f((float)(t0 + 16 * tb + i16 + 1) * lg2));
        }
    f32x4 o[2][8];
#pragma unroll
    for (int tb = 0; tb < 2; ++tb)
#pragma unroll
        for (int eb = 0; eb < 8; ++eb) o[tb][eb] = (f32x4){0.f, 0.f, 0.f, 0.f};
    const int vbase = (4 * g + q) * 32 + 8 * p;
#pragma unroll 1
    for (int sp = 0; sp <= tq; ++sp) {
#pragma unroll
        for (int i = 0; i < 8; ++i) { const int tau = (lane >> 4) + 4 * i, ch = lane & 15; *(LAS u32x4*)(wl + (ch >> 1) * 1024 + tau * 32 + (ch & 1) * 16) = vraw[i]; }
        bf16x8 kf[2][NKS];
#pragma unroll
        for (int sb = 0; sb < 2; ++sb)
#pragma unroll
            for (int ks = 0; ks < NKS; ++ks) {
                if (GLA) {
                    float f[8];
#pragma unroll
                    for (int j = 0; j < 8; ++j) f[j] = __expf(-(kb[sb][ks][j >> 2][j & 3] + (sp >= 2 ? c63[ks][j >> 2][j & 3] : 0.f)));
                    kf[sb][ks] = scale8(kraw[sb][ks], f);
                } else kf[sb][ks] = scale1(kraw[sb][ks], exp2f(-(float)(32 * sp + 16 * sb + i16 + 1) * lg2));
            }
        if (sp < tq) LA3_LOAD_KV(sp + 1);
        bf16x8 pf[2];
#pragma unroll
        for (int tb = 0; tb < 2; ++tb) {
            const int T = 2 * tq + tb;
            f32x4 s0 = (f32x4){0.f, 0.f, 0.f, 0.f}, s1 = s0;
#pragma unroll
            for (int ks = 0; ks < NKS; ++ks) {
                s0 = __builtin_amdgcn_mfma_f32_16x16x32_bf16(kf[0][ks], qf[tb][ks], s0, 0, 0, 0);
                s1 = __builtin_amdgcn_mfma_f32_16x16x32_bf16(kf[1][ks], qf[tb][ks], s1, 0, 0, 0);
            }
            const int S0 = 2 * sp, S1 = 2 * sp + 1;
#pragma unroll
            for (int r = 0; r < 4; ++r) {
                const bool keep = (4 * g + r) <= i16;
                if (S0 == T && !keep) s0[r] = 0.f;
                if (S1 > T || (S1 == T && !keep)) s1[r] = 0.f;
            }
            u32x4 pw_; pw_.x = cvt_pk_bf16(s0[0], s0[1]); pw_.y = cvt_pk_bf16(s0[2], s0[3]); pw_.z = cvt_pk_bf16(s1[0], s1[1]); pw_.w = cvt_pk_bf16(s1[2], s1[3]);
            pf[tb] = __builtin_bit_cast(bf16x8, pw_);
        }
#pragma unroll
        for (int eb = 0; eb < 8; ++eb) {
            const bf16x8 vf = tr_pair(wl + eb * 1024 + vbase, wl + eb * 1024 + vbase + 512);
            o[0][eb] = __builtin_amdgcn_mfma_f32_16x16x32_bf16(pf[0], vf, o[0][eb], 0, 0, 0);
            o[1][eb] = __builtin_amdgcn_mfma_f32_16x16x32_bf16(pf[1], vf, o[1][eb], 0, 0, 0);
        }
    }
#undef LA3_LOAD_KV
    u32x4 gt[8];
#pragma unroll
    for (int i = 0; i < 8; ++i) gt[i] = *(const u32x4*)(F.proj + (size_t)(r0 + t0 + 4 * i + (lane >> 4)) * NPROJ + gcol + 8 * (lane & 15));
    const bf16_t* Sp = SpBase + (size_t)n * 128 * DK;
#pragma unroll
    for (int eb = 0; eb < 8; ++eb)
#pragma unroll
        for (int ks = 0; ks < NKS; ++ks) {
            const bf16x8 sf = *(const bf16x8*)(Sp + (size_t)(16 * eb + i16) * DK + 32 * ks + 8 * g);
            o[0][eb] = __builtin_amdgcn_mfma_f32_16x16x32_bf16(qf[0][ks], sf, o[0][eb], 0, 0, 0);
            o[1][eb] = __builtin_amdgcn_mfma_f32_16x16x32_bf16(qf[1][ks], sf, o[1][eb], 0, 0, 0);
        }
#pragma unroll
    for (int tb = 0; tb < 2; ++tb)
#pragma unroll
        for (int r = 0; r < 4; ++r) {
            float mu = 0.f;
            if (!GLA) {
                float s = 0.f;
#pragma unroll
                for (int eb = 0; eb < 8; ++eb) s += o[tb][eb][r];
                s = row16_sum(s);
                mu = s * (1.0f / 128.f);
            }
            float ss = 0.f;
#pragma unroll
            for (int eb = 0; eb < 8; ++eb) { const float dlt = o[tb][eb][r] - mu; o[tb][eb][r] = dlt; ss += dlt * dlt; }
            ss = row16_sum(ss);
            const float rstd = __builtin_amdgcn_rsqf(ss * (1.0f / 128.f) + EPS);
#pragma unroll
            for (int eb = 0; eb < 8; ++eb) *(LAS float*)(wl + ((16 * tb + 4 * g + r) * 128 + 16 * eb + i16) * 4) = o[tb][eb][r] * rstd;
        }
    {
        const int ch = lane & 15; const float* onw = (GLA ? F.gla_onorm : F.ret_onorm) + 8 * ch;
        const f32x4 w0 = *(const f32x4*)onw, w1 = *(const f32x4*)(onw + 4);
#pragma unroll
        for (int i = 0; i < 8; ++i) {
            const int t = 4 * i + (lane >> 4); const size_t row = (size_t)(r0 + t0 + t);
            const f32x4 y0 = *(const LAS f32x4*)(wl + (t * 128 + 8 * ch) * 4), y1 = *(const LAS f32x4*)(wl + (t * 128 + 8 * ch + 4) * 4);
            const u32x4 gg = gt[i];
            float ov[8];
            ov[0] = y0[0] * w0[0] * bflo(gg.x); ov[1] = y0[1] * w0[1] * bfhi(gg.x); ov[2] = y0[2] * w0[2] * bflo(gg.y); ov[3] = y0[3] * w0[3] * bfhi(gg.y);
            ov[4] = y1[0] * w1[0] * bflo(gg.z); ov[5] = y1[1] * w1[1] * bfhi(gg.z); ov[6] = y1[2] * w1[2] * bflo(gg.w); ov[7] = y1[3] * w1[3] * bfhi(gg.w);
#if O_FP8
            { u32x2 w8; w8.x = pk4_fp8(ov[0] * O8_SCALE, ov[1] * O8_SCALE, ov[2] * O8_SCALE, ov[3] * O8_SCALE); w8.y = pk4_fp8(ov[4] * O8_SCALE, ov[5] * O8_SCALE, ov[6] * O8_SCALE, ov[7] * O8_SCALE);
              *(u32x2*)((unsigned char*)F.obuf + row * D + ocol + 8 * ch) = w8; }
#else
            store8_bf16(F.obuf + row * D + ocol + 8 * ch, ov);
#endif
        }
    }
}

DI void p5_la_pass3(Frame& F) {
    { int t_ = threadIdx.x; asm volatile("" : "+v"(t_)); F.tid = t_; F.lane = t_ & 63; }
    LAS unsigned char* wl = F.lds + F.wave * 16384;
    const int gw = F.bid * NWAVES + F.wave, NGW = F.G * NWAVES;
    const bf16_t* Sg = (const bf16_t*)(F.ws + WS_SP); const bf16_t* Sr = Sg + U_RET_OFF;
    const int ntask_round = NGW >> 2;
#pragma unroll 1
    for (int i = 0; i * ntask_round < 2048; ++i) {
        const int task = i * ntask_round + (gw >> 2); if (task >= 2048) break;
        const int tq = (gw + i) & 3, type = task & 1, idx = task >> 1, st = idx >> 7, n = idx & 127;
        if (type == 0) la_pass3_unit<64, true>(F, wl, st >> 2, st & 3, n, tq, Sg + (size_t)st * LA_NC * 128 * 64);
        else la_pass3_unit<128, false>(F, wl, st >> 2, st & 3, n, tq, Sr + (size_t)st * LA_NC * 128 * 128);
    }
}

#define DPPF(v, ctrl) __builtin_bit_cast(float, __builtin_amdgcn_update_dpp(__builtin_bit_cast(int, v), __builtin_bit_cast(int, v), ctrl, 0xf, 0xf, false))
DI float row16_max(float v) {
    v = fmaxf(v, DPPF(v, 0xB1)); v = fmaxf(v, DPPF(v, 0x4E)); v = fmaxf(v, DPPF(v, 0x141)); v = fmaxf(v, DPPF(v, 0x140)); return v;
}
DI void p7_router(Frame& F) {
    { int t_ = threadIdx.x; asm volatile("" : "+v"(t_)); F.tid = t_; F.lane = t_ & 63; }
    constexpr int RS = 2064;
    LAS unsigned char* hh = F.lds;
    LAS unsigned char* hlo = F.lds + 16 * RS;
    LAS float* part = (LAS float*)(F.lds + 69632);
    LAS int* hist = (LAS int*)(F.lds + 98304);
    LAS int* basearr = hist + 32;
    LAS int* pinfo = hist + 64;
    LAS float* pwl = (LAS float*)(pinfo + 512);
    const int e = F.lane & 31, g = F.lane >> 4, i16 = F.lane & 15;
    for (int rb = F.bid; rb < M / 128; rb += F.G) {
        const int row0 = rb * 128, b = row0 >= SEQ;
        bf16x8 wh[4][2], wl[4][2];
#pragma unroll
        for (int ks = 0; ks < 4; ++ks)
#pragma unroll
            for (int eb = 0; eb < 2; ++eb) {
                const float* wp = F.w_router + (size_t)(128 * F.wave + 32 * ks + 8 * g) * NE + 16 * eb + i16;
                float w[8];
#pragma unroll
                for (int j = 0; j < 8; ++j) w[j] = wp[j * NE];
                u32x4 hi, lo;
                hi.x = pk2(w[0], w[1]); hi.y = pk2(w[2], w[3]); hi.z = pk2(w[4], w[5]); hi.w = pk2(w[6], w[7]);
                lo.x = pk2(w[0] - bflo(hi.x), w[1] - bfhi(hi.x)); lo.y = pk2(w[2] - bflo(hi.y), w[3] - bfhi(hi.y));
                lo.z = pk2(w[4] - bflo(hi.z), w[5] - bfhi(hi.z)); lo.w = pk2(w[6] - bflo(hi.w), w[7] - bfhi(hi.w));
                wh[ks][eb] = __builtin_bit_cast(bf16x8, hi); wl[ks][eb] = __builtin_bit_cast(bf16x8, lo);
            }
        f32x4 cs[4], sh[4];
#pragma unroll
        for (int j = 0; j < 4; ++j) {
            const f32x4 w = ((const f32x4*)F.norm2)[F.lane + 64 * j], sc = ((const f32x4*)(F.mod + b * 6144 + 4096))[F.lane + 64 * j];
            cs[j] = w * (sc + 1.0f); sh[j] = ((const f32x4*)(F.mod + b * 6144 + 3072))[F.lane + 64 * j];
        }
        const float brt = F.b_router[e];
        if (F.tid < 32) hist[F.tid] = 0;
        f32x4 va[4], vb[4];
#if X1_BF16
        { const u32x2* xa = (const u32x2*)((const bf16_t*)F.x1 + (size_t)(row0 + 2 * F.wave) * D) + F.lane;
#pragma unroll
          for (int j = 0; j < 4; ++j) { va[j] = bf4_to_f32(xa[64 * j]); vb[j] = bf4_to_f32(xa[256 + 64 * j]); } }
#else
        { const f32x4* xa = (const f32x4*)(F.x1 + (size_t)(row0 + 2 * F.wave) * D) + F.lane;
#pragma unroll
          for (int j = 0; j < 4; ++j) { va[j] = xa[64 * j]; vb[j] = xa[256 + 64 * j]; } }
#endif
        __syncthreads();
#pragma unroll 1
        for (int batch = 0; batch < 8; ++batch) {
            {
                const int rl0 = 2 * F.wave, rowa = row0 + batch * 16 + rl0;
                float sa = 0.f, sb = 0.f;
#pragma unroll
                for (int j = 0; j < 4; ++j) { sa += (va[j].x * va[j].x + va[j].y * va[j].y) + (va[j].z * va[j].z + va[j].w * va[j].w); sb += (vb[j].x * vb[j].x + vb[j].y * vb[j].y) + (vb[j].z * vb[j].z + vb[j].w * vb[j].w); }
                const float ra = __builtin_amdgcn_rsqf(wave_sum(sa) * (1.0f / D) + EPS), rbb = __builtin_amdgcn_rsqf(wave_sum(sb) * (1.0f / D) + EPS);
#if MOE_FP8
                unsigned* oa = (unsigned*)((unsigned char*)F.hbuf + (size_t)rowa * D) + F.lane;
#else
                u32x2* oa = (u32x2*)(F.hbuf + (size_t)rowa * D) + F.lane;
#endif
#pragma unroll
                for (int j = 0; j < 4; ++j) {
                    const f32x4 ha = va[j] * ra * cs[j] + sh[j], hb = vb[j] * rbb * cs[j] + sh[j];
#if MOE_FP8
                    oa[64 * j] = pk4_fp8(ha.x * H8_SCALE, ha.y * H8_SCALE, ha.z * H8_SCALE, ha.w * H8_SCALE);
                    oa[256 + 64 * j] = pk4_fp8(hb.x * H8_SCALE, hb.y * H8_SCALE, hb.z * H8_SCALE, hb.w * H8_SCALE);
#else
                    u32x2 p; p.x = pk2(ha.x, ha.y); p.y = pk2(ha.z, ha.w); oa[64 * j] = p;
                    p.x = pk2(hb.x, hb.y); p.y = pk2(hb.z, hb.w); oa[256 + 64 * j] = p;
#endif
                    u32x2 h1, l1, h2_, l2_;
                    h1.x = pk2(ha.x, ha.y); h1.y = pk2(ha.z, ha.w); l1.x = pk2(ha.x - bflo(h1.x), ha.y - bfhi(h1.x)); l1.y = pk2(ha.z - bflo(h1.y), ha.w - bfhi(h1.y));
                    h2_.x = pk2(hb.x, hb.y); h2_.y = pk2(hb.z, hb.w); l2_.x = pk2(hb.x - bflo(h2_.x), hb.y - bfhi(h2_.x)); l2_.y = pk2(hb.z - bflo(h2_.y), hb.w - bfhi(h2_.y));
                    const int co = (4 * F.lane + 256 * j) * 2;
                    *(LAS u32x2*)(hh + rl0 * RS + co) = h1; *(LAS u32x2*)(hlo + rl0 * RS + co) = l1;
                    *(LAS u32x2*)(hh + (rl0 + 1) * RS + co) = h2_; *(LAS u32x2*)(hlo + (rl0 + 1) * RS + co) = l2_;
                }
                if (batch < 7) {
#if X1_BF16
                    const u32x2* xn = (const u32x2*)((const bf16_t*)F.x1 + (size_t)(rowa + 16) * D) + F.lane;
#pragma unroll
                    for (int j = 0; j < 4; ++j) { va[j] = bf4_to_f32(xn[64 * j]); vb[j] = bf4_to_f32(xn[256 + 64 * j]); }
#else
                    const f32x4* xn = (const f32x4*)(F.x1 + (size_t)(rowa + 16) * D) + F.lane;
#pragma unroll
                    for (int j = 0; j < 4; ++j) { va[j] = xn[64 * j]; vb[j] = xn[256 + 64 * j]; }
#endif
                }
            }
            __syncthreads();
            {
                f32x4 acc0 = (f32x4){0.f, 0.f, 0.f, 0.f}, acc1 = acc0;
#pragma unroll
                for (int ks = 0; ks < 4; ++ks) {
                    const int off = i16 * RS + (128 * F.wave + 32 * ks + 8 * g) * 2;
                    const bf16x8 ah = *(const LAS bf16x8*)(hh + off), al = *(const LAS bf16x8*)(hlo + off);
                    acc0 = __builtin_amdgcn_mfma_f32_16x16x32_bf16(ah, wh[ks][0], acc0, 0, 0, 0);
                    acc0 = __builtin_amdgcn_mfma_f32_16x16x32_bf16(ah, wl[ks][0], acc0, 0, 0, 0);
                    acc0 = __builtin_amdgcn_mfma_f32_16x16x32_bf16(al, wh[ks][0], acc0, 0, 0, 0);
                    acc1 = __builtin_amdgcn_mfma_f32_16x16x32_bf16(ah, wh[ks][1], acc1, 0, 0, 0);
                    acc1 = __builtin_amdgcn_mfma_f32_16x16x32_bf16(ah, wl[ks][1], acc1, 0, 0, 0);
                    acc1 = __builtin_amdgcn_mfma_f32_16x16x32_bf16(al, wh[ks][1], acc1, 0, 0, 0);
                }
#pragma unroll
                for (int r = 0; r < 4; ++r) { part[((4 * g + r) * 8 + F.wave) * 32 + i16] = acc0[r]; part[((4 * g + r) * 8 + F.wave) * 32 + 16 + i16] = acc1[r]; }
            }
            __syncthreads();
#pragma unroll
            for (int rr = 0; rr < 2; ++rr) {
                const int rl = 2 * F.wave + rr, rloc = batch * 16 + rl;
                float val = brt;
#pragma unroll
                for (int p = 0; p < 8; ++p) val += part[(rl * 8 + p) * 32 + e];
                if (F.lane >= 32) val = -INFINITY;
                int sel[4]; float sv[4];
#pragma unroll
                for (int k = 0; k < 4; ++k) {
                    const float rm = row16_max(val);
                    const float mx = fmaxf(__builtin_bit_cast(float, __builtin_amdgcn_readlane(__builtin_bit_cast(int, rm), 0)), __builtin_bit_cast(float, __builtin_amdgcn_readlane(__builtin_bit_cast(int, rm), 16)));
                    const unsigned long long bal = __ballot(val == mx && F.lane < 32);
                    const int idx = bal ? (int)__builtin_ctzll(bal) : 0;
                    sel[k] = idx; sv[k] = mx;
                    if (F.lane == idx) val = -INFINITY;
                }
                const float e1 = __expf(sv[1] - sv[0]), e2 = __expf(sv[2] - sv[0]), e3 = __expf(sv[3] - sv[0]);
                const float inv = 1.0f / (1.0f + e1 + e2 + e3);
                if (F.lane < 4) {
                    const int k = F.lane;
                    const int se = k == 0 ? sel[0] : k == 1 ? sel[1] : k == 2 ? sel[2] : sel[3];
                    const float wv = (k == 0 ? 1.0f : k == 1 ? e1 : k == 2 ? e2 : e3) * inv;
                    const int lr = __hip_atomic_fetch_add(hist + se, 1, __ATOMIC_RELAXED, __HIP_MEMORY_SCOPE_WORKGROUP);
                    pinfo[rloc * 4 + k] = se | (lr << 8);
                    pwl[rloc * 4 + k] = wv;
                }
            }
            __syncthreads();
        }
        if (F.tid < 32) basearr[F.tid] = (int)atomicAdd(F.ctl + CW_CNT + 64 * F.tid, (unsigned)hist[F.tid]);
        __syncthreads();
        { const int info = pinfo[F.tid], ee = info & 255, lr = info >> 8; u32x2 rec; rec.x = (unsigned)(row0 * 4 + F.tid); rec.y = __builtin_bit_cast(unsigned, pwl[F.tid]); F.perm[(size_t)ee * ECAP + basearr[ee] + lr] = rec; }
        __syncthreads();
    }
}

DI void moe_order(Frame& F, pg8::MoeOrder& S, int NT, const void* Bt, size_t bstride, int ebytes, int sa, int sb) {
    LAS int* mi = (LAS int*)(F.lds + MISC_OFF);
    LAS int* ud = (LAS int*)(F.lds + UD_OFF);
    if (F.tid < 32) mi[F.tid] = (int)F.ctl[CW_CNT + 64 * F.tid];
    __syncthreads();
    if (F.tid == 0) { int o = 0, tp = 0; for (int i = 0; i < NE; ++i) { mi[32 + i] = o; mi[64 + i] = tp; o += mi[i]; tp += (mi[i] + 255) >> 8; } mi[96] = tp; }
    __syncthreads();
    const int x = F.bid & 7, JB = F.G >> 3, j = F.bid >> 3;
    const int ptot = mi[96], lo = ptot * x / 8, hi = ptot * (x + 1) / 8, U = (hi - lo) * NT;
    if (F.tid < 64) {
        const int q = j + F.tid * JB;
        if (q < U) {
            const int pl = q / NT, pn = q % NT, g = lo + pl;
            int e = 0;
            for (int k = 1; k < NE; ++k) e += (mi[64 + k] <= g) ? 1 : 0;
            const int p = g - mi[64 + e], left = mi[e] - p * 256;
            i32x4_ r; r.x = e | (pn << 8) | (((pn + 2 * pl) & 7) << 16); r.y = left < 256 ? left : 256; r.z = mi[32 + e] + p * 256; r.w = e * ECAP + p * 256;
            *(LAS i32x4_*)(ud + 4 * F.tid) = r;
        }
    }
    __syncthreads();
    const int nu = U > j ? (U - j + JB - 1) / JB : 0;
    S.n = __builtin_amdgcn_readfirstlane(nu < 64 ? nu : 64); S.ud = ud; S.Bt = Bt; S.bstride = bstride; S.ebytes = ebytes; S.sa = sa; S.sb = sb;
}
struct MoeBatch {
    pg8::MoeOrder S; int i0, n;
    DI bool next(int i, pg8::Unit& u) const { if (i >= n) return false; return S.next(i0 + i, u); }
    DI const char* bptr(const pg8::Unit& u) const { return S.bptr(u); }
    DI int scale_a() const { return S.sa; }
    DI int scale_b() const { return S.sb; }
};

DI void p8_gu(Frame& F) {
    { int t_ = threadIdx.x; asm volatile("" : "+v"(t_)); F.tid = t_; F.lane = t_ & 63; }
    pg8::MoeOrder S; moe_order(F, S, 8, F.wgu_t, (size_t)2048 * D, MOE_FP8 ? 1 : 2, H8_E8M0, W8_E8M0);
    LAS unsigned* tbl = (LAS unsigned*)(F.lds + TBL_OFF);
    EpiGU E{F.b_gu, F.act};
    for (int i0 = 0;; i0 += TBL_UNITS) {
        pg8::Unit u; if (!S.next(i0, u)) break;
        int n;
        {
            int t_ = threadIdx.x; asm volatile("" : "+v"(t_));
            const int ln = t_ & 63, half = __builtin_amdgcn_readfirstlane(t_ >> 8), idx = t_ & 255;
            pg8::Unit uk; uk.prow0 = 0; uk.rows = 0;
            const bool ok = ln < TBL_UNITS && S.next_lane(i0 + ln, uk);
            n = __builtin_popcountll(__ballot(ok));
            const int pv = ok ? uk.prow0 : 0, rv = ok ? uk.rows : 0;
            unsigned pr[TBL_UNITS / 2];
#pragma unroll
            for (int it = 0; it < TBL_UNITS / 2; ++it) {
                const int k = 2 * it + half; pr[it] = 0u;
                if (k < n) { const int p0 = __builtin_amdgcn_readlane(pv, k), rw = __builtin_amdgcn_readlane(rv, k); pr[it] = F.perm[p0 + (idx < rw ? idx : 0)].x; }
            }
#pragma unroll
            for (int it = 0; it < TBL_UNITS / 2; ++it) { const int k = 2 * it + half; if (k < n) tbl[k * 256 + idx] = (pr[it] >> 2) * (unsigned)(D * (MOE_FP8 ? 1 : 2)); }
        }
        __syncthreads();
        MoeBatch Bt{S, i0, n};
        pg8::gemm_phase<EpiGU, MoeBatch, true, (MOE_FP8 != 0)>(F.lds, F.hbuf, Bt, E, tbl);
        __syncthreads();
    }
}
DI void p9_down(Frame& F) {
    { int t_ = threadIdx.x; asm volatile("" : "+v"(t_)); F.tid = t_; F.lane = t_ & 63; }
    pg8::MoeOrder S; moe_order(F, S, 4, F.wd_t, (size_t)D * D, MOE_FP8 ? 1 : 2, A8_E8M0, W8_E8M0);
    LAS unsigned* tbl = (LAS unsigned*)(F.lds + TBL_OFF);
    EpiDown E{F.b_down, F.perm, F.Y};
    for (int i0 = 0;; i0 += TBL_UNITS) {
        pg8::Unit u; if (!S.next(i0, u)) break;
        int n = 0;
        for (; n < TBL_UNITS; ++n) {
            if (!S.next(i0 + n, u)) break;
            int t_ = threadIdx.x; asm volatile("" : "+v"(t_));
            if (t_ < 256) tbl[n * 256 + t_] = (unsigned)(u.arow0 + t_) * (unsigned)(D * (MOE_FP8 ? 1 : 2));
        }
        __syncthreads();
        MoeBatch Bt{S, i0, n};
        pg8::gemm_phase<EpiDown, MoeBatch, true, (MOE_FP8 != 0), true>(F.lds, F.act, Bt, E, tbl);
        __syncthreads();
    }
}

DI void p10_final(Frame& F) {
    { int t_ = threadIdx.x; asm volatile("" : "+v"(t_)); F.tid = t_; F.lane = t_ & 63; }
    const int gw = F.bid * NWAVES + F.wave, NGW = F.G * NWAVES;
    f32x4 xv[4], xn[4]; int yv[4][4], yn[4][4];
#if X1_BF16
#define P10_XLOAD(xr_, j_) bf4_to_f32(__builtin_nontemporal_load((const u32x2*)((const bf16_t*)(xr_)) + F.lane + 64 * (j_)))
#else
#define P10_XLOAD(xr_, j_) __builtin_nontemporal_load((const f32x4*)(xr_) + F.lane + 64 * (j_))
#endif
#define P10_LOAD(X_, Y_, m_) do { const void* xr_ = X1_BF16 ? (const void*)((const bf16_t*)F.x1 + (size_t)(m_) * D) : (const void*)(F.x1 + (size_t)(m_) * D); \
        _Pragma("unroll") for (int j = 0; j < 4; ++j) { X_[j] = P10_XLOAD(xr_, j); \
            _Pragma("unroll") for (int k = 0; k < 4; ++k) Y_[j][k] = __builtin_nontemporal_load((const int*)((const unsigned char*)F.Y + ((size_t)(m_) * 4 + k) * D * (Y_FP8 ? 1 : 2)) + F.lane + 64 * j); } } while (0)
    static_assert(Y_FP8, "p10_final reads fp8 rows");
    if (gw < M) P10_LOAD(xv, yv, gw);
    for (int m = gw; m < M; m += NGW) {
        const int b = m >= SEQ;
        if (m + NGW < M) P10_LOAD(xn, yn, m + NGW);
        const f32x4* gr = (const f32x4*)(F.mod + b * 6144 + 5120) + F.lane;
        f32x4 v[4]; float s = 0.f;
#pragma unroll
        for (int j = 0; j < 4; ++j) {
            f32x4 y = (f32x4){0.f, 0.f, 0.f, 0.f};
#pragma unroll
            for (int k = 0; k < 4; ++k) {
                const f32x2 lo = __builtin_amdgcn_cvt_pk_f32_fp8(yv[j][k], false), hi = __builtin_amdgcn_cvt_pk_f32_fp8(yv[j][k], true);
                y += (f32x4){lo.x, lo.y, hi.x, hi.y};
            }
            v[j] = xv[j] + gr[64 * j] * (y * Y8_INV);
            s += (v[j].x * v[j].x + v[j].y * v[j].y) + (v[j].z * v[j].z + v[j].w * v[j].w);
        }
        const float rstd = __builtin_amdgcn_rsqf(wave_sum(s) * (1.0f / D) + EPS);
        f32x4* o = (f32x4*)(F.out + (size_t)m * D) + F.lane;
#pragma unroll
        for (int j = 0; j < 4; ++j) __builtin_nontemporal_store(v[j] * rstd * ((const f32x4*)F.norm_f)[F.lane + 64 * j], o + 64 * j);
#pragma unroll
        for (int j = 0; j < 4; ++j) { xv[j] = xn[j];
#pragma unroll
            for (int k = 0; k < 4; ++k) yv[j][k] = yn[j][k]; }
    }
#undef P10_LOAD
}

constexpr int NPH = 11;
template <int LO, int HI>
__global__ void __launch_bounds__(NTHREADS, 2) fwd_kernel(Args args) {
    extern __shared__ __attribute__((aligned(16))) unsigned char lds[];
    Frame F;
    F.lds = (LAS unsigned char*)lds;
    F.tid = threadIdx.x; F.lane = F.tid & 63; F.wave = __builtin_amdgcn_readfirstlane(F.tid >> 6);
    F.G = gridDim.x; F.bid = blockIdx.x;
    F.x = (const float*)args.in[0]; F.c = (const float*)args.in[1]; F.positions = (const int*)args.in[2]; F.w_ada = (const float*)args.in[3]; F.b_ada = (const float*)args.in[4];
    F.norm1 = (const float*)args.in[5]; F.w_in = (const float*)args.in[6]; F.w_gk2 = (const float*)args.in[7]; F.b_gk = (const float*)args.in[8]; F.gla_onorm = (const float*)args.in[9];
    F.ret_onorm = (const float*)args.in[10]; F.w_out = (const float*)args.in[11]; F.norm2 = (const float*)args.in[12]; F.w_router = (const float*)args.in[13]; F.b_router = (const float*)args.in[14];
    F.w_gu = (const float*)args.in[15]; F.b_gu = (const float*)args.in[16]; F.w_down = (const float*)args.in[17]; F.b_down = (const float*)args.in[18]; F.norm_f = (const float*)args.in[19];
    F.out = args.out; F.ws = args.ws;
    unsigned char* ws = args.ws;
    F.ctl = (unsigned*)(ws + WS_CTL); F.mod = (float*)(ws + WS_MOD); F.win_t = (bf16_t*)(ws + WS_WIN); F.wout_t = (bf16_t*)(ws + WS_WOUT); F.wgu_t = (bf16_t*)(ws + WS_WGU); F.wd_t = (bf16_t*)(ws + WS_WD);
    F.hbuf = (bf16_t*)(ws + WS_H); F.obuf = (bf16_t*)(ws + WS_O); F.proj = (bf16_t*)(ws + WS_PROJ); F.act = (bf16_t*)(ws + WS_ACT); F.Y = (bf16_t*)(ws + WS_Y);
    F.x1 = (float*)(ws + WS_X1); F.bcum = (float*)(ws + WS_BCUM); F.pw = (float*)(ws + WS_PW); F.perm = (u32x2*)(ws + WS_PERM);

#define IN(k) (LO <= (k) && (k) < HI)
#if ONE_LAUNCH && USE_CG_SYNC
#define GSYNC(k) do { if (IN(k) && IN((k) + 1)) { cg::this_grid().sync(); } } while (0)
#elif ONE_LAUNCH
    { volatile LAS unsigned* st = (volatile LAS unsigned*)(F.lds + MISC_OFF + 512); if (F.tid < 2) st[F.tid] = 0u; }
    __syncthreads();
    const XcdBarrier bar = xcd_barrier_post(F.ctl + CW_BAR, (volatile LAS unsigned*)(F.lds + MISC_OFF + 512));
#define GSYNC(k) do { if (IN(k) && IN((k) + 1)) { xcd_barrier(bar); } } while (0)
#else
#define GSYNC(k) do { } while (0)
#endif
    if (IN(0)) { p0_prep(F); if (DUP(0)) p0_prep(F); } GSYNC(0);
    if (IN(1)) { p1_h1(F); if (DUP(1)) p1_h1(F); } GSYNC(1);
    if (IN(2)) {
        pg8::DenseOrder S; S.init(M, NIN_T, F.G, F.bid, F.win_t);
        EpiProj E{F.proj, F.bcum, F.positions, F.b_gk};
        pg8::gemm_phase<EpiProj, pg8::DenseOrder, false>(F.lds, F.hbuf, S, E, nullptr);
        if (DUP(2)) pg8::gemm_phase<EpiProj, pg8::DenseOrder, false>(F.lds, F.hbuf, S, E, nullptr);
        { pg8::Unit u8; if (F.G == 256 && !S.next(7, u8)) {
            { int t_ = threadIdx.x; asm volatile("" : "+v"(t_)); F.tid = t_; F.lane = t_ & 63; }
            const int nidle = F.G - (1920 - 7 * F.G), widx = (F.bid - (1920 - 7 * F.G)) * NWAVES + F.wave;
            if (nidle > 0 && widx >= 0) tr_range(F, (LAS float*)(F.lds + 16384 + F.wave * 8704), TR_SPLIT1, TR_SPLIT2, widx, nidle * NWAVES); } }
    } GSYNC(2);
#if NAIVE_LA
    if (IN(3)) { p3_la_naive(F); } GSYNC(3);
    GSYNC(4);
    GSYNC(5);
#else
    if (IN(3)) { p3_la_pass1(F); if (DUP(3)) p3_la_pass1(F); } GSYNC(3);
    if (IN(4)) { p4_la_scan(F); if (DUP(4)) p4_la_scan(F); } GSYNC(4);
    if (IN(5)) { p5_la_pass3(F); if (DUP(5)) p5_la_pass3(F); } GSYNC(5);
#endif
    if (IN(6)) {
        EpiRes1 E{F.x, F.mod, F.x1};
#if O_FP8
        pg8::DenseOrder S; S.init(M, D, F.G, F.bid, F.wout_t, 1, O8_E8M0, W8_E8M0);
        LAS unsigned* tbl = (LAS unsigned*)(F.lds + TBL_OFF);
        { pg8::Unit u; int n = 0;
          for (; n < TBL_UNITS; ++n) { if (!S.next(n, u)) break; int t_ = threadIdx.x; asm volatile("" : "+v"(t_)); if (t_ < 256) tbl[n * 256 + t_] = (unsigned)(u.arow0 + t_) * (unsigned)D; } }
        __syncthreads();
        pg8::gemm_phase<EpiRes1, pg8::DenseOrder, true, true, true>(F.lds, F.obuf, S, E, tbl);
#else
        pg8::DenseOrder S; S.init(M, D, F.G, F.bid, F.wout_t);
        pg8::gemm_phase<EpiRes1, pg8::DenseOrder, false, false, true>(F.lds, F.obuf, S, E, nullptr);
        if (DUP(6)) pg8::gemm_phase<EpiRes1, pg8::DenseOrder, false, false, true>(F.lds, F.obuf, S, E, nullptr);
#endif
    } GSYNC(6);
    if (IN(7)) { p7_router(F); } GSYNC(7);
    if (IN(8)) { p8_gu(F); if (DUP(8)) p8_gu(F); } GSYNC(8);
    if (IN(9)) { p9_down(F); if (DUP(9)) p9_down(F); } GSYNC(9);
    if (IN(10)) { p10_final(F); if (DUP(10)) p10_final(F); }
}

extern "C" void kernel_launch(void* const* d_in, const int* in_sizes, int n_in, void* d_out, int out_size, void* d_ws, size_t ws_size, hipStream_t stream) {
    static int grid = 0;
    if (grid == 0) {
        if (n_in != 20 || out_size != M * D || ws_size < WS_END) { fprintf(stderr, "kernel_launch: unexpected shapes (n_in %d out %d ws %zu)\n", n_in, out_size, ws_size); grid = -1; return; }
        int dev = 0, cus = 0, per_cu = 0;
        hipGetDevice(&dev); hipDeviceGetAttribute(&cus, hipDeviceAttributeMultiprocessorCount, dev);
#if ONE_LAUNCH
        hipFuncSetAttribute((const void*)fwd_kernel<0, NPH>, hipFuncAttributeMaxDynamicSharedMemorySize, LDS_BYTES);
        hipOccupancyMaxActiveBlocksPerMultiprocessor(&per_cu, (const void*)fwd_kernel<0, NPH>, NTHREADS, LDS_BYTES);
#else
        per_cu = 1;
#define SETATTR(k) hipFuncSetAttribute((const void*)fwd_kernel<k, k + 1>, hipFuncAttributeMaxDynamicSharedMemorySize, LDS_BYTES)
        SETATTR(0); SETATTR(1); SETATTR(2); SETATTR(3); SETATTR(4); SETATTR(5); SETATTR(6); SETATTR(7); SETATTR(8); SETATTR(9); SETATTR(10);
#endif
        (void)hipGetLastError();
        if (per_cu < 1) { fprintf(stderr, "kernel_launch: occupancy query says %d blocks/CU\n", per_cu); per_cu = 1; }
        grid = cus;
        if (grid != 256) fprintf(stderr, "kernel_launch: %d CUs (expected 256)\n", grid);
    }
    if (grid < 0) return;
    hipMemsetAsync((char*)d_ws + WS_CTL, 0, CTL_ZERO_BYTES, stream);
    Args a{};
    for (int i = 0; i < 20; ++i) a.in[i] = d_in[i];
    a.out = (float*)d_out; a.ws = (unsigned char*)d_ws;
#if ONE_LAUNCH
    a.ph_lo = 0; a.ph_hi = NPH;
#if USE_CG_SYNC
    void* params[] = {&a};
    hipError_t e = hipLaunchCooperativeKernel((const void*)fwd_kernel<0, NPH>, dim3(grid), dim3(NTHREADS), params, LDS_BYTES, stream);
    if (e != hipSuccess) fprintf(stderr, "cooperative launch failed: %s (grid %d)\n", hipGetErrorString(e), grid);
#else
    hipLaunchKernelGGL((fwd_kernel<0, NPH>), dim3(grid), dim3(NTHREADS), LDS_BYTES, stream, a);
#endif
#else
#define LAUNCH(k) hipLaunchKernelGGL((fwd_kernel<k, k + 1>), dim3(grid), dim3(NTHREADS), LDS_BYTES, stream, a)
    LAUNCH(0); LAUNCH(1); LAUNCH(2); LAUNCH(3); LAUNCH(4); LAUNCH(5); LAUNCH(6); LAUNCH(7); LAUNCH(8); LAUNCH(9); LAUNCH(10);
#endif
}
```
